# Optimizing an MI355X kernel written in HIP

```python
import math
import jax
import jax.numpy as jnp
from jax import lax
import numpy as np

D_MODEL = 1024
BATCH = 32
SEQ = 256
DEPTH = 2
DEC_BATCH = 8
DEC_SEQ = 1024
PAST_LEN = 512

GRID_W = 64
HEAD_DIM = 64
ROPE_PAIRS = HEAD_DIM // 4
ROPE_BASE = 10000.0
BLOCK = 128
EPS = 1e-6
NEG_INF = -1e30
D_FF = 2816
N_MOD = 9
N_BRANCH = 4
BRANCH_W = 512

HY_W = BRANCH_W
HY_SHORT = 3
HY_BANDS = 16
HY_EMB = 1 + 2 * HY_BANDS
HY_FH = 64
HY_SIN_W = 1.0
HY_TARGET = 1e-2
HY_DECAY_SHORT_PCT = 0.3
HY_DECAY_LONG_PCT = 1.5

DIFF_HEADS = 4
DIFF_QK_W = DIFF_HEADS * 2 * HEAD_DIM
DIFF_V_W = DIFF_HEADS * 2 * HEAD_DIM

WIN_Q_HEADS = 8
WIN_KV_HEADS = 2
WIN_GROUP = WIN_Q_HEADS // WIN_KV_HEADS
WINDOW = 128
WIN_Q_W = WIN_Q_HEADS * HEAD_DIM
WIN_KV_W = WIN_KV_HEADS * HEAD_DIM

RET_HEADS = 4
RET_DK = 64
RET_DV = 128
RET_CHUNK = 128
RET_QK_W = RET_HEADS * RET_DK
RET_V_W = RET_HEADS * RET_DV

COL_SIZES = (3 * HY_W, DIFF_QK_W, DIFF_QK_W, DIFF_V_W, WIN_Q_W, WIN_KV_W, WIN_KV_W,
             RET_QK_W, RET_QK_W, RET_V_W, RET_V_W, N_BRANCH * D_MODEL)
IN_COLS = sum(COL_SIZES)

kernel_name = 'hybrid_diffusion_prefix_trunk_step'


def rms_norm(x, gain=None):
    xf = x.astype(jnp.float32)
    y = xf * lax.rsqrt(jnp.mean(xf * xf, axis=-1, keepdims=True) + EPS)
    if gain is not None:
        y = y * gain.astype(jnp.float32)
    return y.astype(x.dtype)


def ada_mod(cond, w, b):
    return jax.nn.silu(cond) @ w + b


def modulate(h, shift, scale):
    return h * (1.0 + scale) + shift


def swiglu(h, w_in, w_out):
    a, g = jnp.split(h @ w_in, 2, axis=-1)
    return (jax.nn.silu(a) * g) @ w_out


def axial_rope(x):
    n = x.shape[1]
    rows = n // GRID_W
    row = jnp.broadcast_to(jnp.arange(rows)[:, None], (rows, GRID_W)).reshape(n)
    col = jnp.broadcast_to(jnp.arange(GRID_W)[None, :], (rows, GRID_W)).reshape(n)
    inv_freq = ROPE_BASE ** (-jnp.arange(ROPE_PAIRS, dtype=jnp.float32) / ROPE_PAIRS)
    bshape = (n,) + (1,) * (x.ndim - 3) + (ROPE_PAIRS,)

    def rotate(xa, pos):
        ang = (pos.astype(jnp.float32)[:, None] * inv_freq[None, :]).reshape(bshape)
        cos, sin = jnp.cos(ang).astype(x.dtype), jnp.sin(ang).astype(x.dtype)
        x1, x2 = xa[..., :ROPE_PAIRS], xa[..., ROPE_PAIRS:]
        return jnp.concatenate([x1 * cos - x2 * sin, x1 * sin + x2 * cos], axis=-1)

    half = HEAD_DIM // 2
    return jnp.concatenate([rotate(x[..., :half], row), rotate(x[..., half:], col)], axis=-1)


def sweep_query_blocks(fn, q):
    B, L = q.shape[:2]
    nb = L // BLOCK
    qb = jnp.moveaxis(q.reshape((B, nb, BLOCK) + q.shape[2:]), 1, 0)
    out = lax.map(fn, qb)
    return jnp.moveaxis(out, 0, 1).reshape((B, L) + out.shape[3:])


def diff_block(qb, k, v, lam):
    s = jnp.einsum('bqhcd,bkhcd->bhcqk', qb, k).astype(jnp.float32) * (HEAD_DIM ** -0.5)
    p = jax.nn.softmax(s, axis=-1)
    a = p[:, :, 0] - lam * p[:, :, 1]
    return jnp.einsum('bhqk,bkhe->bqhe', a.astype(v.dtype), v)


def window_dense_block(qb, k, v, sink):
    B, Q = qb.shape[:2]
    s = jnp.einsum('bqhgd,bkhd->bhgqk', qb, k).astype(jnp.float32) * (HEAD_DIM ** -0.5)
    s_sink = jnp.broadcast_to(sink.astype(jnp.float32).reshape(WIN_KV_HEADS, WIN_GROUP)[None, :, :, None, None],
                              (B, WIN_KV_HEADS, WIN_GROUP, Q, 1))
    p = jax.nn.softmax(jnp.concatenate([s, s_sink], axis=-1), axis=-1)[..., :-1]
    return jnp.einsum('bhgqk,bkhd->bqhgd', p.astype(v.dtype), v)


def window_latent(q, k, v, k_ctx, v_ctx, sink):
    B, L = q.shape[:2]
    nb = L // BLOCK
    C = k_ctx.shape[1]
    qb = q.reshape(B, nb, BLOCK, WIN_KV_HEADS, WIN_GROUP, HEAD_DIM)

    def band(x):
        xp = jnp.pad(x, ((0, 0), (BLOCK, BLOCK), (0, 0), (0, 0))).reshape(B, nb + 2, BLOCK, WIN_KV_HEADS, HEAD_DIM)
        return jnp.concatenate([xp[:, :-2], xp[:, 1:-1], xp[:, 2:]], axis=2)

    kb, vb = band(k), band(v)
    blk = jnp.arange(nb)
    tq = blk[:, None] * BLOCK + jnp.arange(BLOCK)[None, :]
    tk = (blk[:, None] - 1) * BLOCK + jnp.arange(3 * BLOCK)[None, :]
    rel = tk[:, None, :] - tq[:, :, None]
    valid = (jnp.abs(rel) <= WINDOW) & (tk[:, None, :] >= 0) & (tk[:, None, :] < L)
    scale = HEAD_DIM ** -0.5
    s_band = jnp.einsum('bnqhgd,bnkhd->bnhgqk', qb, kb).astype(jnp.float32) * scale
    s_band = jnp.where(valid[None, :, None, None], s_band, NEG_INF)
    s_ctx = jnp.einsum('bnqhgd,bchd->bnhgqc', qb, k_ctx).astype(jnp.float32) * scale
    s_sink = jnp.broadcast_to(sink.astype(jnp.float32).reshape(WIN_KV_HEADS, WIN_GROUP)[None, None, :, :, None, None],
                              (B, nb, WIN_KV_HEADS, WIN_GROUP, BLOCK, 1))
    p = jax.nn.softmax(jnp.concatenate([s_band, s_ctx, s_sink], axis=-1), axis=-1)
    p_band = p[..., :3 * BLOCK].astype(v.dtype)
    p_ctx = p[..., 3 * BLOCK:3 * BLOCK + C].astype(v.dtype)
    o = (jnp.einsum('bnhgqk,bnkhd->bnqhgd', p_band, vb)
         + jnp.einsum('bnhgqc,bchd->bnqhgd', p_ctx, v_ctx))
    return o.reshape(B, L, WIN_KV_HEADS, WIN_GROUP, HEAD_DIM)


def retention_scan(q, k, v, log_gamma, s0):
    B, L, H, _ = q.shape
    nc = L // RET_CHUNK
    f32 = jnp.float32

    def chunks(x):
        return jnp.moveaxis(x.astype(f32).reshape((B, nc, RET_CHUNK) + x.shape[2:]), 1, 0)

    lg = log_gamma.astype(f32)
    idx = jnp.arange(RET_CHUNK, dtype=f32)
    rel = idx[:, None] - idx[None, :]
    intra = jnp.where(rel[None] >= 0, jnp.exp(jnp.maximum(rel, 0.0)[None] * lg[:, None, None]), 0.0)
    q_dec = jnp.exp((idx + 1.0)[:, None] * lg[None, :])[..., None]
    k_dec = jnp.exp((RET_CHUNK - 1.0 - idx)[:, None] * lg[None, :])[..., None]
    chunk_dec = jnp.exp(RET_CHUNK * lg)[None, :, None, None]

    def step(state, inp):
        qc, kc, vc = inp
        scores = jnp.einsum('bqhd,bkhd->bhqk', qc, kc) * intra
        out = (jnp.einsum('bhqk,bkhe->bqhe', scores, vc)
               + jnp.einsum('bqhd,bhde->bqhe', qc * q_dec, state))
        state = state * chunk_dec + jnp.einsum('bkhd,bkhe->bhde', kc * k_dec, vc)
        return state, out

    s_final, out = lax.scan(step, s0.astype(f32), (chunks(q), chunks(k), chunks(v)))
    return jnp.moveaxis(out, 0, 1).reshape(B, L, H, v.shape[-1]), s_final


def retention_bidirectional(q, k, v, lg_f, lg_b, s0_f, s0_b):
    o_f, s_f = retention_scan(q, k, v, lg_f, s0_f)
    o_b, s_b = retention_scan(jnp.flip(q, 1), jnp.flip(k, 1), jnp.flip(v, 1), lg_b, s0_b)
    return o_f + jnp.flip(o_b, 1), s_f, s_b


def short_conv(u, w, b):
    up = jnp.pad(u, ((0, 0), (1, 1), (0, 0)))
    return up[:, :-2] * w[0] + up[:, 1:-1] * w[1] + up[:, 2:] * w[2] + b


def hyena_filters(L, w1, b1, w2, b2, w3):
    t = jnp.arange(L, dtype=jnp.float32) / L
    f = jnp.arange(1, HY_BANDS + 1, dtype=jnp.float32)
    ang = 2.0 * math.pi * t[:, None] * f[None, :]
    feats = jnp.concatenate([t[:, None], jnp.sin(ang), jnp.cos(ang)], axis=-1)
    z = jnp.sin(HY_SIN_W * (feats @ w1 + b1))
    z = jnp.sin(HY_SIN_W * (z @ w2 + b2))
    z = (z @ w3).astype(jnp.float32)
    min_decay = math.log(HY_TARGET) / HY_DECAY_LONG_PCT
    max_decay = math.log(HY_TARGET) / HY_DECAY_SHORT_PCT
    deltas = jnp.linspace(min_decay, max_decay, HY_W, dtype=jnp.float32)
    window = jnp.exp(-t[:, None] * jnp.abs(deltas)[None, :])
    h_f = z[:, :HY_W] * window
    h_b = z[:, HY_W:] * window
    norm = jnp.sum(jnp.abs(h_f), axis=0, keepdims=True) + jnp.sum(jnp.abs(h_b), axis=0, keepdims=True)
    return h_f / norm, h_b / norm


def long_conv(u, h_f, h_b, skip):
    L = u.shape[1]
    k = jnp.concatenate([h_f, jnp.zeros_like(h_f[:1]), h_b[1:][::-1]], axis=0)
    k_f = jnp.fft.rfft(k, n=2 * L, axis=0)
    u_f = jnp.fft.rfft(u.astype(jnp.float32), n=2 * L, axis=1)
    y = jnp.fft.irfft(u_f * k_f[None], n=2 * L, axis=1)[:, :L]
    return (y + u.astype(jnp.float32) * skip.astype(jnp.float32)).astype(u.dtype)


def hyena_branch(cols, lp):
    L = cols.shape[1]
    u = short_conv(cols, lp['hy_conv_w'], lp['hy_conv_b'])
    v, x0, x1 = jnp.split(u, 3, axis=-1)
    h_f, h_b = hyena_filters(L, lp['hy_f_w1'], lp['hy_f_b1'], lp['hy_f_w2'], lp['hy_f_b2'], lp['hy_f_w3'])
    return x0 * long_conv(v * x1, h_f, h_b, lp['hy_skip'])


def mix(h, lp, layer_idx, cache):
    B, L, _ = h.shape
    f32 = jnp.float32
    split_points = np.cumsum(COL_SIZES)[:-1].tolist()
    (hy, dq, dk, dv, wq, wk, wv, rq, rk, rv, rg, gl) = jnp.split(h @ lp['w_in'], split_points, axis=-1)

    y_hy = hyena_branch(hy, lp)

    q_d = rms_norm(dq.reshape(B, L, DIFF_HEADS, 2, HEAD_DIM), lp['diff_q_norm'])
    k_d = rms_norm(dk.reshape(B, L, DIFF_HEADS, 2, HEAD_DIM), lp['diff_k_norm'])
    v_d = dv.reshape(B, L, DIFF_HEADS, 2 * HEAD_DIM)
    lam_init = 0.8 - 0.6 * math.exp(-0.3 * layer_idx)
    dl = lp['diff_lambda'].astype(f32)
    lam = jnp.exp(jnp.sum(dl[0] * dl[1])) - jnp.exp(jnp.sum(dl[2] * dl[3])) + lam_init

    q_w = rms_norm(wq.reshape(B, L, WIN_KV_HEADS, WIN_GROUP, HEAD_DIM), lp['win_q_norm'])
    k_w = rms_norm(wk.reshape(B, L, WIN_KV_HEADS, HEAD_DIM), lp['win_k_norm'])
    v_w = wv.reshape(B, L, WIN_KV_HEADS, HEAD_DIM)

    q_r = rq.reshape(B, L, RET_HEADS, RET_DK)
    k_r = rk.reshape(B, L, RET_HEADS, RET_DK) * (RET_DK ** -0.5)
    v_r = rv.reshape(B, L, RET_HEADS, RET_DV)
    lg_f = -jax.nn.softplus(-lp['ret_decay_f'].astype(f32))
    lg_b = -jax.nn.softplus(-lp['ret_decay_b'].astype(f32))

    if cache is None:
        s0 = jnp.zeros((B, RET_HEADS, RET_DK, RET_DV), f32)
        y_diff = sweep_query_blocks(lambda qb: diff_block(qb, k_d, v_d, lam), q_d)
        y_win = sweep_query_blocks(lambda qb: window_dense_block(qb, k_w, v_w, lp['win_sink']), q_w)
        y_ret, s_f, s_b = retention_bidirectional(q_r, k_r, v_r, lg_f, lg_b, s0, s0)
        state = (k_d, v_d, k_w, v_w, s_f, s_b)
    else:
        ck_d, cv_d, ck_w, cv_w, cs_f, cs_b = cache
        q_dr, k_dr = axial_rope(q_d), axial_rope(k_d)
        keys_d = jnp.concatenate([k_dr, ck_d.astype(k_dr.dtype)], axis=1)
        vals_d = jnp.concatenate([v_d, cv_d.astype(v_d.dtype)], axis=1)
        y_diff = sweep_query_blocks(lambda qb: diff_block(qb, keys_d, vals_d, lam), q_dr)
        y_win = window_latent(axial_rope(q_w), axial_rope(k_w), v_w,
                              ck_w.astype(k_w.dtype), cv_w.astype(v_w.dtype), lp['win_sink'])
        y_ret, _, _ = retention_bidirectional(q_r, k_r, v_r, lg_f, lg_b, cs_f, cs_b)
        state = None

    y_diff = (rms_norm(y_diff, lp['diff_subln']) * (1.0 - lam_init)).reshape(B, L, DIFF_V_W)
    y_win = y_win.reshape(B, L, WIN_Q_W)
    y_ret = rms_norm(y_ret).reshape(B, L, RET_V_W).astype(h.dtype) * jax.nn.silu(rg)

    gates = jax.nn.sigmoid(gl.reshape(B, L, N_BRANCH, D_MODEL))
    branches = (y_hy, y_diff, y_win, y_ret)
    merged = gates[:, :, 0] * (branches[0] @ lp['w_branch'][0])
    for i in range(1, N_BRANCH):
        merged = merged + gates[:, :, i] * (branches[i] @ lp['w_branch'][i])
    return merged @ lp['w_out'], state


def trunk_layer(x, mod, lp, layer_idx, cache):
    sa, ca, ga, sm, cm, gm, sb, cb, gb = jnp.split(mod[:, None, :], N_MOD, axis=-1)
    h = modulate(rms_norm(x, lp['norm_ffa']), sa, ca)
    x = x + 0.5 * ga * swiglu(h, lp['w_ffa_in'], lp['w_ffa_out'])
    h = modulate(rms_norm(x, lp['norm_mix']), sm, cm)
    mixed, state = mix(h, lp, layer_idx, cache)
    x = x + gm * mixed
    h = modulate(rms_norm(x, lp['norm_ffb']), sb, cb)
    x = x + 0.5 * gb * swiglu(h, lp['w_ffb_in'], lp['w_ffb_out'])
    return x, state


def setup_inputs(seed: int = 0) -> dict:
    key = jax.random.key(seed)
    ks = iter(jax.random.split(key, 48))

    def nrm(shape, scale):
        return jax.random.normal(next(ks), shape, jnp.float32) * scale

    def gain(shape):
        return 1.0 + nrm(shape, 0.02)

    ret_base = jnp.log(2.0 ** (5.0 + jnp.arange(RET_HEADS, dtype=jnp.float32)) - 1.0)
    inp = {}
    inp['x_prompt'] = nrm((BATCH, SEQ, D_MODEL), 1.0)
    inp['x_sample'] = nrm((DEC_BATCH, DEC_SEQ, D_MODEL), 1.0)
    inp['c'] = nrm((DEC_BATCH, D_MODEL), 1.0)
    inp['cache_diff_k'] = nrm((DEC_BATCH, DEPTH, PAST_LEN, DIFF_HEADS, 2, HEAD_DIM), 1.0)
    inp['cache_diff_v'] = nrm((DEC_BATCH, DEPTH, PAST_LEN, DIFF_HEADS, 2 * HEAD_DIM), 1.0)
    inp['cache_win_k'] = nrm((DEC_BATCH, DEPTH, PAST_LEN, WIN_KV_HEADS, HEAD_DIM), 1.0)
    inp['cache_win_v'] = nrm((DEC_BATCH, DEPTH, PAST_LEN, WIN_KV_HEADS, HEAD_DIM), 1.0)
    inp['state_ret_f'] = nrm((DEC_BATCH, DEPTH, RET_HEADS, RET_DK, RET_DV), 0.5)
    inp['state_ret_b'] = nrm((DEC_BATCH, DEPTH, RET_HEADS, RET_DK, RET_DV), 0.5)
    inp['c_ctx'] = nrm((D_MODEL,), 1.0)
    inp['norm_ffa'] = gain((DEPTH, D_MODEL))
    inp['norm_mix'] = gain((DEPTH, D_MODEL))
    inp['norm_ffb'] = gain((DEPTH, D_MODEL))
    inp['w_ada'] = nrm((DEPTH, D_MODEL, N_MOD * D_MODEL), 0.5 * D_MODEL ** -0.5)
    inp['b_ada'] = nrm((DEPTH, N_MOD * D_MODEL), 0.02)
    inp['w_ffa_in'] = nrm((DEPTH, D_MODEL, 2 * D_FF), D_MODEL ** -0.5)
    inp['w_ffa_out'] = nrm((DEPTH, D_FF, D_MODEL), D_FF ** -0.5)
    inp['w_ffb_in'] = nrm((DEPTH, D_MODEL, 2 * D_FF), D_MODEL ** -0.5)
    inp['w_ffb_out'] = nrm((DEPTH, D_FF, D_MODEL), D_FF ** -0.5)
    inp['w_in'] = nrm((DEPTH, D_MODEL, IN_COLS), D_MODEL ** -0.5)
    inp['hy_conv_w'] = nrm((DEPTH, HY_SHORT, 3 * HY_W), HY_SHORT ** -0.5)
    inp['hy_conv_b'] = nrm((DEPTH, 3 * HY_W), 0.02)
    inp['hy_f_w1'] = nrm((DEPTH, HY_EMB, HY_FH), HY_EMB ** -0.5)
    inp['hy_f_b1'] = nrm((DEPTH, HY_FH), 0.02)
    inp['hy_f_w2'] = nrm((DEPTH, HY_FH, HY_FH), HY_FH ** -0.5)
    inp['hy_f_b2'] = nrm((DEPTH, HY_FH), 0.02)
    inp['hy_f_w3'] = nrm((DEPTH, HY_FH, 2 * HY_W), HY_FH ** -0.5)
    inp['hy_skip'] = nrm((DEPTH, HY_W), 0.5)
    inp['diff_q_norm'] = gain((DEPTH, HEAD_DIM))
    inp['diff_k_norm'] = gain((DEPTH, HEAD_DIM))
    inp['diff_lambda'] = nrm((DEPTH, 4, HEAD_DIM), 0.1)
    inp['diff_subln'] = gain((DEPTH, 2 * HEAD_DIM))
    inp['win_q_norm'] = gain((DEPTH, HEAD_DIM))
    inp['win_k_norm'] = gain((DEPTH, HEAD_DIM))
    inp['win_sink'] = nrm((DEPTH, WIN_Q_HEADS), 0.5)
    inp['ret_decay_f'] = ret_base[None, :] + nrm((DEPTH, RET_HEADS), 0.1)
    inp['ret_decay_b'] = ret_base[None, :] + nrm((DEPTH, RET_HEADS), 0.1)
    inp['w_branch'] = nrm((DEPTH, N_BRANCH, BRANCH_W, D_MODEL), BRANCH_W ** -0.5)
    inp['w_out'] = nrm((DEPTH, D_MODEL, D_MODEL), D_MODEL ** -0.5)
    return inp


def reference(x_prompt, x_sample, c, cache_diff_k, cache_diff_v, cache_win_k, cache_win_v,
              state_ret_f, state_ret_b, c_ctx, norm_ffa, norm_mix, norm_ffb, w_ada, b_ada,
              w_ffa_in, w_ffa_out, w_ffb_in, w_ffb_out, w_in, hy_conv_w, hy_conv_b,
              hy_f_w1, hy_f_b1, hy_f_w2, hy_f_b2, hy_f_w3, hy_skip,
              diff_q_norm, diff_k_norm, diff_lambda, diff_subln,
              win_q_norm, win_k_norm, win_sink, ret_decay_f, ret_decay_b, w_branch, w_out):
    y_ctx = x_prompt
    y_lat = x_sample
    st_dk, st_dv, st_wk, st_wv, st_rf, st_rb = [], [], [], [], [], []
    for l in range(DEPTH):
        lp = {
            'norm_ffa': norm_ffa[l], 'norm_mix': norm_mix[l], 'norm_ffb': norm_ffb[l],
            'w_ffa_in': w_ffa_in[l], 'w_ffa_out': w_ffa_out[l],
            'w_ffb_in': w_ffb_in[l], 'w_ffb_out': w_ffb_out[l],
            'w_in': w_in[l], 'hy_conv_w': hy_conv_w[l], 'hy_conv_b': hy_conv_b[l],
            'hy_f_w1': hy_f_w1[l], 'hy_f_b1': hy_f_b1[l], 'hy_f_w2': hy_f_w2[l], 'hy_f_b2': hy_f_b2[l],
            'hy_f_w3': hy_f_w3[l], 'hy_skip': hy_skip[l],
            'diff_q_norm': diff_q_norm[l], 'diff_k_norm': diff_k_norm[l],
            'diff_lambda': diff_lambda[l], 'diff_subln': diff_subln[l],
            'win_q_norm': win_q_norm[l], 'win_k_norm': win_k_norm[l], 'win_sink': win_sink[l],
            'ret_decay_f': ret_decay_f[l], 'ret_decay_b': ret_decay_b[l],
            'w_branch': w_branch[l], 'w_out': w_out[l],
        }
        mod_ctx = ada_mod(c_ctx[None, :], w_ada[l], b_ada[l])
        y_ctx, ctx_state = trunk_layer(y_ctx, mod_ctx, lp, l, None)
        st_dk.append(ctx_state[0])
        st_dv.append(ctx_state[1])
        st_wk.append(ctx_state[2])
        st_wv.append(ctx_state[3])
        st_rf.append(ctx_state[4])
        st_rb.append(ctx_state[5])
        mod_lat = ada_mod(c, w_ada[l], b_ada[l])
        cache = (cache_diff_k[:, l], cache_diff_v[:, l], cache_win_k[:, l], cache_win_v[:, l],
                 state_ret_f[:, l], state_ret_b[:, l])
        y_lat, _ = trunk_layer(y_lat, mod_lat, lp, l, cache)
    new_diff_k = jnp.stack(st_dk, axis=1)
    new_diff_v = jnp.stack(st_dv, axis=1)
    new_win_k = jnp.stack(st_wk, axis=1)
    new_win_v = jnp.stack(st_wv, axis=1)
    new_ret_f = jnp.stack(st_rf, axis=1)
    new_ret_b = jnp.stack(st_rb, axis=1)
    return (y_ctx, y_lat, new_diff_k, new_diff_v, new_win_k, new_win_v, new_ret_f, new_ret_b)
```

```cpp
#include <hip/hip_runtime.h>
#include <cstdio>
#include <cstdint>
namespace pg8 {
#define PG8_LAS __attribute__((address_space(3)))
typedef unsigned short bf16_t;
typedef short bf16x8 __attribute__((ext_vector_type(8)));
typedef float f32x4 __attribute__((ext_vector_type(4)));
typedef unsigned u32x4 __attribute__((ext_vector_type(4)));
constexpr int BM = 256, BK = 64, HALF = 128, HTB = HALF * BK * 2  , STAGE_BYTES = 8 * HTB, NXCD = 8, WGM = 8;

__host__ __device__ __forceinline__ int lds_byte(int r, int c) { const int st = (r >> 4) * 2 + (c >> 5), rr = r & 15, cc = c & 31, ob = rr * 64 + cc * 2; return st * 1024 + (ob ^ (((ob >> 9) & 1) << 5)); }
__host__ __device__ __forceinline__ void stage_rc(int b, int& R, int& C) { const int st = b / 1024, sb = b % 1024, swz = sb ^ (((sb >> 9) & 1) << 5); R = (st >> 1) * 16 + swz / 64; C = (st & 1) * 32 + (swz % 64) / 2; }
__host__ __device__ __forceinline__ int perm32(int rho) { const int n = rho >> 4, i = rho & 15; return 8 * (i >> 2) + 4 * n + (i & 3); }

struct Unit { int pm, pn; };
struct Gemm { const bf16_t* A; const bf16_t* Bt; int M, N, K; };

struct StaticOrder {
    int nM, nN, nwg, G, c;
    __host__ __device__ void init(int M, int N, int G_, int c_) { nM = M / BM; nN = N / BM; nwg = nM * nN; G = G_; c = c_; }
    __host__ __device__ bool next(int i, Unit& u) const {
        const long L = (long)i * G + c; if (L >= nwg) return false;
        int wgid = (int)L; { const int q = nwg / NXCD, r = nwg % NXCD, xcd = wgid % NXCD, off = wgid / NXCD; wgid = (xcd < r ? xcd * (q + 1) : r * (q + 1) + (xcd - r) * q) + off; }
        const int nig = WGM * nN, gid = wgid / nig, fm = gid * WGM, gsz = (nM - fm) < WGM ? (nM - fm) : WGM;
        u.pm = fm + ((wgid % nig) % gsz); u.pn = (wgid % nig) / gsz; return true;
    }
    __device__ __forceinline__ void a_ready(const Unit&) const {}
    __device__ __forceinline__ void done(const Unit&) const {}
};
typedef __bf16 bf16x2n __attribute__((ext_vector_type(2)));
typedef float f32x2n __attribute__((ext_vector_type(2)));
__device__ __forceinline__ unsigned cvt_pk_bf16(float lo, float hi) { f32x2n v = {lo, hi}; bf16x2n b = __builtin_convertvector(v, bf16x2n); return __builtin_bit_cast(unsigned, b); }
typedef float f32x2 __attribute__((ext_vector_type(2)));
typedef unsigned u32x2 __attribute__((ext_vector_type(2)));
__device__ __forceinline__ float fast_sigmoid(float a) { return __builtin_amdgcn_rcpf(1.0f + __expf(-a)); }
__device__ __forceinline__ float bf_lo(unsigned u) { return __uint_as_float(u << 16); }
__device__ __forceinline__ float bf_hi(unsigned u) { return __uint_as_float(u & 0xffff0000u); }

struct EpiSwiGLU {
    static constexpr bool PERM = true, AFTER_DRAIN = false;
    bf16_t* O; int ldo;
    __device__ __forceinline__ void operator()(const f32x4 (&acc)[2][2][4][2], const Unit& u, int wr, int wc, int fr, int fq) const {
        const int row0 = u.pm * BM + wr * 64 + fr, col0 = u.pn * HALF + wc * 32 + 8 * fq;
#pragma unroll
        for (int ai = 0; ai < 2; ++ai)
#pragma unroll
            for (int m = 0; m < 4; ++m) { bf16_t* rowp = O + (size_t)(row0 + ai * HALF + m * 16) * ldo + col0;
                f32x4 v0, v1;
#pragma unroll
                for (int j = 0; j < 4; ++j) { const float a0 = acc[ai][0][m][0][j], a1 = acc[ai][0][m][1][j];
                    v0[j] = a0 * fast_sigmoid(a0) * acc[ai][1][m][0][j]; v1[j] = a1 * fast_sigmoid(a1) * acc[ai][1][m][1][j]; }
                u32x4 w; w.x = cvt_pk_bf16(v0[0], v0[1]); w.y = cvt_pk_bf16(v0[2], v0[3]); w.z = cvt_pk_bf16(v1[0], v1[1]); w.w = cvt_pk_bf16(v1[2], v1[3]);
                *(u32x4*)rowp = w; }
    }
};
struct EpiResid {
    static constexpr bool PERM = false, AFTER_DRAIN = false;
    float* X; const float* gate; float coef;
    __device__ __forceinline__ void operator()(const f32x4 (&acc)[2][2][4][2], const Unit& u, int wr, int wc, int fr, int fq) const {
        const int row0 = u.pm * BM + wr * 64 + fr, col0 = u.pn * BM + wc * 32 + 4 * fq;
        const int mr = u.pm < 32 ? 0 : 1 + ((u.pm - 32) >> 2);
        const float* gp = gate + (size_t)mr * 9216 + col0;
        f32x4 gv[2][2];
#pragma unroll
        for (int bj = 0; bj < 2; ++bj)
#pragma unroll
            for (int n = 0; n < 2; ++n) gv[bj][n] = *(const f32x4*)(gp + bj * HALF + n * 16) * coef;
#pragma unroll
        for (int ai = 0; ai < 2; ++ai)
#pragma unroll
            for (int m = 0; m < 4; ++m) { float* rowp = X + (size_t)(row0 + ai * HALF + m * 16) * 1024 + col0;
#pragma unroll
                for (int bj = 0; bj < 2; ++bj)
#pragma unroll
                    for (int n = 0; n < 2; ++n) { f32x4* p = (f32x4*)(rowp + bj * HALF + n * 16); *p = *p + gv[bj][n] * acc[ai][bj][m][n]; } }
    }
};
template <int ACT> struct EpiStore {
    static constexpr bool PERM = true, AFTER_DRAIN = false;
    bf16_t* O; int ldo;
    __device__ __forceinline__ void operator()(const f32x4 (&acc)[2][2][4][2], const Unit& u, int wr, int wc, int fr, int fq) const {
        const int row0 = u.pm * BM + wr * 64 + fr, col0 = u.pn * BM + wc * 32 + 8 * fq;
#pragma unroll
        for (int ai = 0; ai < 2; ++ai)
#pragma unroll
            for (int m = 0; m < 4; ++m) { bf16_t* rowp = O + (size_t)(row0 + ai * HALF + m * 16) * ldo + col0;
#pragma unroll
                for (int bj = 0; bj < 2; ++bj) { f32x4 v0 = acc[ai][bj][m][0], v1 = acc[ai][bj][m][1];
                    if (ACT == 1) {
#pragma unroll
                        for (int j = 0; j < 4; ++j) { v0[j] = fast_sigmoid(v0[j]); v1[j] = fast_sigmoid(v1[j]); } }
                    u32x4 w; w.x = cvt_pk_bf16(v0[0], v0[1]); w.y = cvt_pk_bf16(v0[2], v0[3]); w.z = cvt_pk_bf16(v1[0], v1[1]); w.w = cvt_pk_bf16(v1[2], v1[3]);
                    *(u32x4*)(rowp + bj * HALF) = w; } }
    }
};
struct EpiMerge {
    static constexpr bool PERM = false, AFTER_DRAIN = false;
    float* P; const bf16_t* G; bf16_t* O; int goff; int mode;
    __device__ __forceinline__ void operator()(const f32x4 (&acc)[2][2][4][2], const Unit& u, int wr, int wc, int fr, int fq) const {
        const int row0 = u.pm * BM + wr * 64 + fr, col0 = u.pn * BM + wc * 32 + 4 * fq;
#pragma unroll
        for (int ai = 0; ai < 2; ++ai)
#pragma unroll
            for (int m = 0; m < 4; ++m) { const size_t r = (size_t)(row0 + ai * HALF + m * 16);
#pragma unroll
                for (int bj = 0; bj < 2; ++bj)
#pragma unroll
                    for (int n = 0; n < 2; ++n) { const int c = col0 + bj * HALF + n * 16;
                        const u32x2 gw = *(const u32x2*)(G + r * 4096 + goff + c);
                        f32x4 g; g[0] = bf_lo(gw.x); g[1] = bf_hi(gw.x); g[2] = bf_lo(gw.y); g[3] = bf_hi(gw.y);
                        f32x4 v = g * acc[ai][bj][m][n];
                        f32x4* pp = (f32x4*)(P + r * 1024 + c);
                        if (mode != 0) v = v + *pp;
                        if (mode != 2) *pp = v;
                        else { u32x2 w; w.x = cvt_pk_bf16(v[0], v[1]); w.y = cvt_pk_bf16(v[2], v[3]); *(u32x2*)(O + r * 1024 + c) = w; } } }
    }
};
template <class Epi, class Sched, bool STAMP = false>
__device__ __forceinline__ void gemm_phase(PG8_LAS unsigned char* lds, const Gemm g, const Sched& S, const Epi& E, unsigned long long* stamps) {
    const int tid = threadIdx.x, wid = __builtin_amdgcn_readfirstlane(tid >> 6), lane = tid & 63, wr = wid >> 2, wc = wid & 3, fr = lane & 15, fq = lane >> 4;
    const int K = g.K, nt = K / BK;
    int ts_lo = 0, ts_hi = 0, nts = 0; const unsigned long long rt_entry = STAMP ? (unsigned long long)wall_clock64() : 0ull;
#define PG8_STAMP() do { if (STAMP && wid == 0 && nts < 64) { const unsigned long long _c = (unsigned long long)clock64(); \
        ts_lo = (lane == nts) ? (int)(unsigned)_c : ts_lo; ts_hi = (lane == nts) ? (int)(unsigned)(_c >> 32) : ts_hi; ++nts; } } while (0)
    PG8_STAMP();
    unsigned voffA[2], voffB[2];
#pragma unroll
    for (int i = 0; i < 2; ++i) { int R, C; stage_rc(tid * 16 + i * 8192, R, C); const int Rb = Epi::PERM ? ((R & ~31) + perm32(R & 31)) : R;
        voffA[i] = (unsigned)(R * K + C) * 2u; voffB[i] = (unsigned)(Rb * K + C) * 2u; }
    const size_t kstep = (size_t)(BK * 2);
    const size_t hstep = (size_t)HALF * K * 2;
    const size_t tstep = 2 * hstep;
    const unsigned ldsw = (unsigned)wid * 1024u;
    const int aoff = lds_byte(wr * 64 + fr, fq * 8), boff = lds_byte(wc * 32 + fr, fq * 8);
#define PG8_SA(b, h) (((b) * 2 + (h)) * HTB)
#define PG8_SB(b, h) ((4 + (b) * 2 + (h)) * HTB)
#define PG8_STAGE(bufoff, gbase, voff) do { _Pragma("unroll") for (int _i = 0; _i < 2; ++_i) \
        __builtin_amdgcn_global_load_lds((const unsigned*)((const char*)(gbase) + (voff)[_i]), (PG8_LAS unsigned*)(lds + (bufoff) + ldsw + _i * 8192), 16, 0, 0); } while (0)
#define PG8_LDA(dst, b, h) do { _Pragma("unroll") for (int m = 0; m < 4; ++m) _Pragma("unroll") for (int k = 0; k < 2; ++k) dst[m][k] = *(const PG8_LAS bf16x8*)(lds + PG8_SA(b, h) + aoff + m * 2048 + k * 1024); } while (0)
#define PG8_LDB(dst, b, h) do { _Pragma("unroll") for (int n = 0; n < 2; ++n) _Pragma("unroll") for (int k = 0; k < 2; ++k) dst[n][k] = *(const PG8_LAS bf16x8*)(lds + PG8_SB(b, h) + boff + n * 2048 + k * 1024); } while (0)
#define PG8_MMA(ai, bj, At, Bt) do { __builtin_amdgcn_s_setprio(1); _Pragma("unroll") for (int m = 0; m < 4; ++m) _Pragma("unroll") for (int n = 0; n < 2; ++n) _Pragma("unroll") for (int k = 0; k < 2; ++k) \
        acc[ai][bj][m][n] = __builtin_amdgcn_mfma_f32_16x16x32_bf16(Bt[n][k], At[m][k], acc[ai][bj][m][n], 0, 0, 0); __builtin_amdgcn_s_setprio(0); } while (0)
#define PG8_WAIT_V(n) asm volatile("s_waitcnt vmcnt(" #n ")" ::: "memory")
#define PG8_WAIT_L(n) asm volatile("s_waitcnt lgkmcnt(" #n ")" ::: "memory")
#define PG8_BAR __builtin_amdgcn_s_barrier()
#define PG8_SCHED __builtin_amdgcn_sched_barrier(0)
    Unit cur, nxt; int ui = 0;
    if (!S.next(0, cur)) return;
    f32x4 acc[2][2][4][2];
#pragma unroll
    for (int a = 0; a < 2; ++a)
#pragma unroll
        for (int b = 0; b < 2; ++b)
#pragma unroll
            for (int m = 0; m < 4; ++m)
#pragma unroll
                for (int n = 0; n < 2; ++n) acc[a][b][m][n] = (f32x4){0.f, 0.f, 0.f, 0.f};
    bf16x8 At[4][2], B0[2][2], B1[2][2];
    const char* cA = (const char*)g.A + (size_t)cur.pm * tstep; const char* cB = (const char*)g.Bt + (size_t)cur.pn * tstep;
    S.a_ready(cur);
    PG8_STAGE(PG8_SB(0, 0), cB, voffB); PG8_STAGE(PG8_SA(0, 0), cA, voffA); PG8_STAGE(PG8_SB(0, 1), cB + hstep, voffB); PG8_STAGE(PG8_SA(0, 1), cA + hstep, voffA);
    if (wr == 1) PG8_BAR;
    PG8_WAIT_V(4); PG8_BAR;
    PG8_STAGE(PG8_SB(1, 0), cB + kstep, voffB); PG8_STAGE(PG8_SA(1, 0), cA + kstep, voffA); PG8_STAGE(PG8_SB(1, 1), cB + hstep + kstep, voffB);
    PG8_WAIT_V(6); PG8_BAR;
    PG8_STAMP();
    for (;;) {
        const bool has_next = S.next(ui + 1, nxt);
        const char* nA = has_next ? (const char*)g.A + (size_t)nxt.pm * tstep : cA; const char* nB = has_next ? (const char*)g.Bt + (size_t)nxt.pn * tstep : cB;
        for (int t = 0; t < nt; t += 2) {
            const bool last = (t == nt - 2);
            const char* a1 = cA + (size_t)(t + 1) * kstep;
            const char* a2 = last ? nA : cA + (size_t)(t + 2) * kstep; const char* b2 = last ? nB : cB + (size_t)(t + 2) * kstep;
            const char* a3 = a2 + kstep; const char* b3 = b2 + kstep;
            if (last && has_next) S.a_ready(nxt);
            PG8_LDB(B0, 0, 0); PG8_SCHED; PG8_LDA(At, 0, 0); PG8_STAGE(PG8_SA(1, 1), a1 + hstep, voffA);
            PG8_WAIT_L(8); PG8_BAR; PG8_WAIT_L(0); PG8_MMA(0, 0, At, B0); PG8_BAR; PG8_SCHED;
            PG8_LDB(B1, 0, 1); PG8_STAGE(PG8_SB(0, 0), b2, voffB);
            PG8_BAR; PG8_WAIT_L(0); PG8_MMA(0, 1, At, B1); PG8_BAR;
            PG8_LDA(At, 0, 1); PG8_STAGE(PG8_SA(0, 0), a2, voffA);
            PG8_BAR; PG8_WAIT_L(0); PG8_MMA(1, 0, At, B0); PG8_BAR; PG8_SCHED;
            PG8_STAGE(PG8_SB(0, 1), b2 + hstep, voffB);
            PG8_WAIT_V(6); PG8_BAR; PG8_MMA(1, 1, At, B1); PG8_BAR;
            PG8_LDB(B0, 1, 0); PG8_SCHED; PG8_LDA(At, 1, 0); PG8_STAGE(PG8_SA(0, 1), a2 + hstep, voffA);
            PG8_WAIT_L(8); PG8_BAR; PG8_WAIT_L(0); PG8_MMA(0, 0, At, B0); PG8_BAR; PG8_SCHED;
            PG8_LDB(B1, 1, 1); PG8_STAGE(PG8_SB(1, 0), b3, voffB);
            PG8_BAR; PG8_WAIT_L(0); PG8_MMA(0, 1, At, B1); PG8_BAR;
            PG8_LDA(At, 1, 1); PG8_STAGE(PG8_SA(1, 0), a3, voffA);
            PG8_BAR; PG8_WAIT_L(0); PG8_MMA(1, 0, At, B0); PG8_BAR; PG8_SCHED;
            PG8_STAGE(PG8_SB(1, 1), b3 + hstep, voffB);
            PG8_WAIT_V(6); PG8_BAR; PG8_MMA(1, 1, At, B1); PG8_BAR;
        }
        PG8_STAMP();
        if constexpr (!Epi::AFTER_DRAIN) { E(acc, cur, wr, wc, fr, fq); S.done(cur); }
        PG8_STAMP();
        if (!has_next) break;
#pragma unroll
        for (int a = 0; a < 2; ++a)
#pragma unroll
            for (int b = 0; b < 2; ++b)
#pragma unroll
                for (int m = 0; m < 4; ++m)
#pragma unroll
                    for (int n = 0; n < 2; ++n) acc[a][b][m][n] = (f32x4){0.f, 0.f, 0.f, 0.f};
        cur = nxt; cA = nA; cB = nB; ++ui;
    }
    PG8_WAIT_V(0);
    if (wr == 0) PG8_BAR;
    PG8_BAR;
    if constexpr (Epi::AFTER_DRAIN) { E.fused(acc, cur, wr, wc, fr, fq, lds, wid, lane); S.done(cur); }
    PG8_STAMP();
    if (STAMP && wid == 0) { stamps[lane] = lane < nts ? (((unsigned long long)(unsigned)ts_hi << 32) | (unsigned)ts_lo) : 0ull;
        if (lane == 62) stamps[62] = rt_entry; if (lane == 63) stamps[63] = (unsigned long long)wall_clock64(); }
#undef PG8_STAMP
#undef PG8_SA
#undef PG8_SB
#undef PG8_STAGE
#undef PG8_LDA
#undef PG8_LDB
#undef PG8_MMA
#undef PG8_WAIT_V
#undef PG8_WAIT_L
#undef PG8_BAR
#undef PG8_SCHED
}
}
#define LAS __attribute__((address_space(3)))
typedef pg8::bf16_t bf16_t;
typedef pg8::f32x4 f32x4;
typedef pg8::u32x4 u32x4;
typedef pg8::u32x2 u32x2;
using pg8::bf_lo; using pg8::bf_hi; using pg8::cvt_pk_bf16;
constexpr int D = 1024, M = 16384, DFF = 2816, NMIX = 5376, NGATE = 4096;
constexpr float EPS = 1e-6f;
constexpr int C_HY = 0, C_DQ = 1536, C_DK = 2048, C_DV = 2560, C_WQ = 3072, C_WK = 3584, C_WV = 3712, C_RQ = 3840, C_RK = 4096, C_RV = 4352, C_RG = 4864;
constexpr size_t O_DK = 16777216, O_DV = 25165824, O_WK = 33554432, O_WV = 35651584, O_RF = 37748736, O_RB = 39845888, O_END = 41943040;
constexpr size_t MiB = 1u << 20;
constexpr size_t WS_CTL = 0, CTL_ZERO_BYTES = 1 * MiB;
constexpr size_t WS_MODP = 1 * MiB, WS_MOD = 7 * MiB, WS_Z2 = 8 * MiB, WS_FILT = 9 * MiB, WS_W = 20 * MiB, WS_H = 78 * MiB, WS_BIG = 110 * MiB, WS_YBR = 302 * MiB, WS_ZB = 366 * MiB, WS_END = 398 * MiB;
constexpr size_t W_FA_IN = 0, W_FA_OUT = 11534336, W_FB_IN = 17301504, W_FB_OUT = 28835840, W_IN = 34603008, W_BR = 54001664, W_OUT = 58195968, W_END = 60293120;
static_assert(WS_W + W_END <= WS_H, "weights fit");
constexpr int LDS_BYTES = 147456;
constexpr int NPHASE = 28;
enum InIdx { I_XP = 0, I_XS, I_C, I_CDK, I_CDV, I_CWK, I_CWV, I_SRF, I_SRB, I_CCTX, I_NFA, I_NMIX, I_NFB, I_WADA, I_BADA, I_WFAI, I_WFAO, I_WFBI, I_WFBO, I_WIN, I_HCW, I_HCB,
             I_HW1, I_HB1, I_HW2, I_HB2, I_HW3, I_HSKIP, I_DQN, I_DKN, I_DLAM, I_DSUB, I_WQN, I_WKN, I_WSINK, I_RDF, I_RDB, I_WBR, I_WOUT, N_IN };
struct Args { const float* in[N_IN]; float* out; unsigned char* ws; int ph_lo, ph_hi; };

#define LDS_WAIT() asm volatile("s_waitcnt lgkmcnt(0)" ::: "memory")
__device__ __forceinline__ float wave_sum(float v) {
#pragma unroll
    for (int o = 1; o < 64; o <<= 1) v += __shfl_xor(v, o);
    return v;
}
__device__ __forceinline__ unsigned f2bf(float f) { unsigned u = __float_as_uint(f); return (u + 0x7fffu + ((u >> 16) & 1u)) >> 16; }
__device__ __forceinline__ unsigned pk2(float lo, float hi) { return cvt_pk_bf16(lo, hi); }
__device__ __forceinline__ float bf2f(bf16_t b) { return __uint_as_float(((unsigned)b) << 16); }

__device__ __forceinline__ void ld64bf(const bf16_t* p, float (&x)[64]) {
    const uint4* q = (const uint4*)p;
#pragma unroll
    for (int i = 0; i < 8; ++i) { const uint4 u = q[i]; x[8 * i + 0] = bf_lo(u.x); x[8 * i + 1] = bf_hi(u.x); x[8 * i + 2] = bf_lo(u.y); x[8 * i + 3] = bf_hi(u.y);
        x[8 * i + 4] = bf_lo(u.z); x[8 * i + 5] = bf_hi(u.z); x[8 * i + 6] = bf_lo(u.w); x[8 * i + 7] = bf_hi(u.w); }
}
__device__ __forceinline__ void st64bf(bf16_t* p, const float (&x)[64]) {
    uint4* q = (uint4*)p;
#pragma unroll
    for (int i = 0; i < 8; ++i) { uint4 u; u.x = pk2(x[8 * i + 0], x[8 * i + 1]); u.y = pk2(x[8 * i + 2], x[8 * i + 3]); u.z = pk2(x[8 * i + 4], x[8 * i + 5]); u.w = pk2(x[8 * i + 6], x[8 * i + 7]); q[i] = u; }
}
__device__ __forceinline__ float dot64bf(const bf16_t* p, const float (&q)[64]) {
    const uint4* r = (const uint4*)p; float s0 = 0.f, s1 = 0.f, s2 = 0.f, s3 = 0.f;
#pragma unroll
    for (int i = 0; i < 8; ++i) { const uint4 u = r[i];
        s0 += bf_lo(u.x) * q[8 * i + 0]; s1 += bf_hi(u.x) * q[8 * i + 1]; s2 += bf_lo(u.y) * q[8 * i + 2]; s3 += bf_hi(u.y) * q[8 * i + 3];
        s0 += bf_lo(u.z) * q[8 * i + 4]; s1 += bf_hi(u.z) * q[8 * i + 5]; s2 += bf_lo(u.w) * q[8 * i + 6]; s3 += bf_hi(u.w) * q[8 * i + 7]; }
    return (s0 + s1) + (s2 + s3);
}
__device__ __forceinline__ float dot64f(const float* p, const float (&q)[64]) {
    const float4* r = (const float4*)p; float s0 = 0.f, s1 = 0.f, s2 = 0.f, s3 = 0.f;
#pragma unroll
    for (int i = 0; i < 16; ++i) { const float4 u = r[i]; s0 += u.x * q[4 * i + 0]; s1 += u.y * q[4 * i + 1]; s2 += u.z * q[4 * i + 2]; s3 += u.w * q[4 * i + 3]; }
    return (s0 + s1) + (s2 + s3);
}
__device__ __forceinline__ void axpy64bf(float a, const bf16_t* p, float (&acc)[64]) {
    const uint4* r = (const uint4*)p;
#pragma unroll
    for (int i = 0; i < 8; ++i) { const uint4 u = r[i];
        acc[8 * i + 0] += a * bf_lo(u.x); acc[8 * i + 1] += a * bf_hi(u.x); acc[8 * i + 2] += a * bf_lo(u.y); acc[8 * i + 3] += a * bf_hi(u.y);
        acc[8 * i + 4] += a * bf_lo(u.z); acc[8 * i + 5] += a * bf_hi(u.z); acc[8 * i + 6] += a * bf_lo(u.w); acc[8 * i + 7] += a * bf_hi(u.w); }
}
__device__ __forceinline__ void axpy64f(float a, const float* p, float (&acc)[64]) {
    const float4* r = (const float4*)p;
#pragma unroll
    for (int i = 0; i < 16; ++i) { const float4 u = r[i]; acc[4 * i + 0] += a * u.x; acc[4 * i + 1] += a * u.y; acc[4 * i + 2] += a * u.z; acc[4 * i + 3] += a * u.w; }
}
#define ONLINE_UPDATE(s, AXPY) do { if ((s) > m) { const float f_ = __expf(m - (s)); lsum *= f_; _Pragma("unroll") for (int i_ = 0; i_ < 64; ++i_) acc[i_] *= f_; m = (s); } \
    const float p_ = __expf((s) - m); lsum += p_; AXPY; } while (0)

__device__ __forceinline__ void transpose_item(const float* W, int K, int N, bf16_t* WT, bool swi, LAS float* scr, int item, int lane) {
    const int nblk = N / 32, kb = item / nblk, nb = item % nblk, k0 = 64 * kb, d0 = 32 * nb;
    int n0 = d0;
    if (swi) { const int tile = d0 >> 8, w = d0 & 255; n0 = (w < 128) ? (tile * 128 + w) : (DFF + tile * 128 + (w - 128)); }
#pragma unroll 8
    for (int i = 0; i < 32; ++i) { const int kk = 2 * i + (lane >> 5); scr[kk * 33 + (lane & 31)] = W[(size_t)(k0 + kk) * N + n0 + (lane & 31)]; }
    LDS_WAIT(); asm volatile("" ::: "memory");
    const int c = lane & 7;
#pragma unroll
    for (int j = 0; j < 4; ++j) { const int n = (lane >> 3) + 8 * j; const LAS float* s = scr + (8 * c) * 33 + n;
        uint4 o; o.x = pk2(s[0 * 33], s[1 * 33]); o.y = pk2(s[2 * 33], s[3 * 33]); o.z = pk2(s[4 * 33], s[5 * 33]); o.w = pk2(s[6 * 33], s[7 * 33]);
        *(uint4*)(WT + (size_t)(d0 + n) * K + k0 + 8 * c) = o; }
    LDS_WAIT(); asm volatile("" ::: "memory");
}
__device__ __forceinline__ void convert_weights(const Args& a, int l, LAS unsigned char* lds, int gw, int NGW, int wave, int lane) {
    LAS float* scr = (LAS float*)(lds + wave * 16384);
    bf16_t* wb = (bf16_t*)(a.ws + WS_W);
    constexpr int I0 = 16 * 176, I1 = 44 * 32, I4 = 16 * 296, I5 = 8 * 32, I9 = 16 * 32;
    constexpr int NITEMS = 2 * I0 + 2 * I1 + I4 + 4 * I5 + I9;
    for (int it = gw; it < NITEMS; it += NGW) {
        int r = it;
        if (r < I0) { transpose_item(a.in[I_WFAI] + (size_t)l * D * 2 * DFF, D, 2 * DFF, (bf16_t*)((unsigned char*)wb + W_FA_IN), true, scr, r, lane); continue; } r -= I0;
        if (r < I1) { transpose_item(a.in[I_WFAO] + (size_t)l * DFF * D, DFF, D, (bf16_t*)((unsigned char*)wb + W_FA_OUT), false, scr, r, lane); continue; } r -= I1;
        if (r < I0) { transpose_item(a.in[I_WFBI] + (size_t)l * D * 2 * DFF, D, 2 * DFF, (bf16_t*)((unsigned char*)wb + W_FB_IN), true, scr, r, lane); continue; } r -= I0;
        if (r < I1) { transpose_item(a.in[I_WFBO] + (size_t)l * DFF * D, DFF, D, (bf16_t*)((unsigned char*)wb + W_FB_OUT), false, scr, r, lane); continue; } r -= I1;
        if (r < I4) { transpose_item(a.in[I_WIN] + (size_t)l * D * 9472, D, 9472, (bf16_t*)((unsigned char*)wb + W_IN), false, scr, r, lane); continue; } r -= I4;
        if (r < 4 * I5) { const int b = r / I5; transpose_item(a.in[I_WBR] + ((size_t)l * 4 + b) * 512 * D, 512, D, (bf16_t*)((unsigned char*)wb + W_BR) + (size_t)b * D * 512, false, scr, r % I5, lane); continue; } r -= 4 * I5;
        transpose_item(a.in[I_WOUT] + (size_t)l * D * D, D, D, (bf16_t*)((unsigned char*)wb + W_OUT), false, scr, r, lane);
    }
}
__device__ __forceinline__ void phase_p0a(const Args& a, LAS unsigned char* lds, int bid, int nblk, int tid) {
    const int lane = tid & 63, wave = tid >> 6, gtid = bid * 512 + tid, NT = nblk * 512;
    { const float4* s0 = (const float4*)a.in[I_XP]; const float4* s1 = (const float4*)a.in[I_XS]; float4* o = (float4*)a.out;
      for (int i = gtid; i < 4194304; i += NT) o[i] = i < 2097152 ? s0[i] : s1[i - 2097152]; }
    { LAS float* sc = (LAS float*)lds;
      for (int i = tid; i < 9216; i += 512) { const int r = i >> 10, k = i & 1023; const float v = r == 0 ? a.in[I_CCTX][k] : a.in[I_C][(r - 1) * 1024 + k]; sc[i] = v / (1.0f + expf(-v)); }
      __syncthreads();
      float* modp = (float*)(a.ws + WS_MODP);
      for (int idx = gtid; idx < 2 * 8 * 9216; idx += NT) { const int n = idx % 9216, kc = (idx / 9216) % 8, l = idx / (9216 * 8);
          const float* w = a.in[I_WADA] + ((size_t)l * 1024 + kc * 128) * 9216 + n; float acc[9];
#pragma unroll
          for (int r = 0; r < 9; ++r) acc[r] = 0.f;
          for (int k = 0; k < 128; ++k) { const float wv = w[(size_t)k * 9216];
#pragma unroll
              for (int r = 0; r < 9; ++r) acc[r] += sc[r * 1024 + kc * 128 + k] * wv; }
#pragma unroll
          for (int r = 0; r < 9; ++r) modp[((size_t)(l * 8 + kc) * 9 + r) * 9216 + n] = acc[r]; }
      __syncthreads(); }
    { LAS float* fe = (LAS float*)lds; LAS float* z1 = fe + 8 * 33; float* z2g = (float*)(a.ws + WS_Z2);
      for (int it = bid; it < 320; it += nblk) { const int l = it / 160, tg = it % 160, tt = tid >> 6, j = tid & 63, tglob = tg * 8 + tt;
          const int L = tglob < 256 ? 256 : 1024, tpos = tglob < 256 ? tglob : tglob - 256; const float tf = (float)tpos / (float)L;
          if (j < 33) { float v; if (j == 0) v = tf; else if (j <= 16) v = sinf((6.2831853071795864769f * tf) * (float)j); else v = cosf((6.2831853071795864769f * tf) * (float)(j - 16)); fe[tt * 33 + j] = v; }
          __syncthreads();
          float s = a.in[I_HB1][l * 64 + j];
          for (int i = 0; i < 33; ++i) s += fe[tt * 33 + i] * a.in[I_HW1][(l * 33 + i) * 64 + j];
          z1[tt * 64 + j] = sinf(s);
          __syncthreads();
          float s2 = a.in[I_HB2][l * 64 + j];
          for (int i = 0; i < 64; ++i) s2 += z1[tt * 64 + i] * a.in[I_HW2][(l * 64 + i) * 64 + j];
          z2g[((size_t)l * 1280 + tglob) * 64 + j] = sinf(s2);
          __syncthreads(); } }
    convert_weights(a, 0, lds, bid * 8 + wave, nblk * 8, wave, lane);
}
__device__ __forceinline__ void phase_p0b(const Args& a, LAS unsigned char* lds, int bid, int nblk, int tid) {
    const int gtid = bid * 512 + tid, NT = nblk * 512;
    { const float* modp = (const float*)(a.ws + WS_MODP); float* mod = (float*)(a.ws + WS_MOD);
      for (int idx = gtid; idx < 2 * 9 * 9216; idx += NT) { const int n = idx % 9216, r = (idx / 9216) % 9, l = idx / (9216 * 9); float s = a.in[I_BADA][l * 9216 + n];
#pragma unroll
          for (int kc = 0; kc < 8; ++kc) s += modp[((size_t)(l * 8 + kc) * 9 + r) * 9216 + n];
          mod[idx] = s; } }
    { LAS float* red = (LAS float*)lds; const float* z2g = (const float*)(a.ws + WS_Z2); float* filt = (float*)(a.ws + WS_FILT);
      const float dmin = logf(0.01f) / 1.5f, dmax = logf(0.01f) / 0.3f;
      for (int it = bid; it < 128; it += nblk) { const int l = it >> 6, ls = (it >> 5) & 1, cg = it & 31, ci = tid & 15, tl = tid >> 4, c = cg * 16 + ci;
          const int L = ls ? 1024 : 256, toff = ls ? 256 : 0; float* G = filt + (size_t)l * (2560 * 512) + (ls ? 512 * 512 : 0);
          const float ad = fabsf(dmin + (dmax - dmin) * ((float)c / 511.0f)); const float* w3 = a.in[I_HW3] + (size_t)l * 64 * 1024;
          float asum = 0.f;
          for (int t = tl; t < L; t += 32) { const float* zp = z2g + ((size_t)l * 1280 + toff + t) * 64; float zf = 0.f, zb = 0.f;
              for (int j = 0; j < 64; ++j) { const float z = zp[j]; zf += z * w3[j * 1024 + c]; zb += z * w3[j * 1024 + 512 + c]; }
              const float win = expf(-((float)t / (float)L) * ad); const float hf = zf * win, hb = zb * win; asum += fabsf(hf) + fabsf(hb);
              G[(size_t)(L - 1 + t) * 512 + c] = hf; if (t >= 1) G[(size_t)(L - 1 - t) * 512 + c] = hb; }
          red[tl * 16 + ci] = asum; __syncthreads();
          float tot = 0.f;
          for (int i = 0; i < 32; ++i) tot += red[i * 16 + ci];
          const float inv = 1.0f / tot;
          for (int t = tl; t < L; t += 32) { G[(size_t)(L - 1 + t) * 512 + c] *= inv; if (t >= 1) G[(size_t)(L - 1 - t) * 512 + c] *= inv; }
          __syncthreads(); } }
}
__device__ __forceinline__ void phase_norm(const Args& a, int l, int gidx  , int sidx  , int bid, int nblk, int tid) {
    const int lane = tid & 63, gw = bid * 8 + (tid >> 6), NGW = nblk * 8;
    const float* gain = a.in[gidx] + l * 1024; const float* modl = (const float*)(a.ws + WS_MOD) + (size_t)l * 9 * 9216; bf16_t* H = (bf16_t*)(a.ws + WS_H);
    for (int row = gw; row < M; row += NGW) { const int r = row < 8192 ? 0 : 1 + ((row - 8192) >> 10);
        const f32x4* xr = (const f32x4*)(a.out + (size_t)row * 1024) + lane; f32x4 v[4]; float ss = 0.f;
#pragma unroll
        for (int j = 0; j < 4; ++j) { v[j] = xr[64 * j]; ss += (v[j].x * v[j].x + v[j].y * v[j].y) + (v[j].z * v[j].z + v[j].w * v[j].w); }
        const float rstd = 1.0f / sqrtf(wave_sum(ss) * (1.0f / 1024.0f) + EPS);
#pragma unroll
        for (int j = 0; j < 4; ++j) { const int col = 4 * lane + 256 * j; const f32x4 g = *(const f32x4*)(gain + col), sh = *(const f32x4*)(modl + (size_t)r * 9216 + sidx * 1024 + col), sc = *(const f32x4*)(modl + (size_t)r * 9216 + (sidx + 1) * 1024 + col);
            const f32x4 y = (v[j] * rstd) * g; const f32x4 h = y * (sc + 1.0f) + sh;
            u32x2 w; w.x = pk2(h.x, h.y); w.y = pk2(h.z, h.w); *(u32x2*)(H + (size_t)row * 1024 + col) = w; } }
}
__device__ __forceinline__ void phase_prep(const Args& a, int l, int bid, int nblk, int tid) {
    const int gtid = bid * 512 + tid, NT = nblk * 512; bf16_t* cols = (bf16_t*)(a.ws + WS_BIG);
    for (int idx = gtid; idx < M * 36; idx += NT) { const int row = idx / 36, vt = idx % 36; const bool lat = row >= 8192; bf16_t* cr = cols + (size_t)row * NMIX;
        const int bc = row >> 8, tc = row & 255;
        if (vt < 26) { int col; const float* gn; float* so = nullptr;
            if (vt < 8) { col = C_DQ + 64 * vt; gn = a.in[I_DQN] + l * 64; }
            else if (vt < 16) { col = C_DK + 64 * (vt - 8); gn = a.in[I_DKN] + l * 64; if (!lat) so = a.out + O_DK + ((((size_t)bc * 2 + l) * 256 + tc) * 8 + (vt - 8)) * 64; }
            else if (vt < 24) { col = C_WQ + 64 * (vt - 16); gn = a.in[I_WQN] + l * 64; }
            else { col = C_WK + 64 * (vt - 24); gn = a.in[I_WKN] + l * 64; if (!lat) so = a.out + O_WK + ((((size_t)bc * 2 + l) * 256 + tc) * 2 + (vt - 24)) * 64; }
            float x[64]; ld64bf(cr + col, x); float ss = 0.f;
#pragma unroll
            for (int i = 0; i < 64; ++i) ss += x[i] * x[i];
            const float rs = 1.0f / sqrtf(ss * (1.0f / 64.0f) + EPS);
#pragma unroll
            for (int i = 0; i < 64; ++i) x[i] = x[i] * rs * gn[i];
            if (so) {
#pragma unroll
                for (int i = 0; i < 16; ++i) ((float4*)so)[i] = make_float4(x[4 * i], x[4 * i + 1], x[4 * i + 2], x[4 * i + 3]); }
            if (lat) { const int t = (row - 8192) & 1023; const float prow = (float)(t >> 6), pcol = (float)(t & 63);
#pragma unroll
                for (int hf = 0; hf < 2; ++hf) { const float pos = hf ? pcol : prow;
#pragma unroll
                    for (int i = 0; i < 16; ++i) { const float invf = exp2f(-(float)i * (13.287712379549449f / 16.0f)); float sn, cs; sincosf(pos * invf, &sn, &cs);
                        const float x1 = x[hf * 32 + i], x2 = x[hf * 32 + 16 + i]; x[hf * 32 + i] = x1 * cs - x2 * sn; x[hf * 32 + 16 + i] = x1 * sn + x2 * cs; } } }
            st64bf(cr + col, x);
        } else if (!lat) { const int v = vt < 34 ? vt - 26 : vt - 34; const bf16_t* src = cr + (vt < 34 ? C_DV : C_WV) + 64 * v;
            float* dst = vt < 34 ? a.out + O_DV + (((size_t)bc * 2 + l) * 256 + tc) * 512 + 64 * v : a.out + O_WV + (((size_t)bc * 2 + l) * 256 + tc) * 128 + 64 * v;
            float x[64]; ld64bf(src, x);
#pragma unroll
            for (int i = 0; i < 16; ++i) ((float4*)dst)[i] = make_float4(x[4 * i], x[4 * i + 1], x[4 * i + 2], x[4 * i + 3]); }
    }
    { const float* cw = a.in[I_HCW] + l * 3 * 1536; const float* cb = a.in[I_HCB] + l * 1536; float* ZB = (float*)(a.ws + WS_ZB);
      for (int idx = gtid; idx < M * 512; idx += NT) { const int row = idx >> 9, c = idx & 511; const bool lat = row >= 8192; const int t = lat ? ((row - 8192) & 1023) : (row & 255), L = lat ? 1024 : 256;
          const bf16_t* p = cols + (size_t)row * NMIX; const bool hm = t > 0, hp = t < L - 1;
          const float vm = hm ? bf2f(p[c - NMIX]) : 0.f, v0 = bf2f(p[c]), vp = hp ? bf2f(p[c + NMIX]) : 0.f;
          const float xm = hm ? bf2f(p[1024 + c - NMIX]) : 0.f, x0 = bf2f(p[1024 + c]), xp = hp ? bf2f(p[1024 + c + NMIX]) : 0.f;
          const float v = vm * cw[c] + v0 * cw[1536 + c] + vp * cw[3072 + c] + cb[c];
          const float x1 = xm * cw[1024 + c] + x0 * cw[1536 + 1024 + c] + xp * cw[3072 + 1024 + c] + cb[1024 + c];
          ZB[idx] = v * x1; } }
}
__device__ __forceinline__ void diff_item(const Args& a, int l, int grp, int h, int qb, int lane) {
    const bf16_t* cols = (const bf16_t*)(a.ws + WS_BIG); bf16_t* yo = (bf16_t*)(a.ws + WS_YBR) + (size_t)1 * M * 512;
    const bool lat = grp >= 32; const int b = lat ? grp - 32 : grp, L = lat ? 1024 : 256, rb = lat ? 8192 + b * 1024 : b * 256;
    const int qi = lane >> 2, eq = lane & 3, t = qb * 16 + qi, row = rb + t;
    const float* dl = a.in[I_DLAM] + l * 256; float s01 = 0.f, s23 = 0.f;
    for (int i = 0; i < 64; ++i) { s01 += dl[i] * dl[64 + i]; s23 += dl[128 + i] * dl[192 + i]; }
    const float lam_init = 0.8f - 0.6f * expf(-0.3f * (float)l), lam = expf(s01) - expf(s23) + lam_init;
    float out[32];
#pragma unroll 1
    for (int c = 0; c < 2; ++c) {
        float q[64]; ld64bf(cols + (size_t)row * NMIX + C_DQ + (h * 2 + c) * 64, q);
        float acc[32];
#pragma unroll
        for (int i = 0; i < 32; ++i) acc[i] = 0.f;
        float m = -1e30f, lsum = 0.f;
#pragma unroll 1
        for (int j = 0; j < L; ++j) { const bf16_t* kr = cols + (size_t)(rb + j) * NMIX; const float s = dot64bf(kr + C_DK + (h * 2 + c) * 64, q) * 0.125f;
            if (s > m) { const float f_ = __expf(m - s); lsum *= f_;
#pragma unroll
                for (int i = 0; i < 32; ++i) acc[i] *= f_;
                m = s; }
            const float p_ = __expf(s - m); lsum += p_;
            const uint4* r = (const uint4*)(kr + C_DV + h * 128 + eq * 32);
#pragma unroll
            for (int i = 0; i < 4; ++i) { const uint4 u = r[i];
                acc[8 * i + 0] += p_ * bf_lo(u.x); acc[8 * i + 1] += p_ * bf_hi(u.x); acc[8 * i + 2] += p_ * bf_lo(u.y); acc[8 * i + 3] += p_ * bf_hi(u.y);
                acc[8 * i + 4] += p_ * bf_lo(u.z); acc[8 * i + 5] += p_ * bf_hi(u.z); acc[8 * i + 6] += p_ * bf_lo(u.w); acc[8 * i + 7] += p_ * bf_hi(u.w); } }
        if (lat) {
#pragma unroll 1
            for (int j = 0; j < 512; ++j) { const float* kp = a.in[I_CDK] + (((((size_t)b * 2 + l) * 512 + j) * 4 + h) * 2 + c) * 64; const float4* vp = (const float4*)(a.in[I_CDV] + ((((size_t)b * 2 + l) * 512 + j) * 4 + h) * 128 + eq * 32);
                const float s = dot64f(kp, q) * 0.125f;
                if (s > m) { const float f_ = __expf(m - s); lsum *= f_;
#pragma unroll
                    for (int i = 0; i < 32; ++i) acc[i] *= f_;
                    m = s; }
                const float p_ = __expf(s - m); lsum += p_;
#pragma unroll
                for (int i = 0; i < 8; ++i) { const float4 u = vp[i]; acc[4 * i + 0] += p_ * u.x; acc[4 * i + 1] += p_ * u.y; acc[4 * i + 2] += p_ * u.z; acc[4 * i + 3] += p_ * u.w; } } }
        const float inv = 1.0f / lsum;
        if (c == 0) {
#pragma unroll
            for (int i = 0; i < 32; ++i) out[i] = acc[i] * inv; }
        else {
#pragma unroll
            for (int i = 0; i < 32; ++i) out[i] -= lam * (acc[i] * inv); }
    }
    float ss = 0.f;
#pragma unroll
    for (int i = 0; i < 32; ++i) ss += out[i] * out[i];
    ss += __shfl_xor(ss, 1); ss += __shfl_xor(ss, 2);
    const float rs = (1.0f / sqrtf(ss * (1.0f / 128.0f) + EPS)) * (1.0f - lam_init); const float* sg = a.in[I_DSUB] + l * 128 + eq * 32;
    uint4* dst = (uint4*)(yo + (size_t)row * 512 + h * 128 + eq * 32);
#pragma unroll
    for (int i = 0; i < 4; ++i) { uint4 u; u.x = pk2(out[8 * i + 0] * rs * sg[8 * i + 0], out[8 * i + 1] * rs * sg[8 * i + 1]); u.y = pk2(out[8 * i + 2] * rs * sg[8 * i + 2], out[8 * i + 3] * rs * sg[8 * i + 3]);
        u.z = pk2(out[8 * i + 4] * rs * sg[8 * i + 4], out[8 * i + 5] * rs * sg[8 * i + 5]); u.w = pk2(out[8 * i + 6] * rs * sg[8 * i + 6], out[8 * i + 7] * rs * sg[8 * i + 7]); dst[i] = u; }
}
__device__ __forceinline__ void win_item(const Args& a, int l, int grp, int hq, int qb, int lane) {
    const bf16_t* cols = (const bf16_t*)(a.ws + WS_BIG); bf16_t* yo = (bf16_t*)(a.ws + WS_YBR) + (size_t)2 * M * 512;
    const bool lat = grp >= 32; const int b = lat ? grp - 32 : grp, L = lat ? 1024 : 256, rb = lat ? 8192 + b * 1024 : b * 256;
    const int t = qb * 64 + lane, row = rb + t, hkv = hq >> 2;
    float q[64]; ld64bf(cols + (size_t)row * NMIX + C_WQ + hq * 64, q);
    float acc[64];
#pragma unroll
    for (int i = 0; i < 64; ++i) acc[i] = 0.f;
    float m = a.in[I_WSINK][l * 8 + hq], lsum = 1.0f;
    const int jlo = lat ? max(0, qb * 64 - 128) : 0, jhi = lat ? min(L - 1, qb * 64 + 63 + 128) : L - 1;
    for (int j = jlo; j <= jhi; ++j) { const bf16_t* kr = cols + (size_t)(rb + j) * NMIX; const float s = dot64bf(kr + C_WK + hkv * 64, q) * 0.125f;
        const int dd = t - j; const bool ok = !lat || (dd <= 128 && dd >= -128);
        if (ok) { ONLINE_UPDATE(s, axpy64bf(p_, kr + C_WV + hkv * 64, acc)); } }
    if (lat) for (int j = 0; j < 512; ++j) { const size_t o = ((((size_t)b * 2 + l) * 512 + j) * 2 + hkv) * 64; const float s = dot64f(a.in[I_CWK] + o, q) * 0.125f; ONLINE_UPDATE(s, axpy64f(p_, a.in[I_CWV] + o, acc)); }
    const float inv = 1.0f / lsum;
#pragma unroll
    for (int i = 0; i < 64; ++i) acc[i] *= inv;
    st64bf(yo + (size_t)row * 512 + hq * 64, acc);
}
__device__ __forceinline__ void ret_item(const Args& a, int l, int grp, int h, int qb, int lane, LAS float* qs  ) {
    const bf16_t* cols = (const bf16_t*)(a.ws + WS_BIG); bf16_t* yo = (bf16_t*)(a.ws + WS_YBR) + (size_t)3 * M * 512;
    const bool lat = grp >= 32; const int b = lat ? grp - 32 : grp, L = lat ? 1024 : 256, rb = lat ? 8192 + b * 1024 : b * 256;
    const int qi = lane >> 1, eh = lane & 1, t = qb * 32 + qi, row = rb + t;
    const float lgf = -log1pf(expf(-a.in[I_RDF][l * 4 + h])), lgb = -log1pf(expf(-a.in[I_RDB][l * 4 + h]));
    float q[64]; ld64bf(cols + (size_t)row * NMIX + C_RQ + h * 64, q);
    float acc[64];
#pragma unroll
    for (int i = 0; i < 64; ++i) acc[i] = 0.f;
    for (int s = 0; s < L; ++s) { const bf16_t* kr = cols + (size_t)(rb + s) * NMIX; const int d = t - s;
        const float w = (d >= 0 ? __expf((float)d * lgf) : 0.f) + (d <= 0 ? __expf((float)(-d) * lgb) : 0.f);
        const float dt = dot64bf(kr + C_RK + h * 64, q) * 0.125f; axpy64bf(w * dt, kr + C_RV + h * 128 + eh * 64, acc); }
    if (lat) { const float* Sf = a.in[I_SRF] + ((((size_t)b * 2 + l) * 4 + h) * 64) * 128 + eh * 64; const float* Sb = a.in[I_SRB] + ((((size_t)b * 2 + l) * 4 + h) * 64) * 128 + eh * 64;
        const float wf = expf((float)(t + 1) * lgf), wb = expf((float)(L - t) * lgb);
#pragma unroll
        for (int i = 0; i < 64; ++i) qs[lane * 65 + i] = q[i];
        LDS_WAIT(); asm volatile("" ::: "memory");
#pragma unroll 1
        for (int d = 0; d < 64; ++d) { const float qd = qs[lane * 65 + d]; const float qf = qd * wf, qb2 = qd * wb; axpy64f(qf, Sf + (size_t)d * 128, acc); axpy64f(qb2, Sb + (size_t)d * 128, acc); }
        LDS_WAIT(); asm volatile("" ::: "memory"); }
    float ss = 0.f;
#pragma unroll
    for (int i = 0; i < 64; ++i) ss += acc[i] * acc[i];
    ss += __shfl_xor(ss, 1);
    const float rs = 1.0f / sqrtf(ss * (1.0f / 128.0f) + EPS);
    float g[64]; ld64bf(cols + (size_t)row * NMIX + C_RG + h * 128 + eh * 64, g);
#pragma unroll
    for (int i = 0; i < 64; ++i) { const float gv = g[i]; acc[i] = acc[i] * rs * (gv / (1.0f + __expf(-gv))); }
    st64bf(yo + (size_t)row * 512 + h * 128 + eh * 64, acc);
}
__device__ __forceinline__ void retstate_thread(const Args& a, int l, int idx) {
    const bf16_t* cols = (const bf16_t*)(a.ws + WS_BIG);
    const int e = idx & 127, d = (idx >> 7) & 63, h = (idx >> 13) & 3, b = idx >> 15;
    const float lgf = -log1pf(expf(-a.in[I_RDF][l * 4 + h])), lgb = -log1pf(expf(-a.in[I_RDB][l * 4 + h]));
    float sf = 0.f, sb = 0.f;
    for (int s = 0; s < 256; ++s) { const bf16_t* kr = cols + (size_t)(b * 256 + s) * NMIX; const float kv = bf2f(kr[C_RK + h * 64 + d]) * 0.125f * bf2f(kr[C_RV + h * 128 + e]);
        sf += __expf((float)(255 - s) * lgf) * kv; sb += __expf((float)s * lgb) * kv; }
    const size_t o = ((((size_t)b * 2 + l) * 4 + h) * 64 + d) * 128 + e;
    a.out[O_RF + o] = sf; a.out[O_RB + o] = sb;
}
__device__ __forceinline__ void hy2_thread(const Args& a, int l, int idx) {
    const bf16_t* cols = (const bf16_t*)(a.ws + WS_BIG); bf16_t* yo = (bf16_t*)(a.ws + WS_YBR);
    const bool lat = idx >= 524288; const int i2 = lat ? idx - 524288 : idx, c = i2 & 511, L = lat ? 1024 : 256, ng = L >> 3, tg = (i2 >> 9) % ng, b = (i2 >> 9) / ng;
    const int rb = lat ? 8192 + b * 1024 : b * 256, t0 = tg * 8;
    const float* G = (const float*)(a.ws + WS_FILT) + (size_t)l * (2560 * 512) + (lat ? 512 * 512 : 0) + c;
    const float* Z = (const float*)(a.ws + WS_ZB) + (size_t)rb * 512 + c;
    float w[8], acc[8];
#pragma unroll
    for (int i = 0; i < 8; ++i) { acc[i] = 0.f; w[i] = G[(size_t)(t0 + i + L - 1) * 512]; }
#pragma unroll 8
    for (int s = 0; s < L; ++s) { const float z = Z[(size_t)s * 512];
#pragma unroll
        for (int i = 0; i < 8; ++i) acc[i] += w[i] * z;
#pragma unroll
        for (int i = 7; i >= 1; --i) w[i] = w[i - 1];
        const int jn = t0 - (s + 1) + L - 1; w[0] = G[(size_t)(jn < 0 ? 0 : jn) * 512]; }
    const float* cw = a.in[I_HCW] + l * 3 * 1536; const float cb = a.in[I_HCB][l * 1536 + 512 + c], sk = a.in[I_HSKIP][l * 512 + c];
    const float w0 = cw[512 + c], w1 = cw[1536 + 512 + c], w2 = cw[3072 + 512 + c];
#pragma unroll
    for (int i = 0; i < 8; ++i) { const int t = t0 + i; const bf16_t* p = cols + (size_t)(rb + t) * NMIX + 512 + c;
        const float xm = t > 0 ? bf2f(p[-NMIX]) : 0.f, x0 = bf2f(p[0]), xp = t < L - 1 ? bf2f(p[NMIX]) : 0.f;
        const float x0c = xm * w0 + x0 * w1 + xp * w2 + cb; const float y = acc[i] + sk * Z[(size_t)t * 512];
        yo[(size_t)(rb + t) * 512 + c] = (bf16_t)f2bf(x0c * y); }
}
__device__ __forceinline__ void phase_mix(const Args& a, int l, LAS unsigned char* lds, int bid, int nblk, int tid) {
    const int lane = tid & 63, wave = tid >> 6, gw = bid * 8 + wave, NGW = nblk * 8;
    LAS float* qs = (LAS float*)(lds + wave * 16640);
    constexpr int N_ATT = 1024, N_DIFF = 2048, N_HY = 16384, N_RS = 16384;
    constexpr int NIT = 2 * N_DIFF + 4 * N_ATT + N_HY + N_RS;
#pragma unroll 1
    for (int it = gw; it < NIT; it += NGW) { int r = it;
        if (r < N_DIFF) { diff_item(a, l, 32 + (r >> 8), (r >> 6) & 3, r & 63, lane); continue; } r -= N_DIFF;
        if (r < N_ATT) { ret_item(a, l, 32 + (r >> 7), (r >> 5) & 3, r & 31, lane, qs); continue; } r -= N_ATT;
        if (r < N_ATT) { win_item(a, l, 32 + (r >> 7), (r >> 4) & 7, r & 15, lane); continue; } r -= N_ATT;
        if (r < N_HY) { hy2_thread(a, l, r * 64 + lane); continue; } r -= N_HY;
        if (r < N_DIFF) { diff_item(a, l, r >> 6, (r >> 4) & 3, r & 15, lane); continue; } r -= N_DIFF;
        if (r < N_ATT) { ret_item(a, l, r >> 5, (r >> 3) & 3, r & 7, lane, qs); continue; } r -= N_ATT;
        if (r < N_ATT) { win_item(a, l, r >> 5, (r >> 2) & 7, r & 3, lane); continue; } r -= N_ATT;
        retstate_thread(a, l, r * 64 + lane); }
}
template <class Epi> __device__ __forceinline__ void run_gemm(LAS unsigned char* lds, const bf16_t* A, const bf16_t* Bt, int N, int K, const Epi& E, int bid, int nblk) {
    pg8::Gemm g{A, Bt, M, N, K}; pg8::StaticOrder S; S.init(M, N, nblk, bid);
    pg8::gemm_phase<Epi, pg8::StaticOrder, false>(lds, g, S, E, nullptr);
}
template <int SL> __device__ __forceinline__ void run_slot(const Args& a, int l, LAS unsigned char* lds, int bid, int nblk, int tid) {
    unsigned char* ws = a.ws; unsigned char* wb = ws + WS_W;
    bf16_t* H = (bf16_t*)(ws + WS_H); bf16_t* BIG = (bf16_t*)(ws + WS_BIG); bf16_t* YBR = (bf16_t*)(ws + WS_YBR);
    float* MERGEP = (float*)(ws + WS_BIG + 128 * MiB);
    const float* modl = (const float*)(ws + WS_MOD) + (size_t)l * 9 * 9216;
    if constexpr (SL == 0) phase_p0a(a, lds, bid, nblk, tid);
    if constexpr (SL == 1) phase_p0b(a, lds, bid, nblk, tid);
    if constexpr (SL == 2) { if (l == 1) convert_weights(a, 1, lds, bid * 8 + (tid >> 6), nblk * 8, tid >> 6, tid & 63); phase_norm(a, l, I_NFA, 0, bid, nblk, tid); }
    if constexpr (SL == 3) run_gemm(lds, H, (const bf16_t*)(wb + W_FA_IN), 2 * DFF, D, pg8::EpiSwiGLU{BIG, DFF}, bid, nblk);
    if constexpr (SL == 4) run_gemm(lds, BIG, (const bf16_t*)(wb + W_FA_OUT), D, DFF, pg8::EpiResid{a.out, modl + 2 * 1024, 0.5f}, bid, nblk);
    if constexpr (SL == 5) phase_norm(a, l, I_NMIX, 3, bid, nblk, tid);
    if constexpr (SL == 6) run_gemm(lds, H, (const bf16_t*)(wb + W_IN), NMIX, D, pg8::EpiStore<0>{BIG, NMIX}, bid, nblk);
    if constexpr (SL == 7) phase_prep(a, l, bid, nblk, tid);
    if constexpr (SL == 8) phase_mix(a, l, lds, bid, nblk, tid);
    if constexpr (SL == 9) run_gemm(lds, H, (const bf16_t*)(wb + W_IN) + (size_t)NMIX * D, NGATE, D, pg8::EpiStore<1>{BIG, NGATE}, bid, nblk);
    if constexpr (SL == 10) {
#pragma unroll 1
        for (int b = 0; b < 4; ++b) run_gemm(lds, YBR + (size_t)b * M * 512, (const bf16_t*)(wb + W_BR) + (size_t)b * D * 512, D, 512, pg8::EpiMerge{MERGEP, BIG, H, b * 1024, b == 0 ? 0 : (b == 3 ? 2 : 1)}, bid, nblk); }
    if constexpr (SL == 11) run_gemm(lds, H, (const bf16_t*)(wb + W_OUT), D, D, pg8::EpiResid{a.out, modl + 5 * 1024, 1.0f}, bid, nblk);
    if constexpr (SL == 12) phase_norm(a, l, I_NFB, 6, bid, nblk, tid);
    if constexpr (SL == 13) run_gemm(lds, H, (const bf16_t*)(wb + W_FB_IN), 2 * DFF, D, pg8::EpiSwiGLU{BIG, DFF}, bid, nblk);
    if constexpr (SL == 14) run_gemm(lds, BIG, (const bf16_t*)(wb + W_FB_OUT), D, DFF, pg8::EpiResid{a.out, modl + 8 * 1024, 0.5f}, bid, nblk);
}
template <int SL> __global__ void __launch_bounds__(512, 2) k_slot(Args a) {
    extern __shared__ __attribute__((aligned(16))) unsigned char lds_raw[];
    run_slot<SL>(a, a.ph_lo, (LAS unsigned char*)lds_raw, blockIdx.x, gridDim.x, threadIdx.x);
}
template <int SL> static void launch_slot(const Args& a, int grid, hipStream_t stream) {
    static bool attr = false;
    if (!attr) { (void)hipFuncSetAttribute((const void*)k_slot<SL>, hipFuncAttributeMaxDynamicSharedMemorySize, LDS_BYTES); attr = true; }
    hipLaunchKernelGGL(k_slot<SL>, dim3(grid), dim3(512), LDS_BYTES, stream, a);
}

#ifdef DIAG_YBR
__global__ void k_diag(Args a) {
    for (size_t i = (size_t)blockIdx.x * blockDim.x + threadIdx.x; i < (size_t)M * 1024; i += (size_t)gridDim.x * blockDim.x) { const size_t row = i >> 10, c = i & 1023;
#if DIAG_YBR < 4
        const bf16_t* y = (const bf16_t*)(a.ws + WS_YBR) + (size_t)DIAG_YBR * M * 512;
        a.out[i] = bf2f(y[(c >> 9) * (size_t)M * 512 + row * 512 + (c & 511)]);
#elif DIAG_YBR == 4
        a.out[i] = bf2f(((const bf16_t*)(a.ws + WS_H))[i]);
#elif DIAG_YBR >= 5 && DIAG_YBR < 9
        a.out[i] = bf2f(((const bf16_t*)(a.ws + WS_BIG))[row * 4096 + (DIAG_YBR - 5) * 1024 + c]);
#elif DIAG_YBR == 9
        a.out[i] = ((const float*)(a.ws + WS_BIG + 128 * MiB))[i];
#elif DIAG_YBR >= 10 && DIAG_YBR < 15
        a.out[i] = bf2f(((const bf16_t*)(a.ws + WS_BIG))[row * 5376 + (DIAG_YBR - 10) * 1024 + c]);
#elif DIAG_YBR >= 15 && DIAG_YBR < 17
        a.out[i] = bf2f(((const bf16_t*)(a.ws + WS_BIG))[row * 2816 + (DIAG_YBR - 15) * 1024 + c]);
#endif
    }
}
#endif
extern "C" void kernel_launch(void* const* d_in, const int* in_sizes, int n_in, void* d_out, int out_size, void* d_ws, size_t ws_size, hipStream_t stream) {
    static int grid = 0;
    if (grid == 0) {
        if (n_in != N_IN || out_size != (int)O_END || ws_size < WS_END) { fprintf(stderr, "kernel_launch: unexpected shapes: n_in %d out %d ws %zu (need %zu)\n", n_in, out_size, ws_size, (size_t)WS_END); grid = -1; return; }
        int dev = 0, cus = 0;
        if (hipGetDevice(&dev) != hipSuccess || hipDeviceGetAttribute(&cus, hipDeviceAttributeMultiprocessorCount, dev) != hipSuccess) { grid = -1; return; }
        grid = cus > 0 ? cus : 256;
    }
    if (grid < 0) return;
    (void)hipMemsetAsync((char*)d_ws + WS_CTL, 0, CTL_ZERO_BYTES, stream);
    Args a{};
    for (int i = 0; i < N_IN; ++i) a.in[i] = (const float*)d_in[i];
    a.out = (float*)d_out; a.ws = (unsigned char*)d_ws;
    a.ph_lo = 0; a.ph_hi = 0;
    int nl = 0;
#ifndef STOP_AFTER
#define STOP_AFTER 1000
#endif
#define LS(k) do { if (nl++ < STOP_AFTER) launch_slot<k>(a, grid, stream); } while (0)
    LS(0); LS(1);
    for (int l = 0; l < 2; ++l) { a.ph_lo = l;
        LS(2); LS(3); LS(4); LS(5); LS(6); LS(7); LS(8); LS(9); LS(10); LS(11); LS(12); LS(13); LS(14); }
#ifdef DIAG_YBR
    hipLaunchKernelGGL(k_diag, dim3(1024), dim3(256), 0, stream, a);
#endif
}
```

```cpp
#include <hip/hip_runtime.h>
#include <cstdio>
#include <cstdint>
namespace pg8 {
#define PG8_LAS __attribute__((address_space(3)))
typedef unsigned short bf16_t;
typedef short bf16x8 __attribute__((ext_vector_type(8)));
typedef float f32x4 __attribute__((ext_vector_type(4)));
typedef unsigned u32x4 __attribute__((ext_vector_type(4)));
constexpr int BM = 256, BK = 64, HALF = 128, HTB = HALF * BK * 2  , STAGE_BYTES = 8 * HTB, NXCD = 8, WGM = 8;

__host__ __device__ __forceinline__ int lds_byte(int r, int c) { const int st = (r >> 4) * 2 + (c >> 5), rr = r & 15, cc = c & 31, ob = rr * 64 + cc * 2; return st * 1024 + (ob ^ (((ob >> 9) & 1) << 5)); }
__host__ __device__ __forceinline__ void stage_rc(int b, int& R, int& C) { const int st = b / 1024, sb = b % 1024, swz = sb ^ (((sb >> 9) & 1) << 5); R = (st >> 1) * 16 + swz / 64; C = (st & 1) * 32 + (swz % 64) / 2; }
__host__ __device__ __forceinline__ int perm32(int rho) { const int n = rho >> 4, i = rho & 15; return 8 * (i >> 2) + 4 * n + (i & 3); }

struct Unit { int pm, pn; };
struct Gemm { const bf16_t* A; const bf16_t* Bt; int M, N, K; };

struct StaticOrder {
    int nM, nN, nwg, G, c;
    __host__ __device__ void init(int M, int N, int G_, int c_) { nM = M / BM; nN = N / BM; nwg = nM * nN; G = G_; c = c_; }
    __host__ __device__ bool next(int i, Unit& u) const {
        const long L = (long)i * G + c; if (L >= nwg) return false;
        int wgid = (int)L; { const int q = nwg / NXCD, r = nwg % NXCD, xcd = wgid % NXCD, off = wgid / NXCD; wgid = (xcd < r ? xcd * (q + 1) : r * (q + 1) + (xcd - r) * q) + off; }
        const int nig = WGM * nN, gid = wgid / nig, fm = gid * WGM, gsz = (nM - fm) < WGM ? (nM - fm) : WGM;
        u.pm = fm + ((wgid % nig) % gsz); u.pn = (wgid % nig) / gsz; return true;
    }
    __device__ __forceinline__ void a_ready(const Unit&) const {}
    __device__ __forceinline__ void done(const Unit&) const {}
};
typedef __bf16 bf16x2n __attribute__((ext_vector_type(2)));
typedef float f32x2n __attribute__((ext_vector_type(2)));
__device__ __forceinline__ unsigned cvt_pk_bf16(float lo, float hi) { f32x2n v = {lo, hi}; bf16x2n b = __builtin_convertvector(v, bf16x2n); return __builtin_bit_cast(unsigned, b); }
typedef float f32x2 __attribute__((ext_vector_type(2)));
typedef unsigned u32x2 __attribute__((ext_vector_type(2)));
__device__ __forceinline__ float fast_sigmoid(float a) { return __builtin_amdgcn_rcpf(1.0f + __expf(-a)); }
__device__ __forceinline__ float bf_lo(unsigned u) { return __uint_as_float(u << 16); }
__device__ __forceinline__ float bf_hi(unsigned u) { return __uint_as_float(u & 0xffff0000u); }

struct EpiSwiGLU {
    static constexpr bool PERM = true, AFTER_DRAIN = false;
    bf16_t* O; int ldo;
    __device__ __forceinline__ void operator()(const f32x4 (&acc)[2][2][4][2], const Unit& u, int wr, int wc, int fr, int fq) const {
        const int row0 = u.pm * BM + wr * 64 + fr, col0 = u.pn * HALF + wc * 32 + 8 * fq;
#pragma unroll
        for (int ai = 0; ai < 2; ++ai)
#pragma unroll
            for (int m = 0; m < 4; ++m) { bf16_t* rowp = O + (size_t)(row0 + ai * HALF + m * 16) * ldo + col0;
                f32x4 v0, v1;
#pragma unroll
                for (int j = 0; j < 4; ++j) { const float a0 = acc[ai][0][m][0][j], a1 = acc[ai][0][m][1][j];
                    v0[j] = a0 * fast_sigmoid(a0) * acc[ai][1][m][0][j]; v1[j] = a1 * fast_sigmoid(a1) * acc[ai][1][m][1][j]; }
                u32x4 w; w.x = cvt_pk_bf16(v0[0], v0[1]); w.y = cvt_pk_bf16(v0[2], v0[3]); w.z = cvt_pk_bf16(v1[0], v1[1]); w.w = cvt_pk_bf16(v1[2], v1[3]);
                *(u32x4*)rowp = w; }
    }
};
struct EpiResid {
    static constexpr bool PERM = false, AFTER_DRAIN = false;
    float* X; const float* gate; float coef;
    __device__ __forceinline__ void operator()(const f32x4 (&acc)[2][2][4][2], const Unit& u, int wr, int wc, int fr, int fq) const {
        const int row0 = u.pm * BM + wr * 64 + fr, col0 = u.pn * BM + wc * 32 + 4 * fq;
        const int mr = u.pm < 32 ? 0 : 1 + ((u.pm - 32) >> 2);
        const float* gp = gate + (size_t)mr * 9216 + col0;
        f32x4 gv[2][2];
#pragma unroll
        for (int bj = 0; bj < 2; ++bj)
#pragma unroll
            for (int n = 0; n < 2; ++n) gv[bj][n] = *(const f32x4*)(gp + bj * HALF + n * 16) * coef;
#pragma unroll
        for (int ai = 0; ai < 2; ++ai)
#pragma unroll
            for (int m = 0; m < 4; ++m) { float* rowp = X + (size_t)(row0 + ai * HALF + m * 16) * 1024 + col0;
#pragma unroll
                for (int bj = 0; bj < 2; ++bj)
#pragma unroll
                    for (int n = 0; n < 2; ++n) { f32x4* p = (f32x4*)(rowp + bj * HALF + n * 16); *p = *p + gv[bj][n] * acc[ai][bj][m][n]; } }
    }
};
template <int ACT> struct EpiStore {
    static constexpr bool PERM = true, AFTER_DRAIN = false;
    bf16_t* O; int ldo;
    __device__ __forceinline__ void operator()(const f32x4 (&acc)[2][2][4][2], const Unit& u, int wr, int wc, int fr, int fq) const {
        const int row0 = u.pm * BM + wr * 64 + fr, col0 = u.pn * BM + wc * 32 + 8 * fq;
#pragma unroll
        for (int ai = 0; ai < 2; ++ai)
#pragma unroll
            for (int m = 0; m < 4; ++m) { bf16_t* rowp = O + (size_t)(row0 + ai * HALF + m * 16) * ldo + col0;
#pragma unroll
                for (int bj = 0; bj < 2; ++bj) { f32x4 v0 = acc[ai][bj][m][0], v1 = acc[ai][bj][m][1];
                    if (ACT == 1) {
#pragma unroll
                        for (int j = 0; j < 4; ++j) { v0[j] = fast_sigmoid(v0[j]); v1[j] = fast_sigmoid(v1[j]); } }
                    u32x4 w; w.x = cvt_pk_bf16(v0[0], v0[1]); w.y = cvt_pk_bf16(v0[2], v0[3]); w.z = cvt_pk_bf16(v1[0], v1[1]); w.w = cvt_pk_bf16(v1[2], v1[3]);
                    *(u32x4*)(rowp + bj * HALF) = w; } }
    }
};
struct EpiMerge {
    static constexpr bool PERM = false, AFTER_DRAIN = false;
    float* P; const bf16_t* G; bf16_t* O; int goff; int mode;
    __device__ __forceinline__ void operator()(const f32x4 (&acc)[2][2][4][2], const Unit& u, int wr, int wc, int fr, int fq) const {
        const int row0 = u.pm * BM + wr * 64 + fr, col0 = u.pn * BM + wc * 32 + 4 * fq;
#pragma unroll
        for (int ai = 0; ai < 2; ++ai)
#pragma unroll
            for (int m = 0; m < 4; ++m) { const size_t r = (size_t)(row0 + ai * HALF + m * 16);
#pragma unroll
                for (int bj = 0; bj < 2; ++bj)
#pragma unroll
                    for (int n = 0; n < 2; ++n) { const int c = col0 + bj * HALF + n * 16;
                        const u32x2 gw = *(const u32x2*)(G + r * 4096 + goff + c);
                        f32x4 g; g[0] = bf_lo(gw.x); g[1] = bf_hi(gw.x); g[2] = bf_lo(gw.y); g[3] = bf_hi(gw.y);
                        f32x4 v = g * acc[ai][bj][m][n];
                        f32x4* pp = (f32x4*)(P + r * 1024 + c);
                        if (mode != 0) v = v + *pp;
                        if (mode != 2) *pp = v;
                        else { u32x2 w; w.x = cvt_pk_bf16(v[0], v[1]); w.y = cvt_pk_bf16(v[2], v[3]); *(u32x2*)(O + r * 1024 + c) = w; } } }
    }
};
template <class Epi, class Sched, bool STAMP = false>
__device__ __forceinline__ void gemm_phase(PG8_LAS unsigned char* lds, const Gemm g, const Sched& S, const Epi& E, unsigned long long* stamps) {
    const int tid = threadIdx.x, wid = __builtin_amdgcn_readfirstlane(tid >> 6), lane = tid & 63, wr = wid >> 2, wc = wid & 3, fr = lane & 15, fq = lane >> 4;
    const int K = g.K, nt = K / BK;
    int ts_lo = 0, ts_hi = 0, nts = 0; const unsigned long long rt_entry = STAMP ? (unsigned long long)wall_clock64() : 0ull;
#define PG8_STAMP() do { if (STAMP && wid == 0 && nts < 64) { const unsigned long long _c = (unsigned long long)clock64(); \
        ts_lo = (lane == nts) ? (int)(unsigned)_c : ts_lo; ts_hi = (lane == nts) ? (int)(unsigned)(_c >> 32) : ts_hi; ++nts; } } while (0)
    PG8_STAMP();
    unsigned voffA[2], voffB[2];
#pragma unroll
    for (int i = 0; i < 2; ++i) { int R, C; stage_rc(tid * 16 + i * 8192, R, C); const int Rb = Epi::PERM ? ((R & ~31) + perm32(R & 31)) : R;
        voffA[i] = (unsigned)(R * K + C) * 2u; voffB[i] = (unsigned)(Rb * K + C) * 2u; }
    const size_t kstep = (size_t)(BK * 2);
    const size_t hstep = (size_t)HALF * K * 2;
    const size_t tstep = 2 * hstep;
    const unsigned ldsw = (unsigned)wid * 1024u;
    const int aoff = lds_byte(wr * 64 + fr, fq * 8), boff = lds_byte(wc * 32 + fr, fq * 8);
#define PG8_SA(b, h) (((b) * 2 + (h)) * HTB)
#define PG8_SB(b, h) ((4 + (b) * 2 + (h)) * HTB)
#define PG8_STAGE(bufoff, gbase, voff) do { _Pragma("unroll") for (int _i = 0; _i < 2; ++_i) \
        __builtin_amdgcn_global_load_lds((const unsigned*)((const char*)(gbase) + (voff)[_i]), (PG8_LAS unsigned*)(lds + (bufoff) + ldsw + _i * 8192), 16, 0, 0); } while (0)
#define PG8_LDA(dst, b, h) do { _Pragma("unroll") for (int m = 0; m < 4; ++m) _Pragma("unroll") for (int k = 0; k < 2; ++k) dst[m][k] = *(const PG8_LAS bf16x8*)(lds + PG8_SA(b, h) + aoff + m * 2048 + k * 1024); } while (0)
#define PG8_LDB(dst, b, h) do { _Pragma("unroll") for (int n = 0; n < 2; ++n) _Pragma("unroll") for (int k = 0; k < 2; ++k) dst[n][k] = *(const PG8_LAS bf16x8*)(lds + PG8_SB(b, h) + boff + n * 2048 + k * 1024); } while (0)
#define PG8_MMA(ai, bj, At, Bt) do { __builtin_amdgcn_s_setprio(1); _Pragma("unroll") for (int m = 0; m < 4; ++m) _Pragma("unroll") for (int n = 0; n < 2; ++n) _Pragma("unroll") for (int k = 0; k < 2; ++k) \
        acc[ai][bj][m][n] = __builtin_amdgcn_mfma_f32_16x16x32_bf16(Bt[n][k], At[m][k], acc[ai][bj][m][n], 0, 0, 0); __builtin_amdgcn_s_setprio(0); } while (0)
#define PG8_WAIT_V(n) asm volatile("s_waitcnt vmcnt(" #n ")" ::: "memory")
#define PG8_WAIT_L(n) asm volatile("s_waitcnt lgkmcnt(" #n ")" ::: "memory")
#define PG8_BAR __builtin_amdgcn_s_barrier()
#define PG8_SCHED __builtin_amdgcn_sched_barrier(0)
    Unit cur, nxt; int ui = 0;
    if (!S.next(0, cur)) return;
    f32x4 acc[2][2][4][2];
#pragma unroll
    for (int a = 0; a < 2; ++a)
#pragma unroll
        for (int b = 0; b < 2; ++b)
#pragma unroll
            for (int m = 0; m < 4; ++m)
#pragma unroll
                for (int n = 0; n < 2; ++n) acc[a][b][m][n] = (f32x4){0.f, 0.f, 0.f, 0.f};
    bf16x8 At[4][2], B0[2][2], B1[2][2];
    const char* cA = (const char*)g.A + (size_t)cur.pm * tstep; const char* cB = (const char*)g.Bt + (size_t)cur.pn * tstep;
    S.a_ready(cur);
    PG8_STAGE(PG8_SB(0, 0), cB, voffB); PG8_STAGE(PG8_SA(0, 0), cA, voffA); PG8_STAGE(PG8_SB(0, 1), cB + hstep, voffB); PG8_STAGE(PG8_SA(0, 1), cA + hstep, voffA);
    if (wr == 1) PG8_BAR;
    PG8_WAIT_V(4); PG8_BAR;
    PG8_STAGE(PG8_SB(1, 0), cB + kstep, voffB); PG8_STAGE(PG8_SA(1, 0), cA + kstep, voffA); PG8_STAGE(PG8_SB(1, 1), cB + hstep + kstep, voffB);
    PG8_WAIT_V(6); PG8_BAR;
    PG8_STAMP();
    for (;;) {
        const bool has_next = S.next(ui + 1, nxt);
        const char* nA = has_next ? (const char*)g.A + (size_t)nxt.pm * tstep : cA; const char* nB = has_next ? (const char*)g.Bt + (size_t)nxt.pn * tstep : cB;
        for (int t = 0; t < nt; t += 2) {
            const bool last = (t == nt - 2);
            const char* a1 = cA + (size_t)(t + 1) * kstep;
            const char* a2 = last ? nA : cA + (size_t)(t + 2) * kstep; const char* b2 = last ? nB : cB + (size_t)(t + 2) * kstep;
            const char* a3 = a2 + kstep; const char* b3 = b2 + kstep;
            if (last && has_next) S.a_ready(nxt);
            PG8_LDB(B0, 0, 0); PG8_SCHED; PG8_LDA(At, 0, 0); PG8_STAGE(PG8_SA(1, 1), a1 + hstep, voffA);
            PG8_WAIT_L(8); PG8_BAR; PG8_WAIT_L(0); PG8_MMA(0, 0, At, B0); PG8_BAR; PG8_SCHED;
            PG8_LDB(B1, 0, 1); PG8_STAGE(PG8_SB(0, 0), b2, voffB);
            PG8_BAR; PG8_WAIT_L(0); PG8_MMA(0, 1, At, B1); PG8_BAR;
            PG8_LDA(At, 0, 1); PG8_STAGE(PG8_SA(0, 0), a2, voffA);
            PG8_BAR; PG8_WAIT_L(0); PG8_MMA(1, 0, At, B0); PG8_BAR; PG8_SCHED;
            PG8_STAGE(PG8_SB(0, 1), b2 + hstep, voffB);
            PG8_WAIT_V(6); PG8_BAR; PG8_MMA(1, 1, At, B1); PG8_BAR;
            PG8_LDB(B0, 1, 0); PG8_SCHED; PG8_LDA(At, 1, 0); PG8_STAGE(PG8_SA(0, 1), a2 + hstep, voffA);
            PG8_WAIT_L(8); PG8_BAR; PG8_WAIT_L(0); PG8_MMA(0, 0, At, B0); PG8_BAR; PG8_SCHED;
            PG8_LDB(B1, 1, 1); PG8_STAGE(PG8_SB(1, 0), b3, voffB);
            PG8_BAR; PG8_WAIT_L(0); PG8_MMA(0, 1, At, B1); PG8_BAR;
            PG8_LDA(At, 1, 1); PG8_STAGE(PG8_SA(1, 0), a3, voffA);
            PG8_BAR; PG8_WAIT_L(0); PG8_MMA(1, 0, At, B0); PG8_BAR; PG8_SCHED;
            PG8_STAGE(PG8_SB(1, 1), b3 + hstep, voffB);
            PG8_WAIT_V(6); PG8_BAR; PG8_MMA(1, 1, At, B1); PG8_BAR;
        }
        PG8_STAMP();
        if constexpr (!Epi::AFTER_DRAIN) { E(acc, cur, wr, wc, fr, fq); S.done(cur); }
        PG8_STAMP();
        if (!has_next) break;
#pragma unroll
        for (int a = 0; a < 2; ++a)
#pragma unroll
            for (int b = 0; b < 2; ++b)
#pragma unroll
                for (int m = 0; m < 4; ++m)
#pragma unroll
                    for (int n = 0; n < 2; ++n) acc[a][b][m][n] = (f32x4){0.f, 0.f, 0.f, 0.f};
        cur = nxt; cA = nA; cB = nB; ++ui;
    }
    PG8_WAIT_V(0);
    if (wr == 0) PG8_BAR;
    PG8_BAR;
    if constexpr (Epi::AFTER_DRAIN) { E.fused(acc, cur, wr, wc, fr, fq, lds, wid, lane); S.done(cur); }
    PG8_STAMP();
    if (STAMP && wid == 0) { stamps[lane] = lane < nts ? (((unsigned long long)(unsigned)ts_hi << 32) | (unsigned)ts_lo) : 0ull;
        if (lane == 62) stamps[62] = rt_entry; if (lane == 63) stamps[63] = (unsigned long long)wall_clock64(); }
#undef PG8_STAMP
#undef PG8_SA
#undef PG8_SB
#undef PG8_STAGE
#undef PG8_LDA
#undef PG8_LDB
#undef PG8_MMA
#undef PG8_WAIT_V
#undef PG8_WAIT_L
#undef PG8_BAR
#undef PG8_SCHED
}
}
#define LAS __attribute__((address_space(3)))
typedef pg8::bf16_t bf16_t;
typedef pg8::f32x4 f32x4;
typedef pg8::u32x4 u32x4;
typedef pg8::u32x2 u32x2;
using pg8::bf_lo; using pg8::bf_hi; using pg8::cvt_pk_bf16;
constexpr int D = 1024, M = 16384, DFF = 2816, NMIX = 5376, NGATE = 4096;
constexpr float EPS = 1e-6f;
constexpr int C_HY = 0, C_DQ = 1536, C_DK = 2048, C_DV = 2560, C_WQ = 3072, C_WK = 3584, C_WV = 3712, C_RQ = 3840, C_RK = 4096, C_RV = 4352, C_RG = 4864;
constexpr size_t O_DK = 16777216, O_DV = 25165824, O_WK = 33554432, O_WV = 35651584, O_RF = 37748736, O_RB = 39845888, O_END = 41943040;
constexpr size_t MiB = 1u << 20;
constexpr size_t WS_CTL = 0, CTL_ZERO_BYTES = 1 * MiB;
constexpr size_t WS_MODP = 1 * MiB, WS_MOD = 7 * MiB, WS_Z2 = 8 * MiB, WS_FILT = 9 * MiB, WS_W = 20 * MiB, WS_H = 78 * MiB, WS_BIG = 110 * MiB, WS_YBR = 302 * MiB, WS_ZB = 366 * MiB, WS_END = 398 * MiB;
constexpr size_t W_FA_IN = 0, W_FA_OUT = 11534336, W_FB_IN = 17301504, W_FB_OUT = 28835840, W_IN = 34603008, W_BR = 54001664, W_OUT = 58195968, W_END = 60293120;
static_assert(WS_W + W_END <= WS_H, "weights fit");
constexpr int NPHASE = 28;
enum InIdx { I_XP = 0, I_XS, I_C, I_CDK, I_CDV, I_CWK, I_CWV, I_SRF, I_SRB, I_CCTX, I_NFA, I_NMIX, I_NFB, I_WADA, I_BADA, I_WFAI, I_WFAO, I_WFBI, I_WFBO, I_WIN, I_HCW, I_HCB,
             I_HW1, I_HB1, I_HW2, I_HB2, I_HW3, I_HSKIP, I_DQN, I_DKN, I_DLAM, I_DSUB, I_WQN, I_WKN, I_WSINK, I_RDF, I_RDB, I_WBR, I_WOUT, N_IN };
struct Args { const float* in[N_IN]; float* out; unsigned char* ws; int ph_lo, ph_hi; };
struct Ctx { const LAS unsigned long long* tab; float* out; unsigned char* ws; };
constexpr int LDS_BYTES = 147456;
constexpr int LDS_TAB_OFF = LDS_BYTES - 1024, LDS_ST_OFF = LDS_BYTES - 64;
__device__ __forceinline__ const float* inp(const Ctx& c, int i) { const unsigned long long v = c.tab[i];
    const unsigned lo = __builtin_amdgcn_readfirstlane((unsigned)v), hi = __builtin_amdgcn_readfirstlane((unsigned)(v >> 32)); return (const float*)(((unsigned long long)hi << 32) | lo); }
__device__ __forceinline__ Ctx make_ctx(const Args& a, LAS unsigned char* lds, int tid) {
    LAS unsigned long long* tab = (LAS unsigned long long*)(lds + LDS_TAB_OFF);
    if (tid < N_IN) tab[tid] = (unsigned long long)a.in[tid];
    if (tid >= 64 && tid < 80) ((LAS unsigned*)(lds + LDS_ST_OFF))[tid - 64] = 0u;
    __syncthreads();
    Ctx c; c.tab = tab; c.out = a.out; c.ws = a.ws; return c; }


#define LDS_WAIT() asm volatile("s_waitcnt lgkmcnt(0)" ::: "memory")
__device__ __forceinline__ float wave_sum(float v) {
#pragma unroll
    for (int o = 1; o < 64; o <<= 1) v += __shfl_xor(v, o);
    return v;
}
__device__ __forceinline__ unsigned f2bf(float f) { unsigned u = __float_as_uint(f); return (u + 0x7fffu + ((u >> 16) & 1u)) >> 16; }
__device__ __forceinline__ unsigned pk2(float lo, float hi) { return cvt_pk_bf16(lo, hi); }
__device__ __forceinline__ float bf2f(bf16_t b) { return __uint_as_float(((unsigned)b) << 16); }

__device__ __forceinline__ void ld64bf(const bf16_t* p, float (&x)[64]) {
    const uint4* q = (const uint4*)p;
#pragma unroll
    for (int i = 0; i < 8; ++i) { const uint4 u = q[i]; x[8 * i + 0] = bf_lo(u.x); x[8 * i + 1] = bf_hi(u.x); x[8 * i + 2] = bf_lo(u.y); x[8 * i + 3] = bf_hi(u.y);
        x[8 * i + 4] = bf_lo(u.z); x[8 * i + 5] = bf_hi(u.z); x[8 * i + 6] = bf_lo(u.w); x[8 * i + 7] = bf_hi(u.w); }
}
__device__ __forceinline__ void st64bf(bf16_t* p, const float (&x)[64]) {
    uint4* q = (uint4*)p;
#pragma unroll
    for (int i = 0; i < 8; ++i) { uint4 u; u.x = pk2(x[8 * i + 0], x[8 * i + 1]); u.y = pk2(x[8 * i + 2], x[8 * i + 3]); u.z = pk2(x[8 * i + 4], x[8 * i + 5]); u.w = pk2(x[8 * i + 6], x[8 * i + 7]); q[i] = u; }
}
__device__ __forceinline__ float dot64bf(const bf16_t* p, const float (&q)[64]) {
    const uint4* r = (const uint4*)p; float s0 = 0.f, s1 = 0.f, s2 = 0.f, s3 = 0.f;
#pragma unroll
    for (int i = 0; i < 8; ++i) { const uint4 u = r[i];
        s0 += bf_lo(u.x) * q[8 * i + 0]; s1 += bf_hi(u.x) * q[8 * i + 1]; s2 += bf_lo(u.y) * q[8 * i + 2]; s3 += bf_hi(u.y) * q[8 * i + 3];
        s0 += bf_lo(u.z) * q[8 * i + 4]; s1 += bf_hi(u.z) * q[8 * i + 5]; s2 += bf_lo(u.w) * q[8 * i + 6]; s3 += bf_hi(u.w) * q[8 * i + 7]; }
    return (s0 + s1) + (s2 + s3);
}
__device__ __forceinline__ float dot64f(const float* p, const float (&q)[64]) {
    const float4* r = (const float4*)p; float s0 = 0.f, s1 = 0.f, s2 = 0.f, s3 = 0.f;
#pragma unroll
    for (int i = 0; i < 16; ++i) { const float4 u = r[i]; s0 += u.x * q[4 * i + 0]; s1 += u.y * q[4 * i + 1]; s2 += u.z * q[4 * i + 2]; s3 += u.w * q[4 * i + 3]; }
    return (s0 + s1) + (s2 + s3);
}
__device__ __forceinline__ void axpy64bf(float a, const bf16_t* p, float (&acc)[64]) {
    const uint4* r = (const uint4*)p;
#pragma unroll
    for (int i = 0; i < 8; ++i) { const uint4 u = r[i];
        acc[8 * i + 0] += a * bf_lo(u.x); acc[8 * i + 1] += a * bf_hi(u.x); acc[8 * i + 2] += a * bf_lo(u.y); acc[8 * i + 3] += a * bf_hi(u.y);
        acc[8 * i + 4] += a * bf_lo(u.z); acc[8 * i + 5] += a * bf_hi(u.z); acc[8 * i + 6] += a * bf_lo(u.w); acc[8 * i + 7] += a * bf_hi(u.w); }
}
__device__ __forceinline__ void axpy64f(float a, const float* p, float (&acc)[64]) {
    const float4* r = (const float4*)p;
#pragma unroll
    for (int i = 0; i < 16; ++i) { const float4 u = r[i]; acc[4 * i + 0] += a * u.x; acc[4 * i + 1] += a * u.y; acc[4 * i + 2] += a * u.z; acc[4 * i + 3] += a * u.w; }
}
#define ONLINE_UPDATE(s, AXPY) do { if ((s) > m) { const float f_ = __expf(m - (s)); lsum *= f_; _Pragma("unroll") for (int i_ = 0; i_ < 64; ++i_) acc[i_] *= f_; m = (s); } \
    const float p_ = __expf((s) - m); lsum += p_; AXPY; } while (0)

__device__ __forceinline__ void transpose_item(const float* W, int K, int N, bf16_t* WT, bool swi, LAS float* scr, int item, int lane) {
    const int nblk = N / 32, kb = item / nblk, nb = item % nblk, k0 = 64 * kb, d0 = 32 * nb;
    int n0 = d0;
    if (swi) { const int tile = d0 >> 8, w = d0 & 255; n0 = (w < 128) ? (tile * 128 + w) : (DFF + tile * 128 + (w - 128)); }
#pragma unroll 8
    for (int i = 0; i < 32; ++i) { const int kk = 2 * i + (lane >> 5); scr[kk * 33 + (lane & 31)] = W[(size_t)(k0 + kk) * N + n0 + (lane & 31)]; }
    LDS_WAIT(); asm volatile("" ::: "memory");
    const int c = lane & 7;
#pragma unroll
    for (int j = 0; j < 4; ++j) { const int n = (lane >> 3) + 8 * j; const LAS float* s = scr + (8 * c) * 33 + n;
        uint4 o; o.x = pk2(s[0 * 33], s[1 * 33]); o.y = pk2(s[2 * 33], s[3 * 33]); o.z = pk2(s[4 * 33], s[5 * 33]); o.w = pk2(s[6 * 33], s[7 * 33]);
        *(uint4*)(WT + (size_t)(d0 + n) * K + k0 + 8 * c) = o; }
    LDS_WAIT(); asm volatile("" ::: "memory");
}
__device__ __forceinline__ void convert_weights(const Ctx& a, int l, LAS unsigned char* lds, int gw, int NGW, int wave, int lane) {
    LAS float* scr = (LAS float*)(lds + wave * 16384);
    bf16_t* wb = (bf16_t*)(a.ws + WS_W);
    constexpr int I0 = 16 * 176, I1 = 44 * 32, I4 = 16 * 296, I5 = 8 * 32, I9 = 16 * 32;
    constexpr int NITEMS = 2 * I0 + 2 * I1 + I4 + 4 * I5 + I9;
    for (int it = gw; it < NITEMS; it += NGW) {
        int r = it;
        if (r < I0) { transpose_item(inp(a, I_WFAI) + (size_t)l * D * 2 * DFF, D, 2 * DFF, (bf16_t*)((unsigned char*)wb + W_FA_IN), true, scr, r, lane); continue; } r -= I0;
        if (r < I1) { transpose_item(inp(a, I_WFAO) + (size_t)l * DFF * D, DFF, D, (bf16_t*)((unsigned char*)wb + W_FA_OUT), false, scr, r, lane); continue; } r -= I1;
        if (r < I0) { transpose_item(inp(a, I_WFBI) + (size_t)l * D * 2 * DFF, D, 2 * DFF, (bf16_t*)((unsigned char*)wb + W_FB_IN), true, scr, r, lane); continue; } r -= I0;
        if (r < I1) { transpose_item(inp(a, I_WFBO) + (size_t)l * DFF * D, DFF, D, (bf16_t*)((unsigned char*)wb + W_FB_OUT), false, scr, r, lane); continue; } r -= I1;
        if (r < I4) { transpose_item(inp(a, I_WIN) + (size_t)l * D * 9472, D, 9472, (bf16_t*)((unsigned char*)wb + W_IN), false, scr, r, lane); continue; } r -= I4;
        if (r < 4 * I5) { const int b = r / I5; transpose_item(inp(a, I_WBR) + ((size_t)l * 4 + b) * 512 * D, 512, D, (bf16_t*)((unsigned char*)wb + W_BR) + (size_t)b * D * 512, false, scr, r % I5, lane); continue; } r -= 4 * I5;
        transpose_item(inp(a, I_WOUT) + (size_t)l * D * D, D, D, (bf16_t*)((unsigned char*)wb + W_OUT), false, scr, r, lane);
    }
}
__device__ __forceinline__ void phase_p0a(const Ctx& a, LAS unsigned char* lds, int bid, int nblk, int tid) {
    const int lane = tid & 63, wave = tid >> 6, gtid = bid * 512 + tid, NT = nblk * 512;
    { const float4* s0 = (const float4*)inp(a, I_XP); const float4* s1 = (const float4*)inp(a, I_XS); float4* o = (float4*)a.out;
      for (int i = gtid; i < 4194304; i += NT) o[i] = i < 2097152 ? s0[i] : s1[i - 2097152]; }
    { LAS float* sc = (LAS float*)lds;
      for (int i = tid; i < 9216; i += 512) { const int r = i >> 10, k = i & 1023; const float v = r == 0 ? inp(a, I_CCTX)[k] : inp(a, I_C)[(r - 1) * 1024 + k]; sc[i] = v / (1.0f + expf(-v)); }
      __syncthreads();
      float* modp = (float*)(a.ws + WS_MODP);
      for (int idx = gtid; idx < 2 * 8 * 9216; idx += NT) { const int n = idx % 9216, kc = (idx / 9216) % 8, l = idx / (9216 * 8);
          const float* w = inp(a, I_WADA) + ((size_t)l * 1024 + kc * 128) * 9216 + n; float acc[9];
#pragma unroll
          for (int r = 0; r < 9; ++r) acc[r] = 0.f;
          for (int k = 0; k < 128; ++k) { const float wv = w[(size_t)k * 9216];
#pragma unroll
              for (int r = 0; r < 9; ++r) acc[r] += sc[r * 1024 + kc * 128 + k] * wv; }
#pragma unroll
          for (int r = 0; r < 9; ++r) modp[((size_t)(l * 8 + kc) * 9 + r) * 9216 + n] = acc[r]; }
      __syncthreads(); }
    { LAS float* fe = (LAS float*)lds; LAS float* z1 = fe + 8 * 33; float* z2g = (float*)(a.ws + WS_Z2);
      for (int it = bid; it < 320; it += nblk) { const int l = it / 160, tg = it % 160, tt = tid >> 6, j = tid & 63, tglob = tg * 8 + tt;
          const int L = tglob < 256 ? 256 : 1024, tpos = tglob < 256 ? tglob : tglob - 256; const float tf = (float)tpos / (float)L;
          if (j < 33) { float v; if (j == 0) v = tf; else if (j <= 16) v = sinf((6.2831853071795864769f * tf) * (float)j); else v = cosf((6.2831853071795864769f * tf) * (float)(j - 16)); fe[tt * 33 + j] = v; }
          __syncthreads();
          float s = inp(a, I_HB1)[l * 64 + j];
          for (int i = 0; i < 33; ++i) s += fe[tt * 33 + i] * inp(a, I_HW1)[(l * 33 + i) * 64 + j];
          z1[tt * 64 + j] = sinf(s);
          __syncthreads();
          float s2 = inp(a, I_HB2)[l * 64 + j];
          for (int i = 0; i < 64; ++i) s2 += z1[tt * 64 + i] * inp(a, I_HW2)[(l * 64 + i) * 64 + j];
          z2g[((size_t)l * 1280 + tglob) * 64 + j] = sinf(s2);
          __syncthreads(); } }
    convert_weights(a, 0, lds, bid * 8 + wave, nblk * 8, wave, lane);
}
__device__ __forceinline__ void phase_p0b(const Ctx& a, LAS unsigned char* lds, int bid, int nblk, int tid) {
    const int gtid = bid * 512 + tid, NT = nblk * 512;
    { const float* modp = (const float*)(a.ws + WS_MODP); float* mod = (float*)(a.ws + WS_MOD);
      for (int idx = gtid; idx < 2 * 9 * 9216; idx += NT) { const int n = idx % 9216, r = (idx / 9216) % 9, l = idx / (9216 * 9); float s = inp(a, I_BADA)[l * 9216 + n];
#pragma unroll
          for (int kc = 0; kc < 8; ++kc) s += modp[((size_t)(l * 8 + kc) * 9 + r) * 9216 + n];
          mod[idx] = s; } }
    { LAS float* red = (LAS float*)lds; const float* z2g = (const float*)(a.ws + WS_Z2); float* filt = (float*)(a.ws + WS_FILT);
      const float dmin = logf(0.01f) / 1.5f, dmax = logf(0.01f) / 0.3f;
      for (int it = bid; it < 128; it += nblk) { const int l = it >> 6, ls = (it >> 5) & 1, cg = it & 31, ci = tid & 15, tl = tid >> 4, c = cg * 16 + ci;
          const int L = ls ? 1024 : 256, toff = ls ? 256 : 0; float* G = filt + (size_t)l * (2560 * 512) + (ls ? 512 * 512 : 0);
          const float ad = fabsf(dmin + (dmax - dmin) * ((float)c / 511.0f)); const float* w3 = inp(a, I_HW3) + (size_t)l * 64 * 1024;
          float asum = 0.f;
          for (int t = tl; t < L; t += 32) { const float* zp = z2g + ((size_t)l * 1280 + toff + t) * 64; float zf = 0.f, zb = 0.f;
              for (int j = 0; j < 64; ++j) { const float z = zp[j]; zf += z * w3[j * 1024 + c]; zb += z * w3[j * 1024 + 512 + c]; }
              const float win = expf(-((float)t / (float)L) * ad); const float hf = zf * win, hb = zb * win; asum += fabsf(hf) + fabsf(hb);
              G[(size_t)(L - 1 + t) * 512 + c] = hf; if (t >= 1) G[(size_t)(L - 1 - t) * 512 + c] = hb; }
          red[tl * 16 + ci] = asum; __syncthreads();
          float tot = 0.f;
          for (int i = 0; i < 32; ++i) tot += red[i * 16 + ci];
          const float inv = 1.0f / tot;
          for (int t = tl; t < L; t += 32) { G[(size_t)(L - 1 + t) * 512 + c] *= inv; if (t >= 1) G[(size_t)(L - 1 - t) * 512 + c] *= inv; }
          __syncthreads(); } }
}
__device__ __forceinline__ void phase_norm(const Ctx& a, int l, int gidx  , int sidx  , int bid, int nblk, int tid) {
    const int lane = tid & 63, gw = bid * 8 + (tid >> 6), NGW = nblk * 8;
    const float* gain = inp(a, gidx) + l * 1024; const float* modl = (const float*)(a.ws + WS_MOD) + (size_t)l * 9 * 9216; bf16_t* H = (bf16_t*)(a.ws + WS_H);
    for (int row = gw; row < M; row += NGW) { const int r = row < 8192 ? 0 : 1 + ((row - 8192) >> 10);
        const f32x4* xr = (const f32x4*)(a.out + (size_t)row * 1024) + lane; f32x4 v[4]; float ss = 0.f;
#pragma unroll
        for (int j = 0; j < 4; ++j) { v[j] = xr[64 * j]; ss += (v[j].x * v[j].x + v[j].y * v[j].y) + (v[j].z * v[j].z + v[j].w * v[j].w); }
        const float rstd = 1.0f / sqrtf(wave_sum(ss) * (1.0f / 1024.0f) + EPS);
#pragma unroll
        for (int j = 0; j < 4; ++j) { const int col = 4 * lane + 256 * j; const f32x4 g = *(const f32x4*)(gain + col), sh = *(const f32x4*)(modl + (size_t)r * 9216 + sidx * 1024 + col), sc = *(const f32x4*)(modl + (size_t)r * 9216 + (sidx + 1) * 1024 + col);
            const f32x4 y = (v[j] * rstd) * g; const f32x4 h = y * (sc + 1.0f) + sh;
            u32x2 w; w.x = pk2(h.x, h.y); w.y = pk2(h.z, h.w); *(u32x2*)(H + (size_t)row * 1024 + col) = w; } }
}
__device__ __forceinline__ void phase_prep(const Ctx& a, int l, int bid, int nblk, int tid) {
    const int gtid = bid * 512 + tid, NT = nblk * 512; bf16_t* cols = (bf16_t*)(a.ws + WS_BIG);
    { const int sub = gtid & 7;
#pragma unroll 1
      for (int T = gtid >> 3; T < M * 36; T += NT >> 3) { const int row = T / 36, vt = T % 36; const bool lat = row >= 8192; bf16_t* cr = cols + (size_t)row * NMIX;
        const int bc = row >> 8, tc = row & 255;
        if (vt < 26) { int col; const float* gn; float* so = nullptr;
            if (vt < 8) { col = C_DQ + 64 * vt; gn = inp(a, I_DQN) + l * 64; }
            else if (vt < 16) { col = C_DK + 64 * (vt - 8); gn = inp(a, I_DKN) + l * 64; if (!lat) so = a.out + O_DK + ((((size_t)bc * 2 + l) * 256 + tc) * 8 + (vt - 8)) * 64; }
            else if (vt < 24) { col = C_WQ + 64 * (vt - 16); gn = inp(a, I_WQN) + l * 64; }
            else { col = C_WK + 64 * (vt - 24); gn = inp(a, I_WKN) + l * 64; if (!lat) so = a.out + O_WK + ((((size_t)bc * 2 + l) * 256 + tc) * 2 + (vt - 24)) * 64; }
            const uint4 u = *(const uint4*)(cr + col + 8 * sub);
            float x[8] = {bf_lo(u.x), bf_hi(u.x), bf_lo(u.y), bf_hi(u.y), bf_lo(u.z), bf_hi(u.z), bf_lo(u.w), bf_hi(u.w)};
            float ss = 0.f;
#pragma unroll
            for (int i = 0; i < 8; ++i) ss += x[i] * x[i];
            ss += __shfl_xor(ss, 1); ss += __shfl_xor(ss, 2); ss += __shfl_xor(ss, 4);
            const float rs = 1.0f / sqrtf(ss * (1.0f / 64.0f) + EPS);
            const float4 g0 = *(const float4*)(gn + 8 * sub), g1 = *(const float4*)(gn + 8 * sub + 4);
            x[0] *= rs * g0.x; x[1] *= rs * g0.y; x[2] *= rs * g0.z; x[3] *= rs * g0.w; x[4] *= rs * g1.x; x[5] *= rs * g1.y; x[6] *= rs * g1.z; x[7] *= rs * g1.w;
            if (so) { ((float4*)(so + 8 * sub))[0] = make_float4(x[0], x[1], x[2], x[3]); ((float4*)(so + 8 * sub))[1] = make_float4(x[4], x[5], x[6], x[7]); }
            if (lat) { const int t = (row - 8192) & 1023; const float pos = (sub & 4) ? (float)(t & 63) : (float)(t >> 6); const bool second = (sub & 2) != 0;
#pragma unroll
                for (int i = 0; i < 8; ++i) { const float y = __shfl_xor(x[i], 2); const float invf = exp2f(-(float)((sub & 1) * 8 + i) * (13.287712379549449f / 16.0f));
                    const float ang = pos * invf, sn = __sinf(ang), cs = __cosf(ang);
                    x[i] = second ? (y * sn + x[i] * cs) : (x[i] * cs - y * sn); } }
            uint4 o; o.x = pk2(x[0], x[1]); o.y = pk2(x[2], x[3]); o.z = pk2(x[4], x[5]); o.w = pk2(x[6], x[7]);
            *(uint4*)(cr + col + 8 * sub) = o;
        } else if (!lat) { const int v = vt < 34 ? vt - 26 : vt - 34; const bf16_t* src = cr + (vt < 34 ? C_DV : C_WV) + 64 * v + 8 * sub;
            float* dst = (vt < 34 ? a.out + O_DV + (((size_t)bc * 2 + l) * 256 + tc) * 512 + 64 * v : a.out + O_WV + (((size_t)bc * 2 + l) * 256 + tc) * 128 + 64 * v) + 8 * sub;
            const uint4 u = *(const uint4*)src;
            ((float4*)dst)[0] = make_float4(bf_lo(u.x), bf_hi(u.x), bf_lo(u.y), bf_hi(u.y)); ((float4*)dst)[1] = make_float4(bf_lo(u.z), bf_hi(u.z), bf_lo(u.w), bf_hi(u.w)); }
      } }
    { const float* cw = inp(a, I_HCW) + l * 3 * 1536; const float* cb = inp(a, I_HCB) + l * 1536; float* ZB = (float*)(a.ws + WS_ZB);
      for (int idx = gtid; idx < M * 512; idx += NT) { const int row = idx >> 9, c = idx & 511; const bool lat = row >= 8192; const int t = lat ? ((row - 8192) & 1023) : (row & 255), L = lat ? 1024 : 256;
          const bf16_t* p = cols + (size_t)row * NMIX; const bool hm = t > 0, hp = t < L - 1;
          const float vm = hm ? bf2f(p[c - NMIX]) : 0.f, v0 = bf2f(p[c]), vp = hp ? bf2f(p[c + NMIX]) : 0.f;
          const float xm = hm ? bf2f(p[1024 + c - NMIX]) : 0.f, x0 = bf2f(p[1024 + c]), xp = hp ? bf2f(p[1024 + c + NMIX]) : 0.f;
          const float v = vm * cw[c] + v0 * cw[1536 + c] + vp * cw[3072 + c] + cb[c];
          const float x1 = xm * cw[1024 + c] + x0 * cw[1536 + 1024 + c] + xp * cw[3072 + 1024 + c] + cb[1024 + c];
          ZB[idx] = v * x1; } }
}
__device__ __forceinline__ void diff_item(const Ctx& a, int l, int grp, int h, int qb, int lane) {
    const bf16_t* cols = (const bf16_t*)(a.ws + WS_BIG); bf16_t* yo = (bf16_t*)(a.ws + WS_YBR) + (size_t)1 * M * 512;
    const bool lat = grp >= 32; const int b = lat ? grp - 32 : grp, L = lat ? 1024 : 256, rb = lat ? 8192 + b * 1024 : b * 256;
    const int qi = lane >> 2, eq = lane & 3, t = qb * 16 + qi, row = rb + t;
    const float* dl = inp(a, I_DLAM) + l * 256; float s01 = 0.f, s23 = 0.f;
    for (int i = 0; i < 64; ++i) { s01 += dl[i] * dl[64 + i]; s23 += dl[128 + i] * dl[192 + i]; }
    const float lam_init = 0.8f - 0.6f * expf(-0.3f * (float)l), lam = expf(s01) - expf(s23) + lam_init;
    float out[32];
#pragma unroll 1
    for (int c = 0; c < 2; ++c) {
        float q[64]; ld64bf(cols + (size_t)row * NMIX + C_DQ + (h * 2 + c) * 64, q);
        float acc[32];
#pragma unroll
        for (int i = 0; i < 32; ++i) acc[i] = 0.f;
        float m = -1e30f, lsum = 0.f;
#pragma unroll 1
        for (int j = 0; j < L; ++j) { const bf16_t* kr = cols + (size_t)(rb + j) * NMIX; const float s = dot64bf(kr + C_DK + (h * 2 + c) * 64, q) * 0.125f;
            if (s > m) { const float f_ = __expf(m - s); lsum *= f_;
#pragma unroll
                for (int i = 0; i < 32; ++i) acc[i] *= f_;
                m = s; }
            const float p_ = __expf(s - m); lsum += p_;
            const uint4* r = (const uint4*)(kr + C_DV + h * 128 + eq * 32);
#pragma unroll
            for (int i = 0; i < 4; ++i) { const uint4 u = r[i];
                acc[8 * i + 0] += p_ * bf_lo(u.x); acc[8 * i + 1] += p_ * bf_hi(u.x); acc[8 * i + 2] += p_ * bf_lo(u.y); acc[8 * i + 3] += p_ * bf_hi(u.y);
                acc[8 * i + 4] += p_ * bf_lo(u.z); acc[8 * i + 5] += p_ * bf_hi(u.z); acc[8 * i + 6] += p_ * bf_lo(u.w); acc[8 * i + 7] += p_ * bf_hi(u.w); } }
        if (lat) {
#pragma unroll 1
            for (int j = 0; j < 512; ++j) { const float* kp = inp(a, I_CDK) + (((((size_t)b * 2 + l) * 512 + j) * 4 + h) * 2 + c) * 64; const float4* vp = (const float4*)(inp(a, I_CDV) + ((((size_t)b * 2 + l) * 512 + j) * 4 + h) * 128 + eq * 32);
                const float s = dot64f(kp, q) * 0.125f;
                if (s > m) { const float f_ = __expf(m - s); lsum *= f_;
#pragma unroll
                    for (int i = 0; i < 32; ++i) acc[i] *= f_;
                    m = s; }
                const float p_ = __expf(s - m); lsum += p_;
#pragma unroll
                for (int i = 0; i < 8; ++i) { const float4 u = vp[i]; acc[4 * i + 0] += p_ * u.x; acc[4 * i + 1] += p_ * u.y; acc[4 * i + 2] += p_ * u.z; acc[4 * i + 3] += p_ * u.w; } } }
        const float inv = 1.0f / lsum;
        if (c == 0) {
#pragma unroll
            for (int i = 0; i < 32; ++i) out[i] = acc[i] * inv; }
        else {
#pragma unroll
            for (int i = 0; i < 32; ++i) out[i] -= lam * (acc[i] * inv); }
    }
    float ss = 0.f;
#pragma unroll
    for (int i = 0; i < 32; ++i) ss += out[i] * out[i];
    ss += __shfl_xor(ss, 1); ss += __shfl_xor(ss, 2);
    const float rs = (1.0f / sqrtf(ss * (1.0f / 128.0f) + EPS)) * (1.0f - lam_init); const float* sg = inp(a, I_DSUB) + l * 128 + eq * 32;
    uint4* dst = (uint4*)(yo + (size_t)row * 512 + h * 128 + eq * 32);
#pragma unroll
    for (int i = 0; i < 4; ++i) { uint4 u; u.x = pk2(out[8 * i + 0] * rs * sg[8 * i + 0], out[8 * i + 1] * rs * sg[8 * i + 1]); u.y = pk2(out[8 * i + 2] * rs * sg[8 * i + 2], out[8 * i + 3] * rs * sg[8 * i + 3]);
        u.z = pk2(out[8 * i + 4] * rs * sg[8 * i + 4], out[8 * i + 5] * rs * sg[8 * i + 5]); u.w = pk2(out[8 * i + 6] * rs * sg[8 * i + 6], out[8 * i + 7] * rs * sg[8 * i + 7]); dst[i] = u; }
}
__device__ __forceinline__ void win_item(const Ctx& a, int l, int grp, int hq, int qb, int lane) {
    const bf16_t* cols = (const bf16_t*)(a.ws + WS_BIG); bf16_t* yo = (bf16_t*)(a.ws + WS_YBR) + (size_t)2 * M * 512;
    const bool lat = grp >= 32; const int b = lat ? grp - 32 : grp, L = lat ? 1024 : 256, rb = lat ? 8192 + b * 1024 : b * 256;
    const int t = qb * 64 + lane, row = rb + t, hkv = hq >> 2;
    float q[64]; ld64bf(cols + (size_t)row * NMIX + C_WQ + hq * 64, q);
    float acc[64];
#pragma unroll
    for (int i = 0; i < 64; ++i) acc[i] = 0.f;
    float m = inp(a, I_WSINK)[l * 8 + hq], lsum = 1.0f;
    const int jlo = lat ? max(0, qb * 64 - 128) : 0, jhi = lat ? min(L - 1, qb * 64 + 63 + 128) : L - 1;
    for (int j = jlo; j <= jhi; ++j) { const bf16_t* kr = cols + (size_t)(rb + j) * NMIX; const float s = dot64bf(kr + C_WK + hkv * 64, q) * 0.125f;
        const int dd = t - j; const bool ok = !lat || (dd <= 128 && dd >= -128);
        if (ok) { ONLINE_UPDATE(s, axpy64bf(p_, kr + C_WV + hkv * 64, acc)); } }
    if (lat) for (int j = 0; j < 512; ++j) { const size_t o = ((((size_t)b * 2 + l) * 512 + j) * 2 + hkv) * 64; const float s = dot64f(inp(a, I_CWK) + o, q) * 0.125f; ONLINE_UPDATE(s, axpy64f(p_, inp(a, I_CWV) + o, acc)); }
    const float inv = 1.0f / lsum;
#pragma unroll
    for (int i = 0; i < 64; ++i) acc[i] *= inv;
    st64bf(yo + (size_t)row * 512 + hq * 64, acc);
}
__device__ __forceinline__ void ret_item(const Ctx& a, int l, int grp, int h, int qb, int lane, LAS float* qs  ) {
    const bf16_t* cols = (const bf16_t*)(a.ws + WS_BIG); bf16_t* yo = (bf16_t*)(a.ws + WS_YBR) + (size_t)3 * M * 512;
    const bool lat = grp >= 32; const int b = lat ? grp - 32 : grp, L = lat ? 1024 : 256, rb = lat ? 8192 + b * 1024 : b * 256;
    const int qi = lane >> 1, eh = lane & 1, t = qb * 32 + qi, row = rb + t;
    const float lgf = -log1pf(expf(-inp(a, I_RDF)[l * 4 + h])), lgb = -log1pf(expf(-inp(a, I_RDB)[l * 4 + h]));
    float q[64]; ld64bf(cols + (size_t)row * NMIX + C_RQ + h * 64, q);
    float acc[64];
#pragma unroll
    for (int i = 0; i < 64; ++i) acc[i] = 0.f;
    for (int s = 0; s < L; ++s) { const bf16_t* kr = cols + (size_t)(rb + s) * NMIX; const int d = t - s;
        const float w = (d >= 0 ? __expf((float)d * lgf) : 0.f) + (d <= 0 ? __expf((float)(-d) * lgb) : 0.f);
        const float dt = dot64bf(kr + C_RK + h * 64, q) * 0.125f; axpy64bf(w * dt, kr + C_RV + h * 128 + eh * 64, acc); }
    if (lat) { const float* Sf = inp(a, I_SRF) + ((((size_t)b * 2 + l) * 4 + h) * 64) * 128 + eh * 64; const float* Sb = inp(a, I_SRB) + ((((size_t)b * 2 + l) * 4 + h) * 64) * 128 + eh * 64;
        const float wf = expf((float)(t + 1) * lgf), wb = expf((float)(L - t) * lgb);
#pragma unroll
        for (int i = 0; i < 64; ++i) qs[lane * 65 + i] = q[i];
        LDS_WAIT(); asm volatile("" ::: "memory");
#pragma unroll 1
        for (int d = 0; d < 64; ++d) { const float qd = qs[lane * 65 + d]; const float qf = qd * wf, qb2 = qd * wb; const float4* pf = (const float4*)(Sf + (size_t)d * 128); const float4* pb = (const float4*)(Sb + (size_t)d * 128);
#pragma unroll
            for (int i = 0; i < 16; ++i) { const float4 u = pf[i], v = pb[i]; acc[4 * i + 0] += qf * u.x + qb2 * v.x; acc[4 * i + 1] += qf * u.y + qb2 * v.y; acc[4 * i + 2] += qf * u.z + qb2 * v.z; acc[4 * i + 3] += qf * u.w + qb2 * v.w;
                if ((i & 3) == 3) asm volatile("" ::: "memory"); } }
        LDS_WAIT(); asm volatile("" ::: "memory"); }
    float ss = 0.f;
#pragma unroll
    for (int i = 0; i < 64; ++i) ss += acc[i] * acc[i];
    ss += __shfl_xor(ss, 1);
    const float rs = 1.0f / sqrtf(ss * (1.0f / 128.0f) + EPS);
    float g[64]; ld64bf(cols + (size_t)row * NMIX + C_RG + h * 128 + eh * 64, g);
#pragma unroll
    for (int i = 0; i < 64; ++i) { const float gv = g[i]; acc[i] = acc[i] * rs * (gv / (1.0f + __expf(-gv))); }
    st64bf(yo + (size_t)row * 512 + h * 128 + eh * 64, acc);
}
__device__ __forceinline__ void retstate_thread(const Ctx& a, int l, int idx) {
    const bf16_t* cols = (const bf16_t*)(a.ws + WS_BIG);
    const int e = idx & 127, d = (idx >> 7) & 63, h = (idx >> 13) & 3, b = idx >> 15;
    const float lgf = -log1pf(expf(-inp(a, I_RDF)[l * 4 + h])), lgb = -log1pf(expf(-inp(a, I_RDB)[l * 4 + h]));
    float sf = 0.f, sb = 0.f;
    for (int s = 0; s < 256; ++s) { const bf16_t* kr = cols + (size_t)(b * 256 + s) * NMIX; const float kv = bf2f(kr[C_RK + h * 64 + d]) * 0.125f * bf2f(kr[C_RV + h * 128 + e]);
        sf += __expf((float)(255 - s) * lgf) * kv; sb += __expf((float)s * lgb) * kv; }
    const size_t o = ((((size_t)b * 2 + l) * 4 + h) * 64 + d) * 128 + e;
    a.out[O_RF + o] = sf; a.out[O_RB + o] = sb;
}
__device__ __forceinline__ void hy2_thread(const Ctx& a, int l, int idx) {
    const bf16_t* cols = (const bf16_t*)(a.ws + WS_BIG); bf16_t* yo = (bf16_t*)(a.ws + WS_YBR);
    const bool lat = idx >= 524288; const int i2 = lat ? idx - 524288 : idx, c = i2 & 511, L = lat ? 1024 : 256, ng = L >> 3, tg = (i2 >> 9) % ng, b = (i2 >> 9) / ng;
    const int rb = lat ? 8192 + b * 1024 : b * 256, t0 = tg * 8;
    const float* G = (const float*)(a.ws + WS_FILT) + (size_t)l * (2560 * 512) + (lat ? 512 * 512 : 0) + c;
    const float* Z = (const float*)(a.ws + WS_ZB) + (size_t)rb * 512 + c;
    float w[8], acc[8];
#pragma unroll
    for (int i = 0; i < 8; ++i) { acc[i] = 0.f; w[i] = G[(size_t)(t0 + i + L - 1) * 512]; }
#pragma unroll 8
    for (int s = 0; s < L; ++s) { const float z = Z[(size_t)s * 512];
#pragma unroll
        for (int i = 0; i < 8; ++i) acc[i] += w[i] * z;
#pragma unroll
        for (int i = 7; i >= 1; --i) w[i] = w[i - 1];
        const int jn = t0 - (s + 1) + L - 1; w[0] = G[(size_t)(jn < 0 ? 0 : jn) * 512]; }
    const float* cw = inp(a, I_HCW) + l * 3 * 1536; const float cb = inp(a, I_HCB)[l * 1536 + 512 + c], sk = inp(a, I_HSKIP)[l * 512 + c];
    const float w0 = cw[512 + c], w1 = cw[1536 + 512 + c], w2 = cw[3072 + 512 + c];
#pragma unroll
    for (int i = 0; i < 8; ++i) { const int t = t0 + i; const bf16_t* p = cols + (size_t)(rb + t) * NMIX + 512 + c;
        const float xm = t > 0 ? bf2f(p[-NMIX]) : 0.f, x0 = bf2f(p[0]), xp = t < L - 1 ? bf2f(p[NMIX]) : 0.f;
        const float x0c = xm * w0 + x0 * w1 + xp * w2 + cb; const float y = acc[i] + sk * Z[(size_t)t * 512];
        yo[(size_t)(rb + t) * 512 + c] = (bf16_t)f2bf(x0c * y); }
}
#define LAUNDER_MIX() do { unsigned long long w_ = (unsigned long long)a.ws, o_ = (unsigned long long)a.out; unsigned t_ = (unsigned)(size_t)a.tab; \
    asm volatile("" : "+s"(w_), "+s"(o_), "+s"(t_), "+s"(l), "+s"(gw), "+s"(NGW)); asm volatile("" : "+v"(lane)); a.ws = (unsigned char*)w_; a.out = (float*)o_; a.tab = (const LAS unsigned long long*)(size_t)t_; } while (0)
__device__ __forceinline__ void phase_mix(const Ctx& a0, int l, LAS unsigned char* lds, int bid, int nblk, int tid) {
    int lane = tid & 63; const int wave = __builtin_amdgcn_readfirstlane(tid >> 6); int gw = bid * 8 + wave, NGW = nblk * 8;
    LAS float* qs = (LAS float*)(lds + wave * 16640);
    Ctx a = a0;
    LAUNDER_MIX();
#pragma unroll 1
    for (int r = gw; r < 4096; r += NGW) { if (r < 2048) diff_item(a, l, 32 + (r >> 8), (r >> 6) & 3, r & 63, lane); else { const int q = r - 2048; diff_item(a, l, q >> 6, (q >> 4) & 3, q & 15, lane); } }
    LAUNDER_MIX();
#pragma unroll 1
    for (int r = gw; r < 2048; r += NGW) { if (r < 1024) ret_item(a, l, 32 + (r >> 7), (r >> 5) & 3, r & 31, lane, qs); else { const int q = r - 1024; ret_item(a, l, q >> 5, (q >> 3) & 3, q & 7, lane, qs); } }
    LAUNDER_MIX();
#pragma unroll 1
    for (int r = gw; r < 2048; r += NGW) { if (r < 1024) win_item(a, l, 32 + (r >> 7), (r >> 4) & 7, r & 15, lane); else { const int q = r - 1024; win_item(a, l, q >> 5, (q >> 2) & 7, q & 3, lane); } }
    LAUNDER_MIX();
#pragma unroll 1
    for (int r = gw; r < 16384; r += NGW) hy2_thread(a, l, r * 64 + lane);
    LAUNDER_MIX();
#pragma unroll 1
    for (int r = gw; r < 16384; r += NGW) retstate_thread(a, l, r * 64 + lane);
}
template <class Epi> __device__ __forceinline__ void run_gemm(LAS unsigned char* lds, const bf16_t* A, const bf16_t* Bt, int N, int K, const Epi& E, int bid, int nblk) {
    pg8::Gemm g{A, Bt, M, N, K}; pg8::StaticOrder S; S.init(M, N, nblk, bid);
    pg8::gemm_phase<Epi, pg8::StaticOrder, false>(lds, g, S, E, nullptr);
}
#define XB_TMO      128
#define XB_XCNT(j)  (256  + 64 * (j))
#define XB_XSUB(j)  (1280 + 64 * (j))
#define XB_XGEN(j)  (2304 + 64 * (j))
#define XB_TOP      3328
#define XB_TOPGEN   3392
#define XCD_BAR_WORDS 3456
#define XB_SPIN_CAP (1u << 18)

__device__ __forceinline__ unsigned xb_ld(unsigned* p)              { return __hip_atomic_load(p, __ATOMIC_RELAXED, __HIP_MEMORY_SCOPE_AGENT); }
__device__ __forceinline__ unsigned xb_add(unsigned* p, unsigned v) { return __hip_atomic_fetch_add(p, v, __ATOMIC_RELAXED, __HIP_MEMORY_SCOPE_AGENT); }
__device__ __forceinline__ unsigned xb_xcc_id() { return (unsigned)__builtin_amdgcn_s_getreg((3 << 11) | 20) & 0xFu; }
#define XB_SPIN(cond, bar) do { unsigned _sp = 0; while (cond) { __builtin_amdgcn_s_sleep(1); \
    if ((++_sp & 255u) == 0u) { if (xb_ld(&(bar)[XB_TMO])) break; if (_sp > XB_SPIN_CAP) { atomicAdd(&(bar)[XB_TMO], 1u); break; } } } } while (0)

struct XcdBarrier {
    unsigned* bar; unsigned x;
    volatile LAS unsigned* st;
};

__device__ __forceinline__ XcdBarrier xcd_barrier_post(unsigned* bar, volatile LAS unsigned* st) {
    XcdBarrier b; b.bar = bar; b.x = xb_xcc_id(); b.st = st;
    if (threadIdx.x == 0) (void)xb_add(&bar[XB_XCNT(b.x)], 1u);
    return b;
}
__device__ __forceinline__ void xcd_barrier_complete(unsigned* bar, unsigned x, unsigned& nloc, unsigned& nx) {
    const unsigned G = gridDim.x * gridDim.y * gridDim.z;
    unsigned sum, cnt, mine, sp = 0u;
    for (;;) {
        sum = 0u; cnt = 0u; mine = 0u;
#pragma unroll
        for (unsigned j = 0; j < 16; ++j) { const unsigned c = xb_ld(&bar[XB_XCNT(j)]); sum += c; cnt += (c > 0u) ? 1u : 0u; mine = (j == x) ? c : mine; }
        if (sum == G) break;
        __builtin_amdgcn_s_sleep(1);
        if ((++sp & 255u) == 0u) { if (xb_ld(&bar[XB_TMO])) break; if (sp > XB_SPIN_CAP) { atomicAdd(&bar[XB_TMO], 1u); break; } }
    }
    nloc = mine > 0u ? mine : 1u; nx = cnt > 0u ? cnt : 1u;
}

__device__ __forceinline__ void xcd_barrier(const XcdBarrier& b) {
    asm volatile("s_waitcnt vmcnt(0)" ::: "memory");
    __syncthreads();
    if (threadIdx.x == 0) {
        unsigned* bar = b.bar;
        __builtin_amdgcn_s_waitcnt(0);
        unsigned nloc = b.st[0], nx = b.st[1];
        if (nloc == 0u) { xcd_barrier_complete(bar, b.x, nloc, nx); b.st[0] = nloc; b.st[1] = nx; }
        const unsigned old = xb_add(&bar[XB_XSUB(b.x)], 1u);
        const unsigned gen = old / nloc;
        if (old + 1u == (gen + 1u) * nloc) {
            __builtin_amdgcn_fence(__ATOMIC_RELEASE, "agent");
            asm volatile("s_waitcnt vmcnt(0)" ::: "memory");
            const unsigned og = xb_add(&bar[XB_TOP], 1u);
            const unsigned tg = og / nx;
            if (og + 1u == (tg + 1u) * nx) xb_add(&bar[XB_TOPGEN], 1u);
            else XB_SPIN(xb_ld(&bar[XB_TOPGEN]) == tg, bar);
            __builtin_amdgcn_fence(__ATOMIC_ACQUIRE, "agent");
            xb_add(&bar[XB_XGEN(b.x)], 1u);
            asm volatile("s_waitcnt vmcnt(0)" ::: "memory");
        } else {
            XB_SPIN(xb_ld(&bar[XB_XGEN(b.x)]) == gen, bar);
            __builtin_amdgcn_fence(__ATOMIC_ACQUIRE, "agent");
            asm volatile("s_waitcnt vmcnt(0)" ::: "memory");
        }
    }
    __syncthreads();
}

template <int SL> __device__ __forceinline__ void run_slot(const Ctx& a0, int l, LAS unsigned char* lds, int bid, int nblk, int tid) {
    Ctx a = a0;
    { unsigned long long w = (unsigned long long)a.ws, o = (unsigned long long)a.out; unsigned t = (unsigned)(size_t)a.tab, ld = (unsigned)(size_t)lds;
      asm volatile("" : "+s"(w), "+s"(o), "+s"(t), "+s"(ld), "+s"(l), "+s"(bid), "+s"(nblk)); asm volatile("" : "+v"(tid));
      a.ws = (unsigned char*)w; a.out = (float*)o; a.tab = (const LAS unsigned long long*)(size_t)t; lds = (LAS unsigned char*)(size_t)ld; }
    unsigned char* ws = a.ws; unsigned char* wb = ws + WS_W;
    bf16_t* H = (bf16_t*)(ws + WS_H); bf16_t* BIG = (bf16_t*)(ws + WS_BIG); bf16_t* YBR = (bf16_t*)(ws + WS_YBR);
    float* MERGEP = (float*)(ws + WS_BIG + 128 * MiB);
    const float* modl = (const float*)(ws + WS_MOD) + (size_t)l * 9 * 9216;
    if constexpr (SL == 0) phase_p0a(a, lds, bid, nblk, tid);
    if constexpr (SL == 1) phase_p0b(a, lds, bid, nblk, tid);
    if constexpr (SL == 2) { if (l == 1) convert_weights(a, 1, lds, bid * 8 + (tid >> 6), nblk * 8, tid >> 6, tid & 63); phase_norm(a, l, I_NFA, 0, bid, nblk, tid); }
    if constexpr (SL == 3) run_gemm(lds, H, (const bf16_t*)(wb + W_FA_IN), 2 * DFF, D, pg8::EpiSwiGLU{BIG, DFF}, bid, nblk);
    if constexpr (SL == 4) run_gemm(lds, BIG, (const bf16_t*)(wb + W_FA_OUT), D, DFF, pg8::EpiResid{a.out, modl + 2 * 1024, 0.5f}, bid, nblk);
    if constexpr (SL == 5) phase_norm(a, l, I_NMIX, 3, bid, nblk, tid);
    if constexpr (SL == 6) run_gemm(lds, H, (const bf16_t*)(wb + W_IN), NMIX, D, pg8::EpiStore<0>{BIG, NMIX}, bid, nblk);
    if constexpr (SL == 7) phase_prep(a, l, bid, nblk, tid);
    if constexpr (SL == 8) phase_mix(a, l, lds, bid, nblk, tid);
    if constexpr (SL == 9) run_gemm(lds, H, (const bf16_t*)(wb + W_IN) + (size_t)NMIX * D, NGATE, D, pg8::EpiStore<1>{BIG, NGATE}, bid, nblk);
    if constexpr (SL == 10) {
#pragma unroll 1
        for (int b = 0; b < 4; ++b) run_gemm(lds, YBR + (size_t)b * M * 512, (const bf16_t*)(wb + W_BR) + (size_t)b * D * 512, D, 512, pg8::EpiMerge{MERGEP, BIG, H, b * 1024, b == 0 ? 0 : (b == 3 ? 2 : 1)}, bid, nblk); }
    if constexpr (SL == 11) run_gemm(lds, H, (const bf16_t*)(wb + W_OUT), D, D, pg8::EpiResid{a.out, modl + 5 * 1024, 1.0f}, bid, nblk);
    if constexpr (SL == 12) phase_norm(a, l, I_NFB, 6, bid, nblk, tid);
    if constexpr (SL == 13) run_gemm(lds, H, (const bf16_t*)(wb + W_FB_IN), 2 * DFF, D, pg8::EpiSwiGLU{BIG, DFF}, bid, nblk);
    if constexpr (SL == 14) run_gemm(lds, BIG, (const bf16_t*)(wb + W_FB_OUT), D, DFF, pg8::EpiResid{a.out, modl + 8 * 1024, 0.5f}, bid, nblk);
}
template <int SL> __global__ void __launch_bounds__(512, 2) k_slot(Args a) {
    extern __shared__ __attribute__((aligned(16))) unsigned char lds_raw[];
    const Ctx c = make_ctx(a, (LAS unsigned char*)lds_raw, threadIdx.x);
    run_slot<SL>(c, a.ph_lo, (LAS unsigned char*)lds_raw, blockIdx.x, gridDim.x, threadIdx.x);
}

constexpr int CW_BAR = 4096;
__global__ void __launch_bounds__(512, 2) mega(Args a) {
    extern __shared__ __attribute__((aligned(16))) unsigned char lds_raw[];
    LAS unsigned char* lds = (LAS unsigned char*)lds_raw;
    const int tid = threadIdx.x, bid = blockIdx.x, nblk = gridDim.x;
    volatile LAS unsigned* st = (volatile LAS unsigned*)(lds + LDS_ST_OFF);
    const Ctx c = make_ctx(a, lds, tid);
    const XcdBarrier bar = xcd_barrier_post((unsigned*)(a.ws + WS_CTL) + CW_BAR, st);
#define GB() do { XcdBarrier b_ = bar; unsigned long long bp_ = (unsigned long long)b_.bar; unsigned bx_ = b_.x; asm volatile("" : "+s"(bp_), "+s"(bx_)); b_.bar = (unsigned*)bp_; b_.x = bx_; xcd_barrier(b_); } while (0)
#ifndef MEGA_MASK
#define MEGA_MASK 0x7fff
#endif
#define RS(k) if constexpr ((MEGA_MASK >> k) & 1) run_slot<k>
    RS(0)(c, 0, lds, bid, nblk, tid); GB();
    RS(1)(c, 0, lds, bid, nblk, tid); GB();
#pragma unroll 1
    for (int l = 0; l < 2; ++l) {
        RS(2)(c, l, lds, bid, nblk, tid); GB();
        RS(3)(c, l, lds, bid, nblk, tid); GB();
        RS(4)(c, l, lds, bid, nblk, tid); GB();
        RS(5)(c, l, lds, bid, nblk, tid); GB();
        RS(6)(c, l, lds, bid, nblk, tid); GB();
        RS(7)(c, l, lds, bid, nblk, tid); GB();
        RS(8)(c, l, lds, bid, nblk, tid); GB();
        RS(9)(c, l, lds, bid, nblk, tid); GB();
        RS(10)(c, l, lds, bid, nblk, tid); GB();
        RS(11)(c, l, lds, bid, nblk, tid); GB();
        RS(12)(c, l, lds, bid, nblk, tid); GB();
        RS(13)(c, l, lds, bid, nblk, tid); GB();
        RS(14)(c, l, lds, bid, nblk, tid); if (l == 0) GB();
    }
#undef GB
#undef RS
}
template <int SL> static void launch_slot(const Args& a, int grid, hipStream_t stream) {
    static bool attr = false;
    if (!attr) { (void)hipFuncSetAttribute((const void*)k_slot<SL>, hipFuncAttributeMaxDynamicSharedMemorySize, LDS_BYTES); attr = true; }
    hipLaunchKernelGGL(k_slot<SL>, dim3(grid), dim3(512), LDS_BYTES, stream, a);
}

#ifdef DIAG_YBR
__global__ void k_diag(Args a) {
    for (size_t i = (size_t)blockIdx.x * blockDim.x + threadIdx.x; i < (size_t)M * 1024; i += (size_t)gridDim.x * blockDim.x) { const size_t row = i >> 10, c = i & 1023;
#if DIAG_YBR < 4
        const bf16_t* y = (const bf16_t*)(a.ws + WS_YBR) + (size_t)DIAG_YBR * M * 512;
        a.out[i] = bf2f(y[(c >> 9) * (size_t)M * 512 + row * 512 + (c & 511)]);
#elif DIAG_YBR == 4
        a.out[i] = bf2f(((const bf16_t*)(a.ws + WS_H))[i]);
#elif DIAG_YBR >= 5 && DIAG_YBR < 9
        a.out[i] = bf2f(((const bf16_t*)(a.ws + WS_BIG))[row * 4096 + (DIAG_YBR - 5) * 1024 + c]);
#elif DIAG_YBR == 9
        a.out[i] = ((const float*)(a.ws + WS_BIG + 128 * MiB))[i];
#elif DIAG_YBR >= 10 && DIAG_YBR < 15
        a.out[i] = bf2f(((const bf16_t*)(a.ws + WS_BIG))[row * 5376 + (DIAG_YBR - 10) * 1024 + c]);
#elif DIAG_YBR >= 15 && DIAG_YBR < 17
        a.out[i] = bf2f(((const bf16_t*)(a.ws + WS_BIG))[row * 2816 + (DIAG_YBR - 15) * 1024 + c]);
#endif
    }
}
#endif
extern "C" void kernel_launch(void* const* d_in, const int* in_sizes, int n_in, void* d_out, int out_size, void* d_ws, size_t ws_size, hipStream_t stream) {
    static int grid = 0;
    if (grid == 0) {
        if (n_in != N_IN || out_size != (int)O_END || ws_size < WS_END) { fprintf(stderr, "kernel_launch: unexpected shapes: n_in %d out %d ws %zu (need %zu)\n", n_in, out_size, ws_size, (size_t)WS_END); grid = -1; return; }
        int dev = 0, cus = 0;
        if (hipGetDevice(&dev) != hipSuccess || hipDeviceGetAttribute(&cus, hipDeviceAttributeMultiprocessorCount, dev) != hipSuccess) { grid = -1; return; }
        grid = cus > 0 ? cus : 256;
    }
    if (grid < 0) return;
    (void)hipMemsetAsync((char*)d_ws + WS_CTL, 0, CTL_ZERO_BYTES, stream);
    Args a{};
    for (int i = 0; i < N_IN; ++i) a.in[i] = (const float*)d_in[i];
    a.out = (float*)d_out; a.ws = (unsigned char*)d_ws;
    a.ph_lo = 0; a.ph_hi = 0;
#ifndef MULTI_LAUNCH
    { static bool attr = false; if (!attr) { (void)hipFuncSetAttribute((const void*)mega, hipFuncAttributeMaxDynamicSharedMemorySize, LDS_BYTES); attr = true; }
      hipLaunchKernelGGL(mega, dim3(grid), dim3(512), LDS_BYTES, stream, a); return; }
#endif
    int nl = 0;
#ifndef STOP_AFTER
#define STOP_AFTER 1000
#endif
#define LS(k) do { if (nl++ < STOP_AFTER) launch_slot<k>(a, grid, stream); } while (0)
    LS(0); LS(1);
    for (int l = 0; l < 2; ++l) { a.ph_lo = l;
        LS(2); LS(3); LS(4); LS(5); LS(6); LS(7); LS(8); LS(9); LS(10); LS(11); LS(12); LS(13); LS(14); }
#ifdef DIAG_YBR
    hipLaunchKernelGGL(k_diag, dim3(1024), dim3(256), 0, stream, a);
#endif
}
```

```cpp
#include <hip/hip_runtime.h>
#include <cstdio>
#include <cstdint>
namespace pg8 {
#define PG8_LAS __attribute__((address_space(3)))
typedef unsigned short bf16_t;
typedef short bf16x8 __attribute__((ext_vector_type(8)));
typedef float f32x4 __attribute__((ext_vector_type(4)));
typedef unsigned u32x4 __attribute__((ext_vector_type(4)));
constexpr int BM = 256, BK = 64, HALF = 128, HTB = HALF * BK * 2  , STAGE_BYTES = 8 * HTB, NXCD = 8, WGM = 8;

__host__ __device__ __forceinline__ int lds_byte(int r, int c) { const int st = (r >> 4) * 2 + (c >> 5), rr = r & 15, cc = c & 31, ob = rr * 64 + cc * 2; return st * 1024 + (ob ^ (((ob >> 9) & 1) << 5)); }
__host__ __device__ __forceinline__ void stage_rc(int b, int& R, int& C) { const int st = b / 1024, sb = b % 1024, swz = sb ^ (((sb >> 9) & 1) << 5); R = (st >> 1) * 16 + swz / 64; C = (st & 1) * 32 + (swz % 64) / 2; }
__host__ __device__ __forceinline__ int perm32(int rho) { const int n = rho >> 4, i = rho & 15; return 8 * (i >> 2) + 4 * n + (i & 3); }

struct Unit { int pm, pn; };
struct Gemm { const bf16_t* A; const bf16_t* Bt; int M, N, K; };

struct StaticOrder {
    int nM, nN, nwg, G, c;
    __host__ __device__ void init(int M, int N, int G_, int c_) { nM = M / BM; nN = N / BM; nwg = nM * nN; G = G_; c = c_; }
    __host__ __device__ bool next(int i, Unit& u) const {
        const long L = (long)i * G + c; if (L >= nwg) return false;
        int wgid = (int)L; { const int q = nwg / NXCD, r = nwg % NXCD, xcd = wgid % NXCD, off = wgid / NXCD; wgid = (xcd < r ? xcd * (q + 1) : r * (q + 1) + (xcd - r) * q) + off; }
        const int nig = WGM * nN, gid = wgid / nig, fm = gid * WGM, gsz = (nM - fm) < WGM ? (nM - fm) : WGM;
        u.pm = fm + ((wgid % nig) % gsz); u.pn = (wgid % nig) / gsz; return true;
    }
    __device__ __forceinline__ void a_ready(const Unit&) const {}
    __device__ __forceinline__ void done(const Unit&) const {}
};
typedef __bf16 bf16x2n __attribute__((ext_vector_type(2)));
typedef float f32x2n __attribute__((ext_vector_type(2)));
__device__ __forceinline__ unsigned cvt_pk_bf16(float lo, float hi) { f32x2n v = {lo, hi}; bf16x2n b = __builtin_convertvector(v, bf16x2n); return __builtin_bit_cast(unsigned, b); }
typedef float f32x2 __attribute__((ext_vector_type(2)));
typedef unsigned u32x2 __attribute__((ext_vector_type(2)));
__device__ __forceinline__ float fast_sigmoid(float a) { return __builtin_amdgcn_rcpf(1.0f + __expf(-a)); }
__device__ __forceinline__ float bf_lo(unsigned u) { return __uint_as_float(u << 16); }
__device__ __forceinline__ float bf_hi(unsigned u) { return __uint_as_float(u & 0xffff0000u); }

struct EpiSwiGLU {
    static constexpr bool PERM = true, AFTER_DRAIN = false;
    bf16_t* O; int ldo;
    __device__ __forceinline__ void operator()(const f32x4 (&acc)[2][2][4][2], const Unit& u, int wr, int wc, int fr, int fq) const {
        const int row0 = u.pm * BM + wr * 64 + fr, col0 = u.pn * HALF + wc * 32 + 8 * fq;
#pragma unroll
        for (int ai = 0; ai < 2; ++ai)
#pragma unroll
            for (int m = 0; m < 4; ++m) { bf16_t* rowp = O + (size_t)(row0 + ai * HALF + m * 16) * ldo + col0;
                f32x4 v0, v1;
#pragma unroll
                for (int j = 0; j < 4; ++j) { const float a0 = acc[ai][0][m][0][j], a1 = acc[ai][0][m][1][j];
                    v0[j] = a0 * fast_sigmoid(a0) * acc[ai][1][m][0][j]; v1[j] = a1 * fast_sigmoid(a1) * acc[ai][1][m][1][j]; }
                u32x4 w; w.x = cvt_pk_bf16(v0[0], v0[1]); w.y = cvt_pk_bf16(v0[2], v0[3]); w.z = cvt_pk_bf16(v1[0], v1[1]); w.w = cvt_pk_bf16(v1[2], v1[3]);
                *(u32x4*)rowp = w; }
    }
};
struct EpiResid {
    static constexpr bool PERM = false, AFTER_DRAIN = false;
    float* X; const float* gate; float coef;
    __device__ __forceinline__ void operator()(const f32x4 (&acc)[2][2][4][2], const Unit& u, int wr, int wc, int fr, int fq) const {
        const int row0 = u.pm * BM + wr * 64 + fr, col0 = u.pn * BM + wc * 32 + 4 * fq;
        const int mr = u.pm < 32 ? 0 : 1 + ((u.pm - 32) >> 2);
        const float* gp = gate + (size_t)mr * 9216 + col0;
        f32x4 gv[2][2];
#pragma unroll
        for (int bj = 0; bj < 2; ++bj)
#pragma unroll
            for (int n = 0; n < 2; ++n) gv[bj][n] = *(const f32x4*)(gp + bj * HALF + n * 16) * coef;
#pragma unroll
        for (int ai = 0; ai < 2; ++ai)
#pragma unroll
            for (int m = 0; m < 4; ++m) { float* rowp = X + (size_t)(row0 + ai * HALF + m * 16) * 1024 + col0;
#pragma unroll
                for (int bj = 0; bj < 2; ++bj)
#pragma unroll
                    for (int n = 0; n < 2; ++n) { f32x4* p = (f32x4*)(rowp + bj * HALF + n * 16); *p = *p + gv[bj][n] * acc[ai][bj][m][n]; } }
    }
};
template <int ACT> struct EpiStore {
    static constexpr bool PERM = true, AFTER_DRAIN = false;
    bf16_t* O; int ldo;
    __device__ __forceinline__ void operator()(const f32x4 (&acc)[2][2][4][2], const Unit& u, int wr, int wc, int fr, int fq) const {
        const int row0 = u.pm * BM + wr * 64 + fr, col0 = u.pn * BM + wc * 32 + 8 * fq;
#pragma unroll
        for (int ai = 0; ai < 2; ++ai)
#pragma unroll
            for (int m = 0; m < 4; ++m) { bf16_t* rowp = O + (size_t)(row0 + ai * HALF + m * 16) * ldo + col0;
#pragma unroll
                for (int bj = 0; bj < 2; ++bj) { f32x4 v0 = acc[ai][bj][m][0], v1 = acc[ai][bj][m][1];
                    if (ACT == 1) {
#pragma unroll
                        for (int j = 0; j < 4; ++j) { v0[j] = fast_sigmoid(v0[j]); v1[j] = fast_sigmoid(v1[j]); } }
                    u32x4 w; w.x = cvt_pk_bf16(v0[0], v0[1]); w.y = cvt_pk_bf16(v0[2], v0[3]); w.z = cvt_pk_bf16(v1[0], v1[1]); w.w = cvt_pk_bf16(v1[2], v1[3]);
                    *(u32x4*)(rowp + bj * HALF) = w; } }
    }
};
struct EpiMerge {
    static constexpr bool PERM = false, AFTER_DRAIN = false;
    float* P; const bf16_t* G; bf16_t* O; int goff; int mode;
    __device__ __forceinline__ void operator()(const f32x4 (&acc)[2][2][4][2], const Unit& u, int wr, int wc, int fr, int fq) const {
        const int row0 = u.pm * BM + wr * 64 + fr, col0 = u.pn * BM + wc * 32 + 4 * fq;
#pragma unroll
        for (int ai = 0; ai < 2; ++ai)
#pragma unroll
            for (int m = 0; m < 4; ++m) { const size_t r = (size_t)(row0 + ai * HALF + m * 16);
#pragma unroll
                for (int bj = 0; bj < 2; ++bj)
#pragma unroll
                    for (int n = 0; n < 2; ++n) { const int c = col0 + bj * HALF + n * 16;
                        const u32x2 gw = *(const u32x2*)(G + r * 4096 + goff + c);
                        f32x4 g; g[0] = bf_lo(gw.x); g[1] = bf_hi(gw.x); g[2] = bf_lo(gw.y); g[3] = bf_hi(gw.y);
                        f32x4 v = g * acc[ai][bj][m][n];
                        f32x4* pp = (f32x4*)(P + r * 1024 + c);
                        if (mode != 0) v = v + *pp;
                        if (mode != 2) *pp = v;
                        else { u32x2 w; w.x = cvt_pk_bf16(v[0], v[1]); w.y = cvt_pk_bf16(v[2], v[3]); *(u32x2*)(O + r * 1024 + c) = w; } } }
    }
};
template <class Epi, class Sched, bool STAMP = false>
__device__ __forceinline__ void gemm_phase(PG8_LAS unsigned char* lds, const Gemm g, const Sched& S, const Epi& E, unsigned long long* stamps) {
    const int tid = threadIdx.x, wid = __builtin_amdgcn_readfirstlane(tid >> 6), lane = tid & 63, wr = wid >> 2, wc = wid & 3, fr = lane & 15, fq = lane >> 4;
    const int K = g.K, nt = K / BK;
    int ts_lo = 0, ts_hi = 0, nts = 0; const unsigned long long rt_entry = STAMP ? (unsigned long long)wall_clock64() : 0ull;
#define PG8_STAMP() do { if (STAMP && wid == 0 && nts < 64) { const unsigned long long _c = (unsigned long long)clock64(); \
        ts_lo = (lane == nts) ? (int)(unsigned)_c : ts_lo; ts_hi = (lane == nts) ? (int)(unsigned)(_c >> 32) : ts_hi; ++nts; } } while (0)
    PG8_STAMP();
    unsigned voffA[2], voffB[2];
#pragma unroll
    for (int i = 0; i < 2; ++i) { int R, C; stage_rc(tid * 16 + i * 8192, R, C); const int Rb = Epi::PERM ? ((R & ~31) + perm32(R & 31)) : R;
        voffA[i] = (unsigned)(R * K + C) * 2u; voffB[i] = (unsigned)(Rb * K + C) * 2u; }
    const size_t kstep = (size_t)(BK * 2);
    const size_t hstep = (size_t)HALF * K * 2;
    const size_t tstep = 2 * hstep;
    const unsigned ldsw = (unsigned)wid * 1024u;
    const int aoff = lds_byte(wr * 64 + fr, fq * 8), boff = lds_byte(wc * 32 + fr, fq * 8);
#define PG8_SA(b, h) (((b) * 2 + (h)) * HTB)
#define PG8_SB(b, h) ((4 + (b) * 2 + (h)) * HTB)
#define PG8_STAGE(bufoff, gbase, voff) do { _Pragma("unroll") for (int _i = 0; _i < 2; ++_i) \
        __builtin_amdgcn_global_load_lds((const unsigned*)((const char*)(gbase) + (voff)[_i]), (PG8_LAS unsigned*)(lds + (bufoff) + ldsw + _i * 8192), 16, 0, 0); } while (0)
#define PG8_LDA(dst, b, h) do { _Pragma("unroll") for (int m = 0; m < 4; ++m) _Pragma("unroll") for (int k = 0; k < 2; ++k) dst[m][k] = *(const PG8_LAS bf16x8*)(lds + PG8_SA(b, h) + aoff + m * 2048 + k * 1024); } while (0)
#define PG8_LDB(dst, b, h) do { _Pragma("unroll") for (int n = 0; n < 2; ++n) _Pragma("unroll") for (int k = 0; k < 2; ++k) dst[n][k] = *(const PG8_LAS bf16x8*)(lds + PG8_SB(b, h) + boff + n * 2048 + k * 1024); } while (0)
#define PG8_MMA(ai, bj, At, Bt) do { __builtin_amdgcn_s_setprio(1); _Pragma("unroll") for (int m = 0; m < 4; ++m) _Pragma("unroll") for (int n = 0; n < 2; ++n) _Pragma("unroll") for (int k = 0; k < 2; ++k) \
        acc[ai][bj][m][n] = __builtin_amdgcn_mfma_f32_16x16x32_bf16(Bt[n][k], At[m][k], acc[ai][bj][m][n], 0, 0, 0); __builtin_amdgcn_s_setprio(0); } while (0)
#define PG8_WAIT_V(n) asm volatile("s_waitcnt vmcnt(" #n ")" ::: "memory")
#define PG8_WAIT_L(n) asm volatile("s_waitcnt lgkmcnt(" #n ")" ::: "memory")
#define PG8_BAR __builtin_amdgcn_s_barrier()
#define PG8_SCHED __builtin_amdgcn_sched_barrier(0)
    Unit cur, nxt; int ui = 0;
    if (!S.next(0, cur)) return;
    f32x4 acc[2][2][4][2];
#pragma unroll
    for (int a = 0; a < 2; ++a)
#pragma unroll
        for (int b = 0; b < 2; ++b)
#pragma unroll
            for (int m = 0; m < 4; ++m)
#pragma unroll
                for (int n = 0; n < 2; ++n) acc[a][b][m][n] = (f32x4){0.f, 0.f, 0.f, 0.f};
    bf16x8 At[4][2], B0[2][2], B1[2][2];
    const char* cA = (const char*)g.A + (size_t)cur.pm * tstep; const char* cB = (const char*)g.Bt + (size_t)cur.pn * tstep;
    S.a_ready(cur);
    PG8_STAGE(PG8_SB(0, 0), cB, voffB); PG8_STAGE(PG8_SA(0, 0), cA, voffA); PG8_STAGE(PG8_SB(0, 1), cB + hstep, voffB); PG8_STAGE(PG8_SA(0, 1), cA + hstep, voffA);
    if (wr == 1) PG8_BAR;
    PG8_WAIT_V(4); PG8_BAR;
    PG8_STAGE(PG8_SB(1, 0), cB + kstep, voffB); PG8_STAGE(PG8_SA(1, 0), cA + kstep, voffA); PG8_STAGE(PG8_SB(1, 1), cB + hstep + kstep, voffB);
    PG8_WAIT_V(6); PG8_BAR;
    PG8_STAMP();
    for (;;) {
        const bool has_next = S.next(ui + 1, nxt);
        const char* nA = has_next ? (const char*)g.A + (size_t)nxt.pm * tstep : cA; const char* nB = has_next ? (const char*)g.Bt + (size_t)nxt.pn * tstep : cB;
        for (int t = 0; t < nt; t += 2) {
            const bool last = (t == nt - 2);
            const char* a1 = cA + (size_t)(t + 1) * kstep;
            const char* a2 = last ? nA : cA + (size_t)(t + 2) * kstep; const char* b2 = last ? nB : cB + (size_t)(t + 2) * kstep;
            const char* a3 = a2 + kstep; const char* b3 = b2 + kstep;
            if (last && has_next) S.a_ready(nxt);
            PG8_LDB(B0, 0, 0); PG8_SCHED; PG8_LDA(At, 0, 0); PG8_STAGE(PG8_SA(1, 1), a1 + hstep, voffA);
            PG8_WAIT_L(8); PG8_BAR; PG8_WAIT_L(0); PG8_MMA(0, 0, At, B0); PG8_BAR; PG8_SCHED;
            PG8_LDB(B1, 0, 1); PG8_STAGE(PG8_SB(0, 0), b2, voffB);
            PG8_BAR; PG8_WAIT_L(0); PG8_MMA(0, 1, At, B1); PG8_BAR;
            PG8_LDA(At, 0, 1); PG8_STAGE(PG8_SA(0, 0), a2, voffA);
            PG8_BAR; PG8_WAIT_L(0); PG8_MMA(1, 0, At, B0); PG8_BAR; PG8_SCHED;
            PG8_STAGE(PG8_SB(0, 1), b2 + hstep, voffB);
            PG8_WAIT_V(6); PG8_BAR; PG8_MMA(1, 1, At, B1); PG8_BAR;
            PG8_LDB(B0, 1, 0); PG8_SCHED; PG8_LDA(At, 1, 0); PG8_STAGE(PG8_SA(0, 1), a2 + hstep, voffA);
            PG8_WAIT_L(8); PG8_BAR; PG8_WAIT_L(0); PG8_MMA(0, 0, At, B0); PG8_BAR; PG8_SCHED;
            PG8_LDB(B1, 1, 1); PG8_STAGE(PG8_SB(1, 0), b3, voffB);
            PG8_BAR; PG8_WAIT_L(0); PG8_MMA(0, 1, At, B1); PG8_BAR;
            PG8_LDA(At, 1, 1); PG8_STAGE(PG8_SA(1, 0), a3, voffA);
            PG8_BAR; PG8_WAIT_L(0); PG8_MMA(1, 0, At, B0); PG8_BAR; PG8_SCHED;
            PG8_STAGE(PG8_SB(1, 1), b3 + hstep, voffB);
            PG8_WAIT_V(6); PG8_BAR; PG8_MMA(1, 1, At, B1); PG8_BAR;
        }
        PG8_STAMP();
        if constexpr (!Epi::AFTER_DRAIN) { E(acc, cur, wr, wc, fr, fq); S.done(cur); }
        PG8_STAMP();
        if (!has_next) break;
#pragma unroll
        for (int a = 0; a < 2; ++a)
#pragma unroll
            for (int b = 0; b < 2; ++b)
#pragma unroll
                for (int m = 0; m < 4; ++m)
#pragma unroll
                    for (int n = 0; n < 2; ++n) acc[a][b][m][n] = (f32x4){0.f, 0.f, 0.f, 0.f};
        cur = nxt; cA = nA; cB = nB; ++ui;
    }
    PG8_WAIT_V(0);
    if (wr == 0) PG8_BAR;
    PG8_BAR;
    if constexpr (Epi::AFTER_DRAIN) { E.fused(acc, cur, wr, wc, fr, fq, lds, wid, lane); S.done(cur); }
    PG8_STAMP();
    if (STAMP && wid == 0) { stamps[lane] = lane < nts ? (((unsigned long long)(unsigned)ts_hi << 32) | (unsigned)ts_lo) : 0ull;
        if (lane == 62) stamps[62] = rt_entry; if (lane == 63) stamps[63] = (unsigned long long)wall_clock64(); }
#undef PG8_STAMP
#undef PG8_SA
#undef PG8_SB
#undef PG8_STAGE
#undef PG8_LDA
#undef PG8_LDB
#undef PG8_MMA
#undef PG8_WAIT_V
#undef PG8_WAIT_L
#undef PG8_BAR
#undef PG8_SCHED
}
}
#define LAS __attribute__((address_space(3)))
typedef pg8::bf16_t bf16_t;
typedef pg8::f32x4 f32x4;
typedef pg8::u32x4 u32x4;
typedef pg8::u32x2 u32x2;
using pg8::bf_lo; using pg8::bf_hi; using pg8::cvt_pk_bf16;
constexpr int D = 1024, M = 16384, DFF = 2816, NMIX = 5376, NGATE = 4096;
constexpr float EPS = 1e-6f;
constexpr int C_HY = 0, C_DQ = 1536, C_DK = 2048, C_DV = 2560, C_WQ = 3072, C_WK = 3584, C_WV = 3712, C_RQ = 3840, C_RK = 4096, C_RV = 4352, C_RG = 4864;
constexpr size_t O_DK = 16777216, O_DV = 25165824, O_WK = 33554432, O_WV = 35651584, O_RF = 37748736, O_RB = 39845888, O_END = 41943040;
constexpr size_t MiB = 1u << 20;
constexpr size_t WS_CTL = 0, CTL_ZERO_BYTES = 1 * MiB;
constexpr size_t WS_MODP = 1 * MiB, WS_MOD = 7 * MiB, WS_Z2 = 8 * MiB, WS_FILT = 9 * MiB, WS_W = 20 * MiB, WS_H = 78 * MiB, WS_BIG = 110 * MiB, WS_YBR = 302 * MiB, WS_ZB = 366 * MiB, WS_END = 398 * MiB;
constexpr size_t WS_KDC = 1 * MiB, WS_KWC = 5 * MiB, WS_ST = 6 * MiB;
constexpr size_t WS_GRT = 403 * MiB;
constexpr size_t WS_VTWL = 398 * MiB, WS_VTWC = 401 * MiB;
constexpr size_t WS_VTRL = 382 * MiB, WS_VTRC = 390 * MiB;
constexpr size_t WS_VTDL = WS_BIG + 168 * MiB, WS_VTDC = WS_VTDL + 12 * MiB;
constexpr size_t W_FA_IN = 0, W_FA_OUT = 11534336, W_FB_IN = 17301504, W_FB_OUT = 28835840, W_IN = 34603008, W_BR = 54001664, W_OUT = 58195968, W_END = 60293120;
static_assert(WS_W + W_END <= WS_H, "weights fit");
constexpr int NPHASE = 28;
enum InIdx { I_XP = 0, I_XS, I_C, I_CDK, I_CDV, I_CWK, I_CWV, I_SRF, I_SRB, I_CCTX, I_NFA, I_NMIX, I_NFB, I_WADA, I_BADA, I_WFAI, I_WFAO, I_WFBI, I_WFBO, I_WIN, I_HCW, I_HCB,
             I_HW1, I_HB1, I_HW2, I_HB2, I_HW3, I_HSKIP, I_DQN, I_DKN, I_DLAM, I_DSUB, I_WQN, I_WKN, I_WSINK, I_RDF, I_RDB, I_WBR, I_WOUT, N_IN };
struct Args { const float* in[N_IN]; float* out; unsigned char* ws; int ph_lo, ph_hi; };
struct Ctx { const LAS unsigned long long* tab; float* out; unsigned char* ws; };
constexpr int LDS_BYTES = 147456;
constexpr int LDS_TAB_OFF = LDS_BYTES - 1024, LDS_ST_OFF = LDS_BYTES - 64;
__device__ __forceinline__ const float* inp(const Ctx& c, int i) { const unsigned long long v = c.tab[i];
    const unsigned lo = __builtin_amdgcn_readfirstlane((unsigned)v), hi = __builtin_amdgcn_readfirstlane((unsigned)(v >> 32)); return (const float*)(((unsigned long long)hi << 32) | lo); }
__device__ __forceinline__ Ctx make_ctx(const Args& a, LAS unsigned char* lds, int tid) {
    LAS unsigned long long* tab = (LAS unsigned long long*)(lds + LDS_TAB_OFF);
    if (tid < N_IN) tab[tid] = (unsigned long long)a.in[tid];
    if (tid >= 64 && tid < 80) ((LAS unsigned*)(lds + LDS_ST_OFF))[tid - 64] = 0u;
    __syncthreads();
    Ctx c; c.tab = tab; c.out = a.out; c.ws = a.ws; return c; }


#define LDS_WAIT() asm volatile("s_waitcnt lgkmcnt(0)" ::: "memory")
__device__ __forceinline__ float wave_sum(float v) {
#pragma unroll
    for (int o = 1; o < 64; o <<= 1) v += __shfl_xor(v, o);
    return v;
}
__device__ __forceinline__ unsigned f2bf(float f) { unsigned u = __float_as_uint(f); return (u + 0x7fffu + ((u >> 16) & 1u)) >> 16; }
__device__ __forceinline__ unsigned pk2(float lo, float hi) { return cvt_pk_bf16(lo, hi); }
__device__ __forceinline__ float bf2f(bf16_t b) { return __uint_as_float(((unsigned)b) << 16); }

__device__ __forceinline__ void ld64bf(const bf16_t* p, float (&x)[64]) {
    const uint4* q = (const uint4*)p;
#pragma unroll
    for (int i = 0; i < 8; ++i) { const uint4 u = q[i]; x[8 * i + 0] = bf_lo(u.x); x[8 * i + 1] = bf_hi(u.x); x[8 * i + 2] = bf_lo(u.y); x[8 * i + 3] = bf_hi(u.y);
        x[8 * i + 4] = bf_lo(u.z); x[8 * i + 5] = bf_hi(u.z); x[8 * i + 6] = bf_lo(u.w); x[8 * i + 7] = bf_hi(u.w); }
}
__device__ __forceinline__ void st64bf(bf16_t* p, const float (&x)[64]) {
    uint4* q = (uint4*)p;
#pragma unroll
    for (int i = 0; i < 8; ++i) { uint4 u; u.x = pk2(x[8 * i + 0], x[8 * i + 1]); u.y = pk2(x[8 * i + 2], x[8 * i + 3]); u.z = pk2(x[8 * i + 4], x[8 * i + 5]); u.w = pk2(x[8 * i + 6], x[8 * i + 7]); q[i] = u; }
}
__device__ __forceinline__ float dot64bf(const bf16_t* p, const float (&q)[64]) {
    const uint4* r = (const uint4*)p; float s0 = 0.f, s1 = 0.f, s2 = 0.f, s3 = 0.f;
#pragma unroll
    for (int i = 0; i < 8; ++i) { const uint4 u = r[i];
        s0 += bf_lo(u.x) * q[8 * i + 0]; s1 += bf_hi(u.x) * q[8 * i + 1]; s2 += bf_lo(u.y) * q[8 * i + 2]; s3 += bf_hi(u.y) * q[8 * i + 3];
        s0 += bf_lo(u.z) * q[8 * i + 4]; s1 += bf_hi(u.z) * q[8 * i + 5]; s2 += bf_lo(u.w) * q[8 * i + 6]; s3 += bf_hi(u.w) * q[8 * i + 7]; }
    return (s0 + s1) + (s2 + s3);
}
__device__ __forceinline__ float dot64f(const float* p, const float (&q)[64]) {
    const float4* r = (const float4*)p; float s0 = 0.f, s1 = 0.f, s2 = 0.f, s3 = 0.f;
#pragma unroll
    for (int i = 0; i < 16; ++i) { const float4 u = r[i]; s0 += u.x * q[4 * i + 0]; s1 += u.y * q[4 * i + 1]; s2 += u.z * q[4 * i + 2]; s3 += u.w * q[4 * i + 3]; }
    return (s0 + s1) + (s2 + s3);
}
__device__ __forceinline__ void axpy64bf(float a, const bf16_t* p, float (&acc)[64]) {
    const uint4* r = (const uint4*)p;
#pragma unroll
    for (int i = 0; i < 8; ++i) { const uint4 u = r[i];
        acc[8 * i + 0] += a * bf_lo(u.x); acc[8 * i + 1] += a * bf_hi(u.x); acc[8 * i + 2] += a * bf_lo(u.y); acc[8 * i + 3] += a * bf_hi(u.y);
        acc[8 * i + 4] += a * bf_lo(u.z); acc[8 * i + 5] += a * bf_hi(u.z); acc[8 * i + 6] += a * bf_lo(u.w); acc[8 * i + 7] += a * bf_hi(u.w); }
}
__device__ __forceinline__ void axpy64f(float a, const float* p, float (&acc)[64]) {
    const float4* r = (const float4*)p;
#pragma unroll
    for (int i = 0; i < 16; ++i) { const float4 u = r[i]; acc[4 * i + 0] += a * u.x; acc[4 * i + 1] += a * u.y; acc[4 * i + 2] += a * u.z; acc[4 * i + 3] += a * u.w; }
}
#define ONLINE_UPDATE(s, AXPY) do { if ((s) > m) { const float f_ = __expf(m - (s)); lsum *= f_; _Pragma("unroll") for (int i_ = 0; i_ < 64; ++i_) acc[i_] *= f_; m = (s); } \
    const float p_ = __expf((s) - m); lsum += p_; AXPY; } while (0)

__device__ __forceinline__ void transpose_item(const float* W, int K, int N, bf16_t* WT, bool swi, LAS float* scr, int item, int lane) {
    const int nblk = N / 32, kb = item / nblk, nb = item % nblk, k0 = 64 * kb, d0 = 32 * nb;
    int n0 = d0;
    if (swi) { const int tile = d0 >> 8, w = d0 & 255; n0 = (w < 128) ? (tile * 128 + w) : (DFF + tile * 128 + (w - 128)); }
#pragma unroll 8
    for (int i = 0; i < 32; ++i) { const int kk = 2 * i + (lane >> 5); scr[kk * 33 + (lane & 31)] = W[(size_t)(k0 + kk) * N + n0 + (lane & 31)]; }
    LDS_WAIT(); asm volatile("" ::: "memory");
    const int c = lane & 7;
#pragma unroll
    for (int j = 0; j < 4; ++j) { const int n = (lane >> 3) + 8 * j; const LAS float* s = scr + (8 * c) * 33 + n;
        uint4 o; o.x = pk2(s[0 * 33], s[1 * 33]); o.y = pk2(s[2 * 33], s[3 * 33]); o.z = pk2(s[4 * 33], s[5 * 33]); o.w = pk2(s[6 * 33], s[7 * 33]);
        *(uint4*)(WT + (size_t)(d0 + n) * K + k0 + 8 * c) = o; }
    LDS_WAIT(); asm volatile("" ::: "memory");
}
__device__ __forceinline__ void convert_weights(const Ctx& a, int l, LAS unsigned char* lds, int gw, int NGW, int wave, int lane) {
    LAS float* scr = (LAS float*)(lds + wave * 16384);
    bf16_t* wb = (bf16_t*)(a.ws + WS_W);
    constexpr int I0 = 16 * 176, I1 = 44 * 32, I4 = 16 * 296, I5 = 8 * 32, I9 = 16 * 32;
    constexpr int NITEMS = 2 * I0 + 2 * I1 + I4 + 4 * I5 + I9;
    for (int it = gw; it < NITEMS; it += NGW) {
        int r = it;
        if (r < I0) { transpose_item(inp(a, I_WFAI) + (size_t)l * D * 2 * DFF, D, 2 * DFF, (bf16_t*)((unsigned char*)wb + W_FA_IN), true, scr, r, lane); continue; } r -= I0;
        if (r < I1) { transpose_item(inp(a, I_WFAO) + (size_t)l * DFF * D, DFF, D, (bf16_t*)((unsigned char*)wb + W_FA_OUT), false, scr, r, lane); continue; } r -= I1;
        if (r < I0) { transpose_item(inp(a, I_WFBI) + (size_t)l * D * 2 * DFF, D, 2 * DFF, (bf16_t*)((unsigned char*)wb + W_FB_IN), true, scr, r, lane); continue; } r -= I0;
        if (r < I1) { transpose_item(inp(a, I_WFBO) + (size_t)l * DFF * D, DFF, D, (bf16_t*)((unsigned char*)wb + W_FB_OUT), false, scr, r, lane); continue; } r -= I1;
        if (r < I4) { transpose_item(inp(a, I_WIN) + (size_t)l * D * 9472, D, 9472, (bf16_t*)((unsigned char*)wb + W_IN), false, scr, r, lane); continue; } r -= I4;
        if (r < 4 * I5) { const int b = r / I5; transpose_item(inp(a, I_WBR) + ((size_t)l * 4 + b) * 512 * D, 512, D, (bf16_t*)((unsigned char*)wb + W_BR) + (size_t)b * D * 512, false, scr, r % I5, lane); continue; } r -= 4 * I5;
        transpose_item(inp(a, I_WOUT) + (size_t)l * D * D, D, D, (bf16_t*)((unsigned char*)wb + W_OUT), false, scr, r, lane);
    }
}
__device__ __forceinline__ void phase_p0a(const Ctx& a, LAS unsigned char* lds, int bid, int nblk, int tid) {
    const int lane = tid & 63, wave = tid >> 6, gtid = bid * 512 + tid, NT = nblk * 512;
    { const float4* s0 = (const float4*)inp(a, I_XP); const float4* s1 = (const float4*)inp(a, I_XS); float4* o = (float4*)a.out;
      for (int i = gtid; i < 4194304; i += NT) o[i] = i < 2097152 ? s0[i] : s1[i - 2097152]; }
    { LAS float* sc = (LAS float*)lds;
      for (int i = tid; i < 9216; i += 512) { const int r = i >> 10, k = i & 1023; const float v = r == 0 ? inp(a, I_CCTX)[k] : inp(a, I_C)[(r - 1) * 1024 + k]; sc[i] = v / (1.0f + expf(-v)); }
      __syncthreads();
      float* modp = (float*)(a.ws + WS_MODP);
      for (int idx = gtid; idx < 2 * 8 * 9216; idx += NT) { const int n = idx % 9216, kc = (idx / 9216) % 8, l = idx / (9216 * 8);
          const float* w = inp(a, I_WADA) + ((size_t)l * 1024 + kc * 128) * 9216 + n; float acc[9];
#pragma unroll
          for (int r = 0; r < 9; ++r) acc[r] = 0.f;
          for (int k = 0; k < 128; ++k) { const float wv = w[(size_t)k * 9216];
#pragma unroll
              for (int r = 0; r < 9; ++r) acc[r] += sc[r * 1024 + kc * 128 + k] * wv; }
#pragma unroll
          for (int r = 0; r < 9; ++r) modp[((size_t)(l * 8 + kc) * 9 + r) * 9216 + n] = acc[r]; }
      __syncthreads(); }
    { LAS float* fe = (LAS float*)lds; LAS float* z1 = fe + 8 * 33; float* z2g = (float*)(a.ws + WS_Z2);
      for (int it = bid; it < 320; it += nblk) { const int l = it / 160, tg = it % 160, tt = tid >> 6, j = tid & 63, tglob = tg * 8 + tt;
          const int L = tglob < 256 ? 256 : 1024, tpos = tglob < 256 ? tglob : tglob - 256; const float tf = (float)tpos / (float)L;
          if (j < 33) { float v; if (j == 0) v = tf; else if (j <= 16) v = sinf((6.2831853071795864769f * tf) * (float)j); else v = cosf((6.2831853071795864769f * tf) * (float)(j - 16)); fe[tt * 33 + j] = v; }
          __syncthreads();
          float s = inp(a, I_HB1)[l * 64 + j];
          for (int i = 0; i < 33; ++i) s += fe[tt * 33 + i] * inp(a, I_HW1)[(l * 33 + i) * 64 + j];
          z1[tt * 64 + j] = sinf(s);
          __syncthreads();
          float s2 = inp(a, I_HB2)[l * 64 + j];
          for (int i = 0; i < 64; ++i) s2 += z1[tt * 64 + i] * inp(a, I_HW2)[(l * 64 + i) * 64 + j];
          z2g[((size_t)l * 1280 + tglob) * 64 + j] = sinf(s2);
          __syncthreads(); } }
    convert_weights(a, 0, lds, bid * 8 + wave, nblk * 8, wave, lane);
}
__device__ __forceinline__ void phase_p0b(const Ctx& a, LAS unsigned char* lds, int bid, int nblk, int tid) {
    const int gtid = bid * 512 + tid, NT = nblk * 512;
    { const float* modp = (const float*)(a.ws + WS_MODP); float* mod = (float*)(a.ws + WS_MOD);
      for (int idx = gtid; idx < 2 * 9 * 9216; idx += NT) { const int n = idx % 9216, r = (idx / 9216) % 9, l = idx / (9216 * 9); float s = inp(a, I_BADA)[l * 9216 + n];
#pragma unroll
          for (int kc = 0; kc < 8; ++kc) s += modp[((size_t)(l * 8 + kc) * 9 + r) * 9216 + n];
          mod[idx] = s; } }
    { LAS float* red = (LAS float*)lds; const float* z2g = (const float*)(a.ws + WS_Z2); float* filt = (float*)(a.ws + WS_FILT);
      const float dmin = logf(0.01f) / 1.5f, dmax = logf(0.01f) / 0.3f;
      for (int it = bid; it < 128; it += nblk) { const int l = it >> 6, ls = (it >> 5) & 1, cg = it & 31, ci = tid & 15, tl = tid >> 4, c = cg * 16 + ci;
          const int L = ls ? 1024 : 256, toff = ls ? 256 : 0; float* G = filt + (size_t)l * (2560 * 512) + (ls ? 512 * 512 : 0);
          const float ad = fabsf(dmin + (dmax - dmin) * ((float)c / 511.0f)); const float* w3 = inp(a, I_HW3) + (size_t)l * 64 * 1024;
          float asum = 0.f;
          for (int t = tl; t < L; t += 32) { const float* zp = z2g + ((size_t)l * 1280 + toff + t) * 64; float zf = 0.f, zb = 0.f;
              for (int j = 0; j < 64; ++j) { const float z = zp[j]; zf += z * w3[j * 1024 + c]; zb += z * w3[j * 1024 + 512 + c]; }
              const float win = expf(-((float)t / (float)L) * ad); const float hf = zf * win, hb = zb * win; asum += fabsf(hf) + fabsf(hb);
              G[(size_t)(L - 1 + t) * 512 + c] = hf; if (t >= 1) G[(size_t)(L - 1 - t) * 512 + c] = hb; }
          red[tl * 16 + ci] = asum; __syncthreads();
          float tot = 0.f;
          for (int i = 0; i < 32; ++i) tot += red[i * 16 + ci];
          const float inv = 1.0f / tot;
          bf16_t* GT = (bf16_t*)(a.ws + WS_GRT) + (size_t)l * (512 * 2560) + (ls ? 512 * 512 : 0) + (size_t)c * (2 * L);
          for (int t = tl; t < L; t += 32) { const float hf = G[(size_t)(L - 1 + t) * 512 + c] * inv; G[(size_t)(L - 1 + t) * 512 + c] = hf; GT[L - 1 - t] = (bf16_t)f2bf(hf);
              if (t >= 1) { const float hb = G[(size_t)(L - 1 - t) * 512 + c] * inv; G[(size_t)(L - 1 - t) * 512 + c] = hb; GT[L - 1 + t] = (bf16_t)f2bf(hb); } }
          if (tl == 0) GT[2 * L - 1] = 0;
          __syncthreads(); } }
}
__device__ __forceinline__ void phase_norm(const Ctx& a, int l, int gidx  , int sidx  , int bid, int nblk, int tid) {
    const int lane = tid & 63, gw = bid * 8 + (tid >> 6), NGW = nblk * 8;
    const float* gain = inp(a, gidx) + l * 1024; const float* modl = (const float*)(a.ws + WS_MOD) + (size_t)l * 9 * 9216; bf16_t* H = (bf16_t*)(a.ws + WS_H);
    for (int row = gw; row < M; row += NGW) { const int r = row < 8192 ? 0 : 1 + ((row - 8192) >> 10);
        const f32x4* xr = (const f32x4*)(a.out + (size_t)row * 1024) + lane; f32x4 v[4]; float ss = 0.f;
#pragma unroll
        for (int j = 0; j < 4; ++j) { v[j] = xr[64 * j]; ss += (v[j].x * v[j].x + v[j].y * v[j].y) + (v[j].z * v[j].z + v[j].w * v[j].w); }
        const float rstd = 1.0f / sqrtf(wave_sum(ss) * (1.0f / 1024.0f) + EPS);
#pragma unroll
        for (int j = 0; j < 4; ++j) { const int col = 4 * lane + 256 * j; const f32x4 g = *(const f32x4*)(gain + col), sh = *(const f32x4*)(modl + (size_t)r * 9216 + sidx * 1024 + col), sc = *(const f32x4*)(modl + (size_t)r * 9216 + (sidx + 1) * 1024 + col);
            const f32x4 y = (v[j] * rstd) * g; const f32x4 h = y * (sc + 1.0f) + sh;
            u32x2 w; w.x = pk2(h.x, h.y); w.y = pk2(h.z, h.w); *(u32x2*)(H + (size_t)row * 1024 + col) = w; } }
}
__device__ __forceinline__ void phase_prep(const Ctx& a, int l, int bid, int nblk, int tid) {
    const int gtid = bid * 512 + tid, NT = nblk * 512; bf16_t* cols = (bf16_t*)(a.ws + WS_BIG);
    { const int sub = gtid & 7;
#pragma unroll 1
      for (int T = gtid >> 3; T < M * 36; T += NT >> 3) { const int row = T / 36, vt = T % 36; const bool lat = row >= 8192; bf16_t* cr = cols + (size_t)row * NMIX;
        const int bc = row >> 8, tc = row & 255;
        if (vt < 26) { int col; const float* gn; float* so = nullptr;
            if (vt < 8) { col = C_DQ + 64 * vt; gn = inp(a, I_DQN) + l * 64; }
            else if (vt < 16) { col = C_DK + 64 * (vt - 8); gn = inp(a, I_DKN) + l * 64; if (!lat) so = a.out + O_DK + ((((size_t)bc * 2 + l) * 256 + tc) * 8 + (vt - 8)) * 64; }
            else if (vt < 24) { col = C_WQ + 64 * (vt - 16); gn = inp(a, I_WQN) + l * 64; }
            else { col = C_WK + 64 * (vt - 24); gn = inp(a, I_WKN) + l * 64; if (!lat) so = a.out + O_WK + ((((size_t)bc * 2 + l) * 256 + tc) * 2 + (vt - 24)) * 64; }
            const uint4 u = *(const uint4*)(cr + col + 8 * sub);
            float x[8] = {bf_lo(u.x), bf_hi(u.x), bf_lo(u.y), bf_hi(u.y), bf_lo(u.z), bf_hi(u.z), bf_lo(u.w), bf_hi(u.w)};
            float ss = 0.f;
#pragma unroll
            for (int i = 0; i < 8; ++i) ss += x[i] * x[i];
            ss += __shfl_xor(ss, 1); ss += __shfl_xor(ss, 2); ss += __shfl_xor(ss, 4);
            const float rs = 1.0f / sqrtf(ss * (1.0f / 64.0f) + EPS);
            const float4 g0 = *(const float4*)(gn + 8 * sub), g1 = *(const float4*)(gn + 8 * sub + 4);
            x[0] *= rs * g0.x; x[1] *= rs * g0.y; x[2] *= rs * g0.z; x[3] *= rs * g0.w; x[4] *= rs * g1.x; x[5] *= rs * g1.y; x[6] *= rs * g1.z; x[7] *= rs * g1.w;
            if (so) { ((float4*)(so + 8 * sub))[0] = make_float4(x[0], x[1], x[2], x[3]); ((float4*)(so + 8 * sub))[1] = make_float4(x[4], x[5], x[6], x[7]); }
            if (lat) { const int t = (row - 8192) & 1023; const float pos = (sub & 4) ? (float)(t & 63) : (float)(t >> 6); const bool second = (sub & 2) != 0;
#pragma unroll
                for (int i = 0; i < 8; ++i) { const float y = __shfl_xor(x[i], 2); const float invf = exp2f(-(float)((sub & 1) * 8 + i) * (13.287712379549449f / 16.0f));
                    const float ang = pos * invf, sn = __sinf(ang), cs = __cosf(ang);
                    x[i] = second ? (y * sn + x[i] * cs) : (x[i] * cs - y * sn); } }
            uint4 o; o.x = pk2(x[0], x[1]); o.y = pk2(x[2], x[3]); o.z = pk2(x[4], x[5]); o.w = pk2(x[6], x[7]);
            *(uint4*)(cr + col + 8 * sub) = o;
        } else if (!lat) { const int v = vt < 34 ? vt - 26 : vt - 34; const bf16_t* src = cr + (vt < 34 ? C_DV : C_WV) + 64 * v + 8 * sub;
            float* dst = (vt < 34 ? a.out + O_DV + (((size_t)bc * 2 + l) * 256 + tc) * 512 + 64 * v : a.out + O_WV + (((size_t)bc * 2 + l) * 256 + tc) * 128 + 64 * v) + 8 * sub;
            const uint4 u = *(const uint4*)src;
            ((float4*)dst)[0] = make_float4(bf_lo(u.x), bf_hi(u.x), bf_lo(u.y), bf_hi(u.y)); ((float4*)dst)[1] = make_float4(bf_lo(u.z), bf_hi(u.z), bf_lo(u.w), bf_hi(u.w)); }
      } }
}
__device__ __forceinline__ void prep_hy(const Ctx& a, int l, LAS unsigned char* lds, int bid, int nblk, int tid) {
    const int lane = tid & 63, wave = __builtin_amdgcn_readfirstlane(tid >> 6), gw = bid * 8 + wave, NGW = nblk * 8;
    LAS float* scr = (LAS float*)(lds + wave * 16640);
    const bf16_t* cols = (const bf16_t*)(a.ws + WS_BIG); bf16_t* ztl = (bf16_t*)(a.ws + WS_ZB); bf16_t* ztc = ztl + (size_t)512 * 8 * 1024;
    const float* cw = inp(a, I_HCW) + l * 3 * 1536; const float* cb = inp(a, I_HCB) + l * 1536;
#pragma unroll 1
    for (int it = gw; it < 2048; it += NGW) { const int rblk = it >> 3, c = (it & 7) * 64 + lane, row0 = rblk * 64; const bool lat = row0 >= 8192;
        const int L = lat ? 1024 : 256, t0 = lat ? ((row0 - 8192) & 1023) : (row0 & 255), b = lat ? ((row0 - 8192) >> 10) : (row0 >> 8);
        const float wv0 = cw[c], wv1 = cw[1536 + c], wv2 = cw[3072 + c], bv = cb[c], wx0 = cw[1024 + c], wx1 = cw[1536 + 1024 + c], wx2 = cw[3072 + 1024 + c], bx = cb[1024 + c];
        const bf16_t* p = cols + (size_t)row0 * NMIX + c;
        float vm = t0 > 0 ? bf2f(p[-NMIX]) : 0.f, xm = t0 > 0 ? bf2f(p[1024 - NMIX]) : 0.f, v0 = bf2f(p[0]), x0 = bf2f(p[1024]);
#pragma unroll 4
        for (int i = 0; i < 64; ++i) { const bool hp = t0 + i < L - 1; const float vp = hp ? bf2f(p[(size_t)(i + 1) * NMIX]) : 0.f, xp = hp ? bf2f(p[(size_t)(i + 1) * NMIX + 1024]) : 0.f;
            const float v = vm * wv0 + v0 * wv1 + vp * wv2 + bv, x1 = xm * wx0 + x0 * wx1 + xp * wx2 + bx;
            scr[i * 65 + lane] = v * x1; vm = v0; v0 = vp; xm = x0; x0 = xp; }
        LDS_WAIT(); asm volatile("" ::: "memory");
        bf16_t* dst = (lat ? ztl + ((size_t)c * 8 + b) * 1024 : ztc + ((size_t)c * 32 + b) * 256) + t0; uint4* o = (uint4*)dst;
#pragma unroll
        for (int i = 0; i < 8; ++i) { const LAS float* q = scr + (8 * i) * 65 + lane; uint4 w;
            w.x = pk2(q[0], q[65]); w.y = pk2(q[2 * 65], q[3 * 65]); w.z = pk2(q[4 * 65], q[5 * 65]); w.w = pk2(q[6 * 65], q[7 * 65]); o[i] = w; }
        LDS_WAIT(); asm volatile("" ::: "memory"); }
}
__device__ __forceinline__ void diff_item(const Ctx& a, int l, int grp, int h, int qb, int lane) {
    const bf16_t* cols = (const bf16_t*)(a.ws + WS_BIG); bf16_t* yo = (bf16_t*)(a.ws + WS_YBR) + (size_t)1 * M * 512;
    const bool lat = grp >= 32; const int b = lat ? grp - 32 : grp, L = lat ? 1024 : 256, rb = lat ? 8192 + b * 1024 : b * 256;
    const int qi = lane >> 2, eq = lane & 3, t = qb * 16 + qi, row = rb + t;
    const float* dl = inp(a, I_DLAM) + l * 256; float s01 = 0.f, s23 = 0.f;
    for (int i = 0; i < 64; ++i) { s01 += dl[i] * dl[64 + i]; s23 += dl[128 + i] * dl[192 + i]; }
    const float lam_init = 0.8f - 0.6f * expf(-0.3f * (float)l), lam = expf(s01) - expf(s23) + lam_init;
    float out[32];
#pragma unroll 1
    for (int c = 0; c < 2; ++c) {
        float q[64]; ld64bf(cols + (size_t)row * NMIX + C_DQ + (h * 2 + c) * 64, q);
        float acc[32];
#pragma unroll
        for (int i = 0; i < 32; ++i) acc[i] = 0.f;
        float m = -1e30f, lsum = 0.f;
#pragma unroll 1
        for (int j = 0; j < L; ++j) { const bf16_t* kr = cols + (size_t)(rb + j) * NMIX; const float s = dot64bf(kr + C_DK + (h * 2 + c) * 64, q) * 0.125f;
            if (s > m) { const float f_ = __expf(m - s); lsum *= f_;
#pragma unroll
                for (int i = 0; i < 32; ++i) acc[i] *= f_;
                m = s; }
            const float p_ = __expf(s - m); lsum += p_;
            const uint4* r = (const uint4*)(kr + C_DV + h * 128 + eq * 32);
#pragma unroll
            for (int i = 0; i < 4; ++i) { const uint4 u = r[i];
                acc[8 * i + 0] += p_ * bf_lo(u.x); acc[8 * i + 1] += p_ * bf_hi(u.x); acc[8 * i + 2] += p_ * bf_lo(u.y); acc[8 * i + 3] += p_ * bf_hi(u.y);
                acc[8 * i + 4] += p_ * bf_lo(u.z); acc[8 * i + 5] += p_ * bf_hi(u.z); acc[8 * i + 6] += p_ * bf_lo(u.w); acc[8 * i + 7] += p_ * bf_hi(u.w); } }
        if (lat) {
#pragma unroll 1
            for (int j = 0; j < 512; ++j) { const float* kp = inp(a, I_CDK) + (((((size_t)b * 2 + l) * 512 + j) * 4 + h) * 2 + c) * 64; const float4* vp = (const float4*)(inp(a, I_CDV) + ((((size_t)b * 2 + l) * 512 + j) * 4 + h) * 128 + eq * 32);
                const float s = dot64f(kp, q) * 0.125f;
                if (s > m) { const float f_ = __expf(m - s); lsum *= f_;
#pragma unroll
                    for (int i = 0; i < 32; ++i) acc[i] *= f_;
                    m = s; }
                const float p_ = __expf(s - m); lsum += p_;
#pragma unroll
                for (int i = 0; i < 8; ++i) { const float4 u = vp[i]; acc[4 * i + 0] += p_ * u.x; acc[4 * i + 1] += p_ * u.y; acc[4 * i + 2] += p_ * u.z; acc[4 * i + 3] += p_ * u.w; } } }
        const float inv = 1.0f / lsum;
        if (c == 0) {
#pragma unroll
            for (int i = 0; i < 32; ++i) out[i] = acc[i] * inv; }
        else {
#pragma unroll
            for (int i = 0; i < 32; ++i) out[i] -= lam * (acc[i] * inv); }
    }
    float ss = 0.f;
#pragma unroll
    for (int i = 0; i < 32; ++i) ss += out[i] * out[i];
    ss += __shfl_xor(ss, 1); ss += __shfl_xor(ss, 2);
    const float rs = (1.0f / sqrtf(ss * (1.0f / 128.0f) + EPS)) * (1.0f - lam_init); const float* sg = inp(a, I_DSUB) + l * 128 + eq * 32;
    uint4* dst = (uint4*)(yo + (size_t)row * 512 + h * 128 + eq * 32);
#pragma unroll
    for (int i = 0; i < 4; ++i) { uint4 u; u.x = pk2(out[8 * i + 0] * rs * sg[8 * i + 0], out[8 * i + 1] * rs * sg[8 * i + 1]); u.y = pk2(out[8 * i + 2] * rs * sg[8 * i + 2], out[8 * i + 3] * rs * sg[8 * i + 3]);
        u.z = pk2(out[8 * i + 4] * rs * sg[8 * i + 4], out[8 * i + 5] * rs * sg[8 * i + 5]); u.w = pk2(out[8 * i + 6] * rs * sg[8 * i + 6], out[8 * i + 7] * rs * sg[8 * i + 7]); dst[i] = u; }
}
__device__ __forceinline__ void win_item(const Ctx& a, int l, int grp, int hq, int qb, int lane) {
    const bf16_t* cols = (const bf16_t*)(a.ws + WS_BIG); bf16_t* yo = (bf16_t*)(a.ws + WS_YBR) + (size_t)2 * M * 512;
    const bool lat = grp >= 32; const int b = lat ? grp - 32 : grp, L = lat ? 1024 : 256, rb = lat ? 8192 + b * 1024 : b * 256;
    const int t = qb * 64 + lane, row = rb + t, hkv = hq >> 2;
    float q[64]; ld64bf(cols + (size_t)row * NMIX + C_WQ + hq * 64, q);
    float acc[64];
#pragma unroll
    for (int i = 0; i < 64; ++i) acc[i] = 0.f;
    float m = inp(a, I_WSINK)[l * 8 + hq], lsum = 1.0f;
    const int jlo = lat ? max(0, qb * 64 - 128) : 0, jhi = lat ? min(L - 1, qb * 64 + 63 + 128) : L - 1;
    for (int j = jlo; j <= jhi; ++j) { const bf16_t* kr = cols + (size_t)(rb + j) * NMIX; const float s = dot64bf(kr + C_WK + hkv * 64, q) * 0.125f;
        const int dd = t - j; const bool ok = !lat || (dd <= 128 && dd >= -128);
        if (ok) { ONLINE_UPDATE(s, axpy64bf(p_, kr + C_WV + hkv * 64, acc)); } }
    if (lat) for (int j = 0; j < 512; ++j) { const size_t o = ((((size_t)b * 2 + l) * 512 + j) * 2 + hkv) * 64; const float s = dot64f(inp(a, I_CWK) + o, q) * 0.125f; ONLINE_UPDATE(s, axpy64f(p_, inp(a, I_CWV) + o, acc)); }
    const float inv = 1.0f / lsum;
#pragma unroll
    for (int i = 0; i < 64; ++i) acc[i] *= inv;
    st64bf(yo + (size_t)row * 512 + hq * 64, acc);
}
__device__ __forceinline__ void ret_item(const Ctx& a, int l, int grp, int h, int qb, int lane, LAS float* qs  ) {
    const bf16_t* cols = (const bf16_t*)(a.ws + WS_BIG); bf16_t* yo = (bf16_t*)(a.ws + WS_YBR) + (size_t)3 * M * 512;
    const bool lat = grp >= 32; const int b = lat ? grp - 32 : grp, L = lat ? 1024 : 256, rb = lat ? 8192 + b * 1024 : b * 256;
    const int qi = lane >> 1, eh = lane & 1, t = qb * 32 + qi, row = rb + t;
    const float lgf = -log1pf(expf(-inp(a, I_RDF)[l * 4 + h])), lgb = -log1pf(expf(-inp(a, I_RDB)[l * 4 + h]));
    float q[64]; ld64bf(cols + (size_t)row * NMIX + C_RQ + h * 64, q);
    float acc[64];
#pragma unroll
    for (int i = 0; i < 64; ++i) acc[i] = 0.f;
    for (int s = 0; s < L; ++s) { const bf16_t* kr = cols + (size_t)(rb + s) * NMIX; const int d = t - s;
        const float w = (d >= 0 ? __expf((float)d * lgf) : 0.f) + (d <= 0 ? __expf((float)(-d) * lgb) : 0.f);
        const float dt = dot64bf(kr + C_RK + h * 64, q) * 0.125f; axpy64bf(w * dt, kr + C_RV + h * 128 + eh * 64, acc); }
    if (lat) { const float* Sf = inp(a, I_SRF) + ((((size_t)b * 2 + l) * 4 + h) * 64) * 128 + eh * 64; const float* Sb = inp(a, I_SRB) + ((((size_t)b * 2 + l) * 4 + h) * 64) * 128 + eh * 64;
        const float wf = expf((float)(t + 1) * lgf), wb = expf((float)(L - t) * lgb);
#pragma unroll
        for (int i = 0; i < 64; ++i) qs[lane * 65 + i] = q[i];
        LDS_WAIT(); asm volatile("" ::: "memory");
#pragma unroll 1
        for (int d = 0; d < 64; ++d) { const float qd = qs[lane * 65 + d]; const float qf = qd * wf, qb2 = qd * wb; const float4* pf = (const float4*)(Sf + (size_t)d * 128); const float4* pb = (const float4*)(Sb + (size_t)d * 128);
#pragma unroll
            for (int i = 0; i < 16; ++i) { const float4 u = pf[i], v = pb[i]; acc[4 * i + 0] += qf * u.x + qb2 * v.x; acc[4 * i + 1] += qf * u.y + qb2 * v.y; acc[4 * i + 2] += qf * u.z + qb2 * v.z; acc[4 * i + 3] += qf * u.w + qb2 * v.w;
                if ((i & 3) == 3) asm volatile("" ::: "memory"); } }
        LDS_WAIT(); asm volatile("" ::: "memory"); }
    float ss = 0.f;
#pragma unroll
    for (int i = 0; i < 64; ++i) ss += acc[i] * acc[i];
    ss += __shfl_xor(ss, 1);
    const float rs = 1.0f / sqrtf(ss * (1.0f / 128.0f) + EPS);
    float g[64]; ld64bf(cols + (size_t)row * NMIX + C_RG + h * 128 + eh * 64, g);
#pragma unroll
    for (int i = 0; i < 64; ++i) { const float gv = g[i]; acc[i] = acc[i] * rs * (gv / (1.0f + __expf(-gv))); }
    st64bf(yo + (size_t)row * 512 + h * 128 + eh * 64, acc);
}
__device__ __forceinline__ void retstate_thread(const Ctx& a, int l, int idx) {
    const bf16_t* cols = (const bf16_t*)(a.ws + WS_BIG);
    const int e = idx & 127, d = (idx >> 7) & 63, h = (idx >> 13) & 3, b = idx >> 15;
    const float lgf = -log1pf(expf(-inp(a, I_RDF)[l * 4 + h])), lgb = -log1pf(expf(-inp(a, I_RDB)[l * 4 + h]));
    float sf = 0.f, sb = 0.f;
    for (int s = 0; s < 256; ++s) { const bf16_t* kr = cols + (size_t)(b * 256 + s) * NMIX; const float kv = bf2f(kr[C_RK + h * 64 + d]) * 0.125f * bf2f(kr[C_RV + h * 128 + e]);
        sf += __expf((float)(255 - s) * lgf) * kv; sb += __expf((float)s * lgb) * kv; }
    const size_t o = ((((size_t)b * 2 + l) * 4 + h) * 64 + d) * 128 + e;
    a.out[O_RF + o] = sf; a.out[O_RB + o] = sb;
}
__device__ __forceinline__ void hy2_thread(const Ctx& a, int l, int idx) {
    const bf16_t* cols = (const bf16_t*)(a.ws + WS_BIG); bf16_t* yo = (bf16_t*)(a.ws + WS_YBR);
    const bool lat = idx >= 524288; const int i2 = lat ? idx - 524288 : idx, c = i2 & 511, L = lat ? 1024 : 256, ng = L >> 3, tg = (i2 >> 9) % ng, b = (i2 >> 9) / ng;
    const int rb = lat ? 8192 + b * 1024 : b * 256, t0 = tg * 8;
    const float* G = (const float*)(a.ws + WS_FILT) + (size_t)l * (2560 * 512) + (lat ? 512 * 512 : 0) + c;
    const bf16_t* Z = (const bf16_t*)(a.ws + WS_ZB) + (size_t)rb * 512 + c;
    float w[8], acc[8];
#pragma unroll
    for (int i = 0; i < 8; ++i) { acc[i] = 0.f; w[i] = G[(size_t)(t0 + i + L - 1) * 512]; }
#pragma unroll 8
    for (int s = 0; s < L; ++s) { const float z = bf2f(Z[(size_t)s * 512]);
#pragma unroll
        for (int i = 0; i < 8; ++i) acc[i] += w[i] * z;
#pragma unroll
        for (int i = 7; i >= 1; --i) w[i] = w[i - 1];
        const int jn = t0 - (s + 1) + L - 1; w[0] = G[(size_t)(jn < 0 ? 0 : jn) * 512]; }
    const float* cw = inp(a, I_HCW) + l * 3 * 1536; const float cb = inp(a, I_HCB)[l * 1536 + 512 + c], sk = inp(a, I_HSKIP)[l * 512 + c];
    const float w0 = cw[512 + c], w1 = cw[1536 + 512 + c], w2 = cw[3072 + 512 + c];
#pragma unroll
    for (int i = 0; i < 8; ++i) { const int t = t0 + i; const bf16_t* p = cols + (size_t)(rb + t) * NMIX + 512 + c;
        const float xm = t > 0 ? bf2f(p[-NMIX]) : 0.f, x0 = bf2f(p[0]), xp = t < L - 1 ? bf2f(p[NMIX]) : 0.f;
        const float x0c = xm * w0 + x0 * w1 + xp * w2 + cb; const float y = acc[i] + sk * bf2f(Z[(size_t)t * 512]);
        yo[(size_t)(rb + t) * 512 + c] = (bf16_t)f2bf(x0c * y); }
}

typedef pg8::bf16x8 bf16x8;
__device__ __forceinline__ bf16x8 ldfrag(const bf16_t* p) { return *(const bf16x8*)p; }
__device__ __forceinline__ bf16x8 pack8(const float (&p)[8]) { u32x4 w; w.x = cvt_pk_bf16(p[0], p[1]); w.y = cvt_pk_bf16(p[2], p[3]); w.z = cvt_pk_bf16(p[4], p[5]); w.w = cvt_pk_bf16(p[6], p[7]); return __builtin_bit_cast(bf16x8, w); }
#define MFMA16(a, b, c) __builtin_amdgcn_mfma_f32_16x16x32_bf16((a), (b), (c), 0, 0, 0)
template <bool F32SRC> __device__ __forceinline__ void transpose64(const void* src, size_t sp, bf16_t* dst, size_t dp, LAS float* scr, int lane) {
    if (F32SRC) { const float4* p = (const float4*)((const float*)src + (size_t)lane * sp);
#pragma unroll
        for (int i = 0; i < 16; ++i) { const float4 u = p[i]; scr[lane * 65 + 4 * i + 0] = u.x; scr[lane * 65 + 4 * i + 1] = u.y; scr[lane * 65 + 4 * i + 2] = u.z; scr[lane * 65 + 4 * i + 3] = u.w; } }
    else { const uint4* p = (const uint4*)((const bf16_t*)src + (size_t)lane * sp);
#pragma unroll
        for (int i = 0; i < 8; ++i) { const uint4 u = p[i]; LAS float* d = scr + lane * 65 + 8 * i;
            d[0] = bf_lo(u.x); d[1] = bf_hi(u.x); d[2] = bf_lo(u.y); d[3] = bf_hi(u.y); d[4] = bf_lo(u.z); d[5] = bf_hi(u.z); d[6] = bf_lo(u.w); d[7] = bf_hi(u.w); } }
    LDS_WAIT(); asm volatile("" ::: "memory");
    uint4* o = (uint4*)(dst + (size_t)lane * dp);
#pragma unroll
    for (int i = 0; i < 8; ++i) { const LAS float* c = scr + (8 * i) * 65 + lane; uint4 w;
        w.x = pk2(c[0], c[65]); w.y = pk2(c[2 * 65], c[3 * 65]); w.z = pk2(c[4 * 65], c[5 * 65]); w.w = pk2(c[6 * 65], c[7 * 65]); o[i] = w; }
    LDS_WAIT(); asm volatile("" ::: "memory");
}
__device__ __forceinline__ void prep_diff(const Ctx& a, int l, LAS unsigned char* lds, int bid, int nblk, int tid) {
    const int lane = tid & 63, wave = __builtin_amdgcn_readfirstlane(tid >> 6), gw = bid * 8 + wave, NGW = nblk * 8, gtid = bid * 512 + tid, NT = nblk * 512;
    LAS float* scr = (LAS float*)(lds + wave * 16640);
    const bf16_t* cols = (const bf16_t*)(a.ws + WS_BIG); bf16_t* vtl = (bf16_t*)(a.ws + WS_VTDL); bf16_t* vtc = (bf16_t*)(a.ws + WS_VTDC);
#pragma unroll 1
    for (int it = gw; it < 2560; it += NGW) {
        if (it < 1024) { const int b = it >> 7, h = (it >> 5) & 3, tb = (it >> 1) & 15, eb = it & 1;
            transpose64<false>(cols + (size_t)(8192 + b * 1024 + tb * 64) * NMIX + C_DV + h * 128 + eb * 64, NMIX, vtl + (size_t)((b * 4 + h) * 128 + eb * 64) * 1536 + tb * 64, 1536, scr, lane); }
        else if (it < 1536) { const int q = it - 1024, b = q >> 6, h = (q >> 4) & 3, jb = (q >> 1) & 7, eb = q & 1;
            transpose64<true>(inp(a, I_CDV) + ((((size_t)b * 2 + l) * 512 + jb * 64) * 4 + h) * 128 + eb * 64, 512, vtl + (size_t)((b * 4 + h) * 128 + eb * 64) * 1536 + 1024 + jb * 64, 1536, scr, lane); }
        else { const int q = it - 1536, b = q >> 5, h = (q >> 3) & 3, tb = (q >> 1) & 3, eb = q & 1;
            transpose64<false>(cols + (size_t)(b * 256 + tb * 64) * NMIX + C_DV + h * 128 + eb * 64, NMIX, vtc + (size_t)((b * 4 + h) * 128 + eb * 64) * 256 + tb * 64, 256, scr, lane); }
    }
    { bf16_t* kdc = (bf16_t*)(a.ws + WS_KDC); const float* ck = inp(a, I_CDK);
      for (int i = gtid; i < 8 * 4 * 2 * 512 * 8; i += NT) { const int d8 = i & 7, j = (i >> 3) & 511, c = (i >> 12) & 1, h = (i >> 13) & 3, b = i >> 15;
          const float4* p = (const float4*)(ck + (((((size_t)b * 2 + l) * 512 + j) * 4 + h) * 2 + c) * 64 + d8 * 8); const float4 u = p[0], v = p[1];
          uint4 w; w.x = pk2(u.x, u.y); w.y = pk2(u.z, u.w); w.z = pk2(v.x, v.y); w.w = pk2(v.z, v.w);
          *(uint4*)(kdc + ((((size_t)b * 4 + h) * 2 + c) * 512 + j) * 64 + d8 * 8) = w; } }
}
__device__ __forceinline__ void diff_map(const bf16_t* cols, const bf16_t* kdc_bh  , const bf16_t* vt  , int nk, int L, int rb, int h, int c, int q0, int lane, f32x4 (&O)[2][8]) {
    const int q16 = lane & 15, g = lane >> 4;
    bf16x8 bq[2][2];
#pragma unroll
    for (int qt = 0; qt < 2; ++qt)
#pragma unroll
        for (int kd = 0; kd < 2; ++kd) bq[qt][kd] = ldfrag(cols + (size_t)(rb + q0 + 16 * qt + q16) * NMIX + C_DQ + (h * 2 + c) * 64 + 32 * kd + 8 * g);
    float m[2] = {-1e30f, -1e30f}, ls[2] = {0.f, 0.f};
#pragma unroll
    for (int qt = 0; qt < 2; ++qt)
#pragma unroll
        for (int et = 0; et < 8; ++et) O[qt][et] = (f32x4){0.f, 0.f, 0.f, 0.f};
    const int nkb = nk >> 5, nkt = L >> 5, kr = 8 * (q16 >> 2) + (q16 & 3);
    const float sc2 = 0.125f * 1.44269504088896f;
#pragma unroll 1
    for (int kb = 0; kb < nkb; ++kb) {
        const bf16_t* kp0; const bf16_t* kp1;
        if (kb < nkt) { kp0 = cols + (size_t)(rb + kb * 32 + kr) * NMIX + C_DK + (h * 2 + c) * 64 + 8 * g; kp1 = kp0 + 4 * NMIX; }
        else { kp0 = kdc_bh + ((size_t)c * 512 + (kb - nkt) * 32 + kr) * 64 + 8 * g; kp1 = kp0 + 4 * 64; }
        const bf16x8 ak00 = ldfrag(kp0), ak01 = ldfrag(kp0 + 32), ak10 = ldfrag(kp1), ak11 = ldfrag(kp1 + 32);
        bf16x8 pb[2];
#pragma unroll
        for (int qt = 0; qt < 2; ++qt) {
            f32x4 s0 = MFMA16(ak00, bq[qt][0], ((f32x4){0.f, 0.f, 0.f, 0.f})); s0 = MFMA16(ak01, bq[qt][1], s0);
            f32x4 s1 = MFMA16(ak10, bq[qt][0], ((f32x4){0.f, 0.f, 0.f, 0.f})); s1 = MFMA16(ak11, bq[qt][1], s1);
            float x[8] = {s0[0] * sc2, s0[1] * sc2, s0[2] * sc2, s0[3] * sc2, s1[0] * sc2, s1[1] * sc2, s1[2] * sc2, s1[3] * sc2};
            float ml = fmaxf(fmaxf(fmaxf(x[0], x[1]), fmaxf(x[2], x[3])), fmaxf(fmaxf(x[4], x[5]), fmaxf(x[6], x[7])));
            ml = fmaxf(ml, __shfl_xor(ml, 16)); ml = fmaxf(ml, __shfl_xor(ml, 32));
            const float mn = fmaxf(m[qt], ml), alpha = __builtin_amdgcn_exp2f(m[qt] - mn); m[qt] = mn;
            float p[8], psum = 0.f;
#pragma unroll
            for (int j = 0; j < 8; ++j) { p[j] = __builtin_amdgcn_exp2f(x[j] - mn); psum += p[j]; }
            ls[qt] = ls[qt] * alpha + psum;
#pragma unroll
            for (int et = 0; et < 8; ++et) O[qt][et] = O[qt][et] * alpha;
            pb[qt] = pack8(p);
        }
#pragma unroll
        for (int et = 0; et < 8; ++et) { const bf16x8 av = ldfrag(vt + (size_t)(16 * et + q16) * nk + kb * 32 + 8 * g);
            O[0][et] = MFMA16(av, pb[0], O[0][et]); O[1][et] = MFMA16(av, pb[1], O[1][et]); }
    }
#pragma unroll
    for (int qt = 0; qt < 2; ++qt) { float lt = ls[qt]; lt += __shfl_xor(lt, 16); lt += __shfl_xor(lt, 32); const float inv = 1.0f / lt;
#pragma unroll
        for (int et = 0; et < 8; ++et) O[qt][et] = O[qt][et] * inv; }
}
__device__ __forceinline__ void diff_mfma_item(const Ctx& a, int l, int grp, int h, int qb, int lane, LAS float* scr) {
    const bf16_t* cols = (const bf16_t*)(a.ws + WS_BIG); bf16_t* yo = (bf16_t*)(a.ws + WS_YBR) + (size_t)1 * M * 512;
    const bool lat = grp >= 32; const int b = lat ? grp - 32 : grp, L = lat ? 1024 : 256, rb = lat ? 8192 + b * 1024 : b * 256, nk = lat ? 1536 : 256;
    const int q16 = lane & 15, g = lane >> 4, q0 = qb * 32;
    const bf16_t* vt = lat ? (const bf16_t*)(a.ws + WS_VTDL) + (size_t)((b * 4 + h) * 128) * 1536 : (const bf16_t*)(a.ws + WS_VTDC) + (size_t)((b * 4 + h) * 128) * 256;
    const bf16_t* kdc = (const bf16_t*)(a.ws + WS_KDC) + (size_t)((b * 4 + h) * 2) * 512 * 64;
    const float* dl = inp(a, I_DLAM) + l * 256; float s01 = 0.f, s23 = 0.f;
    for (int i = 0; i < 64; ++i) { s01 += dl[i] * dl[64 + i]; s23 += dl[128 + i] * dl[192 + i]; }
    const float lam_init = 0.8f - 0.6f * expf(-0.3f * (float)l), lam = expf(s01) - expf(s23) + lam_init;
    f32x4 o0[2][8], o1[2][8];
    diff_map(cols, kdc, vt, nk, L, rb, h, 0, q0, lane, o0);
#pragma unroll
    for (int qt = 0; qt < 2; ++qt)
#pragma unroll
        for (int et = 0; et < 8; ++et) *(LAS f32x4*)(scr + ((qt * 8 + et) * 64 + lane) * 4) = o0[qt][et];
    asm volatile("" ::: "memory");
    diff_map(cols, kdc, vt, nk, L, rb, h, 1, q0, lane, o1);
    LDS_WAIT(); asm volatile("" ::: "memory");
#pragma unroll
    for (int qt = 0; qt < 2; ++qt)
#pragma unroll
        for (int et = 0; et < 8; ++et) o0[qt][et] = *(const LAS f32x4*)(scr + ((qt * 8 + et) * 64 + lane) * 4);
    LDS_WAIT(); asm volatile("" ::: "memory");
    const float* sg = inp(a, I_DSUB) + l * 128;
#pragma unroll
    for (int qt = 0; qt < 2; ++qt) { float ss = 0.f;
#pragma unroll
        for (int et = 0; et < 8; ++et) { o0[qt][et] = o0[qt][et] - o1[qt][et] * lam; const f32x4 v = o0[qt][et]; ss += (v[0] * v[0] + v[1] * v[1]) + (v[2] * v[2] + v[3] * v[3]); }
        ss += __shfl_xor(ss, 16); ss += __shfl_xor(ss, 32);
        const float rs = (1.0f / sqrtf(ss * (1.0f / 128.0f) + EPS)) * (1.0f - lam_init);
        bf16_t* orow = yo + (size_t)(rb + q0 + 16 * qt + q16) * 512 + h * 128 + 4 * g;
#pragma unroll
        for (int et = 0; et < 8; ++et) { const f32x4 gn = *(const f32x4*)(sg + 16 * et + 4 * g); const f32x4 v = o0[qt][et] * rs * gn;
            u32x2 w; w.x = cvt_pk_bf16(v[0], v[1]); w.y = cvt_pk_bf16(v[2], v[3]); *(u32x2*)(orow + 16 * et) = w; } }
}

__device__ __forceinline__ void prep_ret(const Ctx& a, int l, LAS unsigned char* lds, int bid, int nblk, int tid) {
    const int lane = tid & 63, wave = __builtin_amdgcn_readfirstlane(tid >> 6), gw = bid * 8 + wave, NGW = nblk * 8;
    LAS float* scr = (LAS float*)(lds + wave * 16640);
    const bf16_t* cols = (const bf16_t*)(a.ws + WS_BIG); bf16_t* vtl = (bf16_t*)(a.ws + WS_VTRL); bf16_t* vtc = (bf16_t*)(a.ws + WS_VTRC); bf16_t* st = (bf16_t*)(a.ws + WS_ST);
#pragma unroll 1
    for (int it = gw; it < 2048 + 128; it += NGW) {
        if (it < 1024) { const int b = it >> 7, h = (it >> 5) & 3, tb = (it >> 1) & 15, eb = it & 1;
            transpose64<false>(cols + (size_t)(8192 + b * 1024 + tb * 64) * NMIX + C_RV + h * 128 + eb * 64, NMIX, vtl + (size_t)((b * 4 + h) * 128 + eb * 64) * 1024 + tb * 64, 1024, scr, lane); }
        else if (it < 2048) { const int q = it - 1024, b = q >> 5, h = (q >> 3) & 3, tb = (q >> 1) & 3, eb = q & 1;
            transpose64<false>(cols + (size_t)(b * 256 + tb * 64) * NMIX + C_RV + h * 128 + eb * 64, NMIX, vtc + (size_t)((b * 4 + h) * 128 + eb * 64) * 256 + tb * 64, 256, scr, lane); }
        else { const int q = it - 2048, b = q >> 4, h = (q >> 2) & 3, dir = (q >> 1) & 1, eb = q & 1;
            const float* src = inp(a, dir ? I_SRB : I_SRF) + ((((size_t)b * 2 + l) * 4 + h) * 64) * 128 + eb * 64;
            transpose64<true>(src, 128, st + ((size_t)((b * 4 + h) * 2 + dir) * 128 + eb * 64) * 64, 64, scr, lane); }
    }
}
__device__ __forceinline__ bf16x8 scale8(bf16x8 v, float w) { const u32x4 u = __builtin_bit_cast(u32x4, v); float p[8] = {bf_lo(u.x) * w, bf_hi(u.x) * w, bf_lo(u.y) * w, bf_hi(u.y) * w, bf_lo(u.z) * w, bf_hi(u.z) * w, bf_lo(u.w) * w, bf_hi(u.w) * w}; return pack8(p); }
__device__ __forceinline__ void ret_mfma_item(const Ctx& a, int l, int grp, int h, int qb, int lane) {
    const bf16_t* cols = (const bf16_t*)(a.ws + WS_BIG); bf16_t* yo = (bf16_t*)(a.ws + WS_YBR) + (size_t)3 * M * 512;
    const bool lat = grp >= 32; const int b = lat ? grp - 32 : grp, L = lat ? 1024 : 256, rb = lat ? 8192 + b * 1024 : b * 256;
    const int q16 = lane & 15, g = lane >> 4, q0 = qb * 32;
    const bf16_t* vt = lat ? (const bf16_t*)(a.ws + WS_VTRL) + (size_t)((b * 4 + h) * 128) * 1024 : (const bf16_t*)(a.ws + WS_VTRC) + (size_t)((b * 4 + h) * 128) * 256;
    const float lgf2 = -log1pf(expf(-inp(a, I_RDF)[l * 4 + h])) * 1.44269504088896f, lgb2 = -log1pf(expf(-inp(a, I_RDB)[l * 4 + h])) * 1.44269504088896f;
    bf16x8 bq[2][2];
#pragma unroll
    for (int qt = 0; qt < 2; ++qt)
#pragma unroll
        for (int kd = 0; kd < 2; ++kd) bq[qt][kd] = ldfrag(cols + (size_t)(rb + q0 + 16 * qt + q16) * NMIX + C_RQ + h * 64 + 32 * kd + 8 * g);
    f32x4 O[2][8];
#pragma unroll
    for (int qt = 0; qt < 2; ++qt)
#pragma unroll
        for (int et = 0; et < 8; ++et) O[qt][et] = (f32x4){0.f, 0.f, 0.f, 0.f};
    const int nkb = L >> 5, kr = 8 * (q16 >> 2) + (q16 & 3);
#pragma unroll 1
    for (int kb = 0; kb < nkb; ++kb) {
        const bf16_t* kp0 = cols + (size_t)(rb + kb * 32 + kr) * NMIX + C_RK + h * 64 + 8 * g; const bf16_t* kp1 = kp0 + 4 * NMIX;
        const bf16x8 ak00 = ldfrag(kp0), ak01 = ldfrag(kp0 + 32), ak10 = ldfrag(kp1), ak11 = ldfrag(kp1 + 32);
        bf16x8 pb[2];
#pragma unroll
        for (int qt = 0; qt < 2; ++qt) {
            f32x4 s0 = MFMA16(ak00, bq[qt][0], ((f32x4){0.f, 0.f, 0.f, 0.f})); s0 = MFMA16(ak01, bq[qt][1], s0);
            f32x4 s1 = MFMA16(ak10, bq[qt][0], ((f32x4){0.f, 0.f, 0.f, 0.f})); s1 = MFMA16(ak11, bq[qt][1], s1);
            const float x[8] = {s0[0], s0[1], s0[2], s0[3], s1[0], s1[1], s1[2], s1[3]};
            const int d0 = (q0 + 16 * qt + q16) - (kb * 32 + 8 * g);
            float p[8];
#pragma unroll
            for (int j = 0; j < 8; ++j) { const int d = d0 - j; const float wf = d >= 0 ? __builtin_amdgcn_exp2f((float)d * lgf2) : 0.f, wb = d <= 0 ? __builtin_amdgcn_exp2f((float)(-d) * lgb2) : 0.f;
                p[j] = x[j] * 0.125f * (wf + wb); }
            pb[qt] = pack8(p);
        }
#pragma unroll
        for (int et = 0; et < 8; ++et) { const bf16x8 av = ldfrag(vt + (size_t)(16 * et + q16) * L + kb * 32 + 8 * g);
            O[0][et] = MFMA16(av, pb[0], O[0][et]); O[1][et] = MFMA16(av, pb[1], O[1][et]); }
    }
    if (lat) { const bf16_t* stf = (const bf16_t*)(a.ws + WS_ST) + (size_t)((b * 4 + h) * 2) * 128 * 64; const bf16_t* stb = stf + 128 * 64;
        bf16x8 qf[2][2], qk[2][2];
#pragma unroll
        for (int qt = 0; qt < 2; ++qt) { const int t = q0 + 16 * qt + q16; const float wf = __builtin_amdgcn_exp2f((float)(t + 1) * lgf2), wb = __builtin_amdgcn_exp2f((float)(L - t) * lgb2);
#pragma unroll
            for (int kd = 0; kd < 2; ++kd) { qf[qt][kd] = scale8(bq[qt][kd], wf); qk[qt][kd] = scale8(bq[qt][kd], wb); } }
#pragma unroll
        for (int et = 0; et < 8; ++et) { const bf16_t* pf = stf + (size_t)(16 * et + q16) * 64 + 8 * g; const bf16_t* pb2 = stb + (size_t)(16 * et + q16) * 64 + 8 * g;
            const bf16x8 f0 = ldfrag(pf), f1 = ldfrag(pf + 32), b0 = ldfrag(pb2), b1 = ldfrag(pb2 + 32);
#pragma unroll
            for (int qt = 0; qt < 2; ++qt) { O[qt][et] = MFMA16(f0, qf[qt][0], O[qt][et]); O[qt][et] = MFMA16(f1, qf[qt][1], O[qt][et]); O[qt][et] = MFMA16(b0, qk[qt][0], O[qt][et]); O[qt][et] = MFMA16(b1, qk[qt][1], O[qt][et]); }
            asm volatile("" ::: "memory"); } }
#pragma unroll
    for (int qt = 0; qt < 2; ++qt) { float ss = 0.f;
#pragma unroll
        for (int et = 0; et < 8; ++et) { const f32x4 v = O[qt][et]; ss += (v[0] * v[0] + v[1] * v[1]) + (v[2] * v[2] + v[3] * v[3]); }
        ss += __shfl_xor(ss, 16); ss += __shfl_xor(ss, 32);
        const float rs = 1.0f / sqrtf(ss * (1.0f / 128.0f) + EPS);
        const size_t row = (size_t)(rb + q0 + 16 * qt + q16);
        const bf16_t* rg = cols + row * NMIX + C_RG + h * 128 + 4 * g; bf16_t* orow = yo + row * 512 + h * 128 + 4 * g;
#pragma unroll
        for (int et = 0; et < 8; ++et) { const u32x2 gw2 = *(const u32x2*)(rg + 16 * et); const float g0 = bf_lo(gw2.x), g1 = bf_hi(gw2.x), g2 = bf_lo(gw2.y), g3 = bf_hi(gw2.y);
            const f32x4 v = O[qt][et] * rs;
            u32x2 w; w.x = cvt_pk_bf16(v[0] * (g0 / (1.0f + __expf(-g0))), v[1] * (g1 / (1.0f + __expf(-g1)))); w.y = cvt_pk_bf16(v[2] * (g2 / (1.0f + __expf(-g2))), v[3] * (g3 / (1.0f + __expf(-g3))));
            *(u32x2*)(orow + 16 * et) = w; } }
}

__device__ __forceinline__ void prep_win(const Ctx& a, int l, LAS unsigned char* lds, int bid, int nblk, int tid) {
    const int lane = tid & 63, wave = __builtin_amdgcn_readfirstlane(tid >> 6), gw = bid * 8 + wave, NGW = nblk * 8, gtid = bid * 512 + tid, NT = nblk * 512;
    LAS float* scr = (LAS float*)(lds + wave * 16640);
    const bf16_t* cols = (const bf16_t*)(a.ws + WS_BIG); bf16_t* vtl = (bf16_t*)(a.ws + WS_VTWL); bf16_t* vtc = (bf16_t*)(a.ws + WS_VTWC);
#pragma unroll 1
    for (int it = gw; it < 640; it += NGW) {
        if (it < 256) { const int b = it >> 5, hk = (it >> 4) & 1, tb = it & 15;
            transpose64<false>(cols + (size_t)(8192 + b * 1024 + tb * 64) * NMIX + C_WV + hk * 64, NMIX, vtl + (size_t)((b * 2 + hk) * 64) * 1536 + tb * 64, 1536, scr, lane); }
        else if (it < 384) { const int q = it - 256, b = q >> 4, hk = (q >> 3) & 1, jb = q & 7;
            transpose64<true>(inp(a, I_CWV) + ((((size_t)b * 2 + l) * 512 + jb * 64) * 2 + hk) * 64, 128, vtl + (size_t)((b * 2 + hk) * 64) * 1536 + 1024 + jb * 64, 1536, scr, lane); }
        else { const int q = it - 384, b = q >> 3, hk = (q >> 2) & 1, tb = q & 3;
            transpose64<false>(cols + (size_t)(b * 256 + tb * 64) * NMIX + C_WV + hk * 64, NMIX, vtc + (size_t)((b * 2 + hk) * 64) * 256 + tb * 64, 256, scr, lane); }
    }
    { bf16_t* kwc = (bf16_t*)(a.ws + WS_KWC); const float* ck = inp(a, I_CWK);
      for (int i = gtid; i < 8 * 2 * 512 * 8; i += NT) { const int d8 = i & 7, j = (i >> 3) & 511, hk = (i >> 12) & 1, b = i >> 13;
          const float4* p = (const float4*)(ck + ((((size_t)b * 2 + l) * 512 + j) * 2 + hk) * 64 + d8 * 8); const float4 u = p[0], v = p[1];
          uint4 w; w.x = pk2(u.x, u.y); w.y = pk2(u.z, u.w); w.z = pk2(v.x, v.y); w.w = pk2(v.z, v.w);
          *(uint4*)(kwc + (((size_t)b * 2 + hk) * 512 + j) * 64 + d8 * 8) = w; } }
}
__device__ __forceinline__ void win_mfma_item(const Ctx& a, int l, int grp, int hk, int tb, int lane) {
    const bf16_t* cols = (const bf16_t*)(a.ws + WS_BIG); bf16_t* yo = (bf16_t*)(a.ws + WS_YBR) + (size_t)2 * M * 512;
    const bool lat = grp >= 32; const int b = lat ? grp - 32 : grp, L = lat ? 1024 : 256, rb = lat ? 8192 + b * 1024 : b * 256, nk = lat ? 1536 : 256;
    const int q16 = lane & 15, g = lane >> 4, t0 = tb * 16, t = t0 + q16;
    const bf16_t* vt = lat ? (const bf16_t*)(a.ws + WS_VTWL) + (size_t)((b * 2 + hk) * 64) * 1536 : (const bf16_t*)(a.ws + WS_VTWC) + (size_t)((b * 2 + hk) * 64) * 256;
    const bf16_t* kwc = (const bf16_t*)(a.ws + WS_KWC) + (size_t)(b * 2 + hk) * 512 * 64;
    bf16x8 bq[4][2]; float m[4], ls[4]; f32x4 O[4][4];
#pragma unroll
    for (int qh = 0; qh < 4; ++qh) { m[qh] = inp(a, I_WSINK)[l * 8 + hk * 4 + qh] * 1.44269504088896f; ls[qh] = g == 0 ? 1.0f : 0.0f;
#pragma unroll
        for (int kd = 0; kd < 2; ++kd) bq[qh][kd] = ldfrag(cols + (size_t)(rb + t) * NMIX + C_WQ + (hk * 4 + qh) * 64 + 32 * kd + 8 * g);
#pragma unroll
        for (int et = 0; et < 4; ++et) O[qh][et] = (f32x4){0.f, 0.f, 0.f, 0.f}; }
    const int kr = 8 * (q16 >> 2) + (q16 & 3); const float sc2 = 0.125f * 1.44269504088896f;
    const int kb_lo = lat ? max(0, (t0 - 128) >> 5) : 0, kb_hi = lat ? min(31, (t0 + 143) >> 5) : 7, ncache = lat ? 16 : 0, nblocks = (kb_hi - kb_lo + 1) + ncache;
#pragma unroll 1
    for (int ib = 0; ib < nblocks; ++ib) {
        const bool tok = ib <= kb_hi - kb_lo; const int kb = tok ? kb_lo + ib : ib - (kb_hi - kb_lo + 1);
        const bf16_t* kp0; const bf16_t* kp1; int vcol;
        if (tok) { kp0 = cols + (size_t)(rb + kb * 32 + kr) * NMIX + C_WK + hk * 64 + 8 * g; kp1 = kp0 + 4 * NMIX; vcol = kb * 32; }
        else { kp0 = kwc + (size_t)(kb * 32 + kr) * 64 + 8 * g; kp1 = kp0 + 4 * 64; vcol = 1024 + kb * 32; }
        const bf16x8 ak00 = ldfrag(kp0), ak01 = ldfrag(kp0 + 32), ak10 = ldfrag(kp1), ak11 = ldfrag(kp1 + 32);
        const bool domask = lat && tok; const int dk0 = t - (kb * 32 + 8 * g);
        bf16x8 pb[4];
#pragma unroll
        for (int qh = 0; qh < 4; ++qh) {
            f32x4 s0 = MFMA16(ak00, bq[qh][0], ((f32x4){0.f, 0.f, 0.f, 0.f})); s0 = MFMA16(ak01, bq[qh][1], s0);
            f32x4 s1 = MFMA16(ak10, bq[qh][0], ((f32x4){0.f, 0.f, 0.f, 0.f})); s1 = MFMA16(ak11, bq[qh][1], s1);
            float x[8] = {s0[0] * sc2, s0[1] * sc2, s0[2] * sc2, s0[3] * sc2, s1[0] * sc2, s1[1] * sc2, s1[2] * sc2, s1[3] * sc2};
            if (domask) {
#pragma unroll
                for (int j = 0; j < 8; ++j) { const int d = dk0 - j; if (d > 128 || d < -128) x[j] = -1e30f; } }
            float ml = fmaxf(fmaxf(fmaxf(x[0], x[1]), fmaxf(x[2], x[3])), fmaxf(fmaxf(x[4], x[5]), fmaxf(x[6], x[7])));
            ml = fmaxf(ml, __shfl_xor(ml, 16)); ml = fmaxf(ml, __shfl_xor(ml, 32));
            const float mn = fmaxf(m[qh], ml), alpha = __builtin_amdgcn_exp2f(m[qh] - mn); m[qh] = mn;
            float p[8], psum = 0.f;
#pragma unroll
            for (int j = 0; j < 8; ++j) { p[j] = __builtin_amdgcn_exp2f(x[j] - mn); psum += p[j]; }
            ls[qh] = ls[qh] * alpha + psum;
#pragma unroll
            for (int et = 0; et < 4; ++et) O[qh][et] = O[qh][et] * alpha;
            pb[qh] = pack8(p);
        }
#pragma unroll
        for (int et = 0; et < 4; ++et) { const bf16x8 av = ldfrag(vt + (size_t)(16 * et + q16) * nk + vcol + 8 * g);
#pragma unroll
            for (int qh = 0; qh < 4; ++qh) O[qh][et] = MFMA16(av, pb[qh], O[qh][et]); }
    }
#pragma unroll
    for (int qh = 0; qh < 4; ++qh) { float lt = ls[qh]; lt += __shfl_xor(lt, 16); lt += __shfl_xor(lt, 32); const float inv = 1.0f / lt;
        bf16_t* orow = yo + (size_t)(rb + t) * 512 + (hk * 4 + qh) * 64 + 4 * g;
#pragma unroll
        for (int et = 0; et < 4; ++et) { const f32x4 v = O[qh][et] * inv; u32x2 w; w.x = cvt_pk_bf16(v[0], v[1]); w.y = cvt_pk_bf16(v[2], v[3]); *(u32x2*)(orow + 16 * et) = w; } }
}

__device__ __forceinline__ void hy_mfma_item(const Ctx& a, int l, int it, int lane, LAS unsigned* fl  ) {
    const bf16_t* cols = (const bf16_t*)(a.ws + WS_BIG); bf16_t* yo = (bf16_t*)(a.ws + WS_YBR);
    const bool lat = it < 2048; const int c = lat ? it >> 2 : (it - 2048) >> 1, sub = lat ? it & 3 : (it - 2048) & 1;
    const int L = lat ? 1024 : 256, NB = lat ? 8 : 32, tg0 = lat ? sub * 256 : 0, b0 = lat ? 0 : sub * 16;
    const int tl = lane & 15, g = lane >> 4;
    const bf16_t* gt = (const bf16_t*)(a.ws + WS_GRT) + (size_t)l * (512 * 2560) + (lat ? 512 * 512 : 0) + (size_t)c * (2 * L);
    { const u32x4* src = (const u32x4*)gt; LAS u32x4* dst = (LAS u32x4*)fl;
      for (int i = lane; i < (2 * L) / 8; i += 64) dst[i] = src[i];
      LDS_WAIT(); asm volatile("" ::: "memory"); }
    const bf16_t* zt = (const bf16_t*)(a.ws + WS_ZB) + (lat ? ((size_t)c * 8 + (tl & 7)) * 1024 : (size_t)512 * 8 * 1024 + ((size_t)c * 32 + b0 + tl) * 256) + 8 * g;
    f32x4 acc[16];
#pragma unroll
    for (int tt = 0; tt < 16; ++tt) acc[tt] = (f32x4){0.f, 0.f, 0.f, 0.f};
#pragma unroll 1
    for (int s0 = 0; s0 < L; s0 += 32) { const bf16x8 zf = ldfrag(zt + s0);
        const int idx0 = L - 1 - (tg0 + tl) + s0 + 8 * g;
#pragma unroll
        for (int tt = 0; tt < 16; ++tt) { const int idx = idx0 - 16 * tt; const unsigned sh = (unsigned)(idx & 1) * 16u; const LAS unsigned* q = fl + (idx >> 1);
            const unsigned d0 = q[0], d1 = q[1], d2 = q[2], d3 = q[3], d4 = q[4];
            u32x4 w; w.x = __builtin_amdgcn_alignbit(d1, d0, sh); w.y = __builtin_amdgcn_alignbit(d2, d1, sh); w.z = __builtin_amdgcn_alignbit(d3, d2, sh); w.w = __builtin_amdgcn_alignbit(d4, d3, sh);
            acc[tt] = MFMA16(zf, __builtin_bit_cast(bf16x8, w), acc[tt]); } }
    const float* cw = inp(a, I_HCW) + l * 3 * 1536; const float cb = inp(a, I_HCB)[l * 1536 + 512 + c], sk = inp(a, I_HSKIP)[l * 512 + c];
    const float w0 = cw[512 + c], w1 = cw[1536 + 512 + c], w2 = cw[3072 + 512 + c];
    if (!lat || g < 2) {
#pragma unroll
        for (int tt = 0; tt < 16; ++tt) { const int t = tg0 + 16 * tt + tl;
#pragma unroll
            for (int r = 0; r < 4; ++r) { const int bb = b0 + 4 * g + r; const size_t row = (lat ? 8192 + (size_t)bb * 1024 : (size_t)bb * 256) + t; const bf16_t* p = cols + row * NMIX + 512 + c;
                const float xm = t > 0 ? bf2f(p[-NMIX]) : 0.f, x0 = bf2f(p[0]), xp = t < L - 1 ? bf2f(p[NMIX]) : 0.f;
                const float z = bf2f(((const bf16_t*)(a.ws + WS_ZB))[(lat ? ((size_t)c * 8 + bb) * 1024 : (size_t)512 * 8 * 1024 + ((size_t)c * 32 + bb) * 256) + t]);
                yo[row * 512 + c] = (bf16_t)f2bf((xm * w0 + x0 * w1 + xp * w2 + cb) * (acc[tt][r] + sk * z)); } } }
    LDS_WAIT(); asm volatile("" ::: "memory");
}
#define LAUNDER_MIX() do { unsigned long long w_ = (unsigned long long)a.ws, o_ = (unsigned long long)a.out; unsigned t_ = (unsigned)(size_t)a.tab; \
    asm volatile("" : "+s"(w_), "+s"(o_), "+s"(t_), "+s"(l), "+s"(gw), "+s"(NGW)); asm volatile("" : "+v"(lane)); a.ws = (unsigned char*)w_; a.out = (float*)o_; a.tab = (const LAS unsigned long long*)(size_t)t_; } while (0)
__device__ __forceinline__ void phase_mix(const Ctx& a0, int l, LAS unsigned char* lds, int bid, int nblk, int tid) {
    int lane = tid & 63; const int wave = __builtin_amdgcn_readfirstlane(tid >> 6); int gw = bid * 8 + wave, NGW = nblk * 8;
    LAS float* qs = (LAS float*)(lds + wave * 16640);
    Ctx a = a0;
    LAUNDER_MIX();
#pragma unroll 1
    for (int r = gw; r < 2048; r += NGW) { if (r < 1024) diff_mfma_item(a, l, 32 + (r >> 7), (r >> 5) & 3, r & 31, lane, qs); else { const int q = r - 1024; diff_mfma_item(a, l, q >> 5, (q >> 3) & 3, q & 7, lane, qs); } }
    LAUNDER_MIX();
#pragma unroll 1
    for (int r = gw; r < 2048; r += NGW) { if (r < 1024) ret_mfma_item(a, l, 32 + (r >> 7), (r >> 5) & 3, r & 31, lane); else { const int q = r - 1024; ret_mfma_item(a, l, q >> 5, (q >> 3) & 3, q & 7, lane); } }
    LAUNDER_MIX();
#pragma unroll 1
    for (int r = gw; r < 2048; r += NGW) { if (r < 1024) win_mfma_item(a, l, 32 + (r >> 7), (r >> 6) & 1, r & 63, lane); else { const int q = r - 1024; win_mfma_item(a, l, q >> 5, (q >> 4) & 1, q & 15, lane); } }
    LAUNDER_MIX();
#pragma unroll 1
    for (int r = gw; r < 3072; r += NGW) hy_mfma_item(a, l, r, lane, (LAS unsigned*)qs);
    LAUNDER_MIX();
#pragma unroll 1
    for (int r = gw; r < 16384; r += NGW) retstate_thread(a, l, r * 64 + lane);
}
template <class Epi> __device__ __forceinline__ void run_gemm(LAS unsigned char* lds, const bf16_t* A, const bf16_t* Bt, int N, int K, const Epi& E, int bid, int nblk) {
    pg8::Gemm g{A, Bt, M, N, K}; pg8::StaticOrder S; S.init(M, N, nblk, bid);
    pg8::gemm_phase<Epi, pg8::StaticOrder, false>(lds, g, S, E, nullptr);
}
#define XB_TMO      128
#define XB_XCNT(j)  (256  + 64 * (j))
#define XB_XSUB(j)  (1280 + 64 * (j))
#define XB_XGEN(j)  (2304 + 64 * (j))
#define XB_TOP      3328
#define XB_TOPGEN   3392
#define XCD_BAR_WORDS 3456
#define XB_SPIN_CAP (1u << 18)

__device__ __forceinline__ unsigned xb_ld(unsigned* p)              { return __hip_atomic_load(p, __ATOMIC_RELAXED, __HIP_MEMORY_SCOPE_AGENT); }
__device__ __forceinline__ unsigned xb_add(unsigned* p, unsigned v) { return __hip_atomic_fetch_add(p, v, __ATOMIC_RELAXED, __HIP_MEMORY_SCOPE_AGENT); }
__device__ __forceinline__ unsigned xb_xcc_id() { return (unsigned)__builtin_amdgcn_s_getreg((3 << 11) | 20) & 0xFu; }
#define XB_SPIN(cond, bar) do { unsigned _sp = 0; while (cond) { __builtin_amdgcn_s_sleep(1); \
    if ((++_sp & 255u) == 0u) { if (xb_ld(&(bar)[XB_TMO])) break; if (_sp > XB_SPIN_CAP) { atomicAdd(&(bar)[XB_TMO], 1u); break; } } } } while (0)

struct XcdBarrier {
    unsigned* bar; unsigned x;
    volatile LAS unsigned* st;
};

__device__ __forceinline__ XcdBarrier xcd_barrier_post(unsigned* bar, volatile LAS unsigned* st) {
    XcdBarrier b; b.bar = bar; b.x = xb_xcc_id(); b.st = st;
    if (threadIdx.x == 0) (void)xb_add(&bar[XB_XCNT(b.x)], 1u);
    return b;
}
__device__ __forceinline__ void xcd_barrier_complete(unsigned* bar, unsigned x, unsigned& nloc, unsigned& nx) {
    const unsigned G = gridDim.x * gridDim.y * gridDim.z;
    unsigned sum, cnt, mine, sp = 0u;
    for (;;) {
        sum = 0u; cnt = 0u; mine = 0u;
#pragma unroll
        for (unsigned j = 0; j < 16; ++j) { const unsigned c = xb_ld(&bar[XB_XCNT(j)]); sum += c; cnt += (c > 0u) ? 1u : 0u; mine = (j == x) ? c : mine; }
        if (sum == G) break;
        __builtin_amdgcn_s_sleep(1);
        if ((++sp & 255u) == 0u) { if (xb_ld(&bar[XB_TMO])) break; if (sp > XB_SPIN_CAP) { atomicAdd(&bar[XB_TMO], 1u); break; } }
    }
    nloc = mine > 0u ? mine : 1u; nx = cnt > 0u ? cnt : 1u;
}

__device__ __forceinline__ void xcd_barrier(const XcdBarrier& b) {
    asm volatile("s_waitcnt vmcnt(0)" ::: "memory");
    __syncthreads();
    if (threadIdx.x == 0) {
        unsigned* bar = b.bar;
        __builtin_amdgcn_s_waitcnt(0);
        unsigned nloc = b.st[0], nx = b.st[1];
        if (nloc == 0u) { xcd_barrier_complete(bar, b.x, nloc, nx); b.st[0] = nloc; b.st[1] = nx; }
        const unsigned old = xb_add(&bar[XB_XSUB(b.x)], 1u);
        const unsigned gen = old / nloc;
        if (old + 1u == (gen + 1u) * nloc) {
            __builtin_amdgcn_fence(__ATOMIC_RELEASE, "agent");
            asm volatile("s_waitcnt vmcnt(0)" ::: "memory");
            const unsigned og = xb_add(&bar[XB_TOP], 1u);
            const unsigned tg = og / nx;
            if (og + 1u == (tg + 1u) * nx) xb_add(&bar[XB_TOPGEN], 1u);
            else XB_SPIN(xb_ld(&bar[XB_TOPGEN]) == tg, bar);
            __builtin_amdgcn_fence(__ATOMIC_ACQUIRE, "agent");
            xb_add(&bar[XB_XGEN(b.x)], 1u);
            asm volatile("s_waitcnt vmcnt(0)" ::: "memory");
        } else {
            XB_SPIN(xb_ld(&bar[XB_XGEN(b.x)]) == gen, bar);
            __builtin_amdgcn_fence(__ATOMIC_ACQUIRE, "agent");
            asm volatile("s_waitcnt vmcnt(0)" ::: "memory");
        }
    }
    __syncthreads();
}

template <int SL> __device__ __forceinline__ void run_slot(const Ctx& a0, int l, LAS unsigned char* lds, int bid, int nblk, int tid) {
    Ctx a = a0;
    { unsigned long long w = (unsigned long long)a.ws, o = (unsigned long long)a.out; unsigned t = (unsigned)(size_t)a.tab, ld = (unsigned)(size_t)lds;
      asm volatile("" : "+s"(w), "+s"(o), "+s"(t), "+s"(ld), "+s"(l), "+s"(bid), "+s"(nblk)); asm volatile("" : "+v"(tid));
      a.ws = (unsigned char*)w; a.out = (float*)o; a.tab = (const LAS unsigned long long*)(size_t)t; lds = (LAS unsigned char*)(size_t)ld; }
    unsigned char* ws = a.ws; unsigned char* wb = ws + WS_W;
    bf16_t* H = (bf16_t*)(ws + WS_H); bf16_t* BIG = (bf16_t*)(ws + WS_BIG); bf16_t* YBR = (bf16_t*)(ws + WS_YBR);
    float* MERGEP = (float*)(ws + WS_BIG + 128 * MiB);
    const float* modl = (const float*)(ws + WS_MOD) + (size_t)l * 9 * 9216;
    if constexpr (SL == 0) phase_p0a(a, lds, bid, nblk, tid);
    if constexpr (SL == 1) phase_p0b(a, lds, bid, nblk, tid);
    if constexpr (SL == 2) { if (l == 1) convert_weights(a, 1, lds, bid * 8 + (tid >> 6), nblk * 8, tid >> 6, tid & 63); phase_norm(a, l, I_NFA, 0, bid, nblk, tid); }
    if constexpr (SL == 3) run_gemm(lds, H, (const bf16_t*)(wb + W_FA_IN), 2 * DFF, D, pg8::EpiSwiGLU{BIG, DFF}, bid, nblk);
    if constexpr (SL == 4) run_gemm(lds, BIG, (const bf16_t*)(wb + W_FA_OUT), D, DFF, pg8::EpiResid{a.out, modl + 2 * 1024, 0.5f}, bid, nblk);
    if constexpr (SL == 5) phase_norm(a, l, I_NMIX, 3, bid, nblk, tid);
    if constexpr (SL == 6) run_gemm(lds, H, (const bf16_t*)(wb + W_IN), NMIX, D, pg8::EpiStore<0>{BIG, NMIX}, bid, nblk);
    if constexpr (SL == 7) { phase_prep(a, l, bid, nblk, tid); prep_diff(a, l, lds, bid, nblk, tid); prep_ret(a, l, lds, bid, nblk, tid); prep_win(a, l, lds, bid, nblk, tid); prep_hy(a, l, lds, bid, nblk, tid); }
    if constexpr (SL == 8) phase_mix(a, l, lds, bid, nblk, tid);
    if constexpr (SL == 9) run_gemm(lds, H, (const bf16_t*)(wb + W_IN) + (size_t)NMIX * D, NGATE, D, pg8::EpiStore<1>{BIG, NGATE}, bid, nblk);
    if constexpr (SL == 10) {
#pragma unroll 1
        for (int b = 0; b < 4; ++b) run_gemm(lds, YBR + (size_t)b * M * 512, (const bf16_t*)(wb + W_BR) + (size_t)b * D * 512, D, 512, pg8::EpiMerge{MERGEP, BIG, H, b * 1024, b == 0 ? 0 : (b == 3 ? 2 : 1)}, bid, nblk); }
    if constexpr (SL == 11) run_gemm(lds, H, (const bf16_t*)(wb + W_OUT), D, D, pg8::EpiResid{a.out, modl + 5 * 1024, 1.0f}, bid, nblk);
    if constexpr (SL == 12) phase_norm(a, l, I_NFB, 6, bid, nblk, tid);
    if constexpr (SL == 13) run_gemm(lds, H, (const bf16_t*)(wb + W_FB_IN), 2 * DFF, D, pg8::EpiSwiGLU{BIG, DFF}, bid, nblk);
    if constexpr (SL == 14) run_gemm(lds, BIG, (const bf16_t*)(wb + W_FB_OUT), D, DFF, pg8::EpiResid{a.out, modl + 8 * 1024, 0.5f}, bid, nblk);
}
template <int SL> __global__ void __launch_bounds__(512, 2) k_slot(Args a) {
    extern __shared__ __attribute__((aligned(16))) unsigned char lds_raw[];
    const Ctx c = make_ctx(a, (LAS unsigned char*)lds_raw, threadIdx.x);
    run_slot<SL>(c, a.ph_lo, (LAS unsigned char*)lds_raw, blockIdx.x, gridDim.x, threadIdx.x);
}

constexpr int CW_BAR = 4096;
__global__ void __launch_bounds__(512, 2) mega(Args a) {
    extern __shared__ __attribute__((aligned(16))) unsigned char lds_raw[];
    LAS unsigned char* lds = (LAS unsigned char*)lds_raw;
    const int tid = threadIdx.x, bid = blockIdx.x, nblk = gridDim.x;
    volatile LAS unsigned* st = (volatile LAS unsigned*)(lds + LDS_ST_OFF);
    const Ctx c = make_ctx(a, lds, tid);
    const XcdBarrier bar = xcd_barrier_post((unsigned*)(a.ws + WS_CTL) + CW_BAR, st);
#define GB() do { XcdBarrier b_ = bar; unsigned long long bp_ = (unsigned long long)b_.bar; unsigned bx_ = b_.x; asm volatile("" : "+s"(bp_), "+s"(bx_)); b_.bar = (unsigned*)bp_; b_.x = bx_; xcd_barrier(b_); } while (0)
#ifndef MEGA_MASK
#define MEGA_MASK 0x7fff
#endif
#define RS(k) if constexpr ((MEGA_MASK >> k) & 1) run_slot<k>
    RS(0)(c, 0, lds, bid, nblk, tid); GB();
    RS(1)(c, 0, lds, bid, nblk, tid); GB();
#pragma unroll 1
    for (int l = 0; l < 2; ++l) {
        RS(2)(c, l, lds, bid, nblk, tid); GB();
        RS(3)(c, l, lds, bid, nblk, tid); GB();
        RS(4)(c, l, lds, bid, nblk, tid); GB();
        RS(5)(c, l, lds, bid, nblk, tid); GB();
        RS(6)(c, l, lds, bid, nblk, tid); GB();
        RS(7)(c, l, lds, bid, nblk, tid); GB();
        RS(8)(c, l, lds, bid, nblk, tid); GB();
        RS(9)(c, l, lds, bid, nblk, tid); GB();
        RS(10)(c, l, lds, bid, nblk, tid); GB();
        RS(11)(c, l, lds, bid, nblk, tid); GB();
        RS(12)(c, l, lds, bid, nblk, tid); GB();
        RS(13)(c, l, lds, bid, nblk, tid); GB();
        RS(14)(c, l, lds, bid, nblk, tid); if (l == 0) GB();
    }
#undef GB
#undef RS
}
template <int SL> static void launch_slot(const Args& a, int grid, hipStream_t stream) {
    static bool attr = false;
    if (!attr) { (void)hipFuncSetAttribute((const void*)k_slot<SL>, hipFuncAttributeMaxDynamicSharedMemorySize, LDS_BYTES); attr = true; }
    hipLaunchKernelGGL(k_slot<SL>, dim3(grid), dim3(512), LDS_BYTES, stream, a);
}

#ifdef DIAG_YBR
__global__ void k_diag(Args a) {
    for (size_t i = (size_t)blockIdx.x * blockDim.x + threadIdx.x; i < (size_t)M * 1024; i += (size_t)gridDim.x * blockDim.x) { const size_t row = i >> 10, c = i & 1023;
#if DIAG_YBR < 4
        const bf16_t* y = (const bf16_t*)(a.ws + WS_YBR) + (size_t)DIAG_YBR * M * 512;
        a.out[i] = bf2f(y[(c >> 9) * (size_t)M * 512 + row * 512 + (c & 511)]);
#elif DIAG_YBR == 4
        a.out[i] = bf2f(((const bf16_t*)(a.ws + WS_H))[i]);
#elif DIAG_YBR >= 5 && DIAG_YBR < 9
        a.out[i] = bf2f(((const bf16_t*)(a.ws + WS_BIG))[row * 4096 + (DIAG_YBR - 5) * 1024 + c]);
#elif DIAG_YBR == 9
        a.out[i] = ((const float*)(a.ws + WS_BIG + 128 * MiB))[i];
#elif DIAG_YBR >= 10 && DIAG_YBR < 15
        a.out[i] = bf2f(((const bf16_t*)(a.ws + WS_BIG))[row * 5376 + (DIAG_YBR - 10) * 1024 + c]);
#elif DIAG_YBR >= 15 && DIAG_YBR < 17
        a.out[i] = bf2f(((const bf16_t*)(a.ws + WS_BIG))[row * 2816 + (DIAG_YBR - 15) * 1024 + c]);
#endif
    }
}
#endif
extern "C" void kernel_launch(void* const* d_in, const int* in_sizes, int n_in, void* d_out, int out_size, void* d_ws, size_t ws_size, hipStream_t stream) {
    static int grid = 0;
    if (grid == 0) {
        if (n_in != N_IN || out_size != (int)O_END || ws_size < WS_END) { fprintf(stderr, "kernel_launch: unexpected shapes: n_in %d out %d ws %zu (need %zu)\n", n_in, out_size, ws_size, (size_t)WS_END); grid = -1; return; }
        int dev = 0, cus = 0;
        if (hipGetDevice(&dev) != hipSuccess || hipDeviceGetAttribute(&cus, hipDeviceAttributeMultiprocessorCount, dev) != hipSuccess) { grid = -1; return; }
        grid = cus > 0 ? cus : 256;
    }
    if (grid < 0) return;
    (void)hipMemsetAsync((char*)d_ws + WS_CTL, 0, CTL_ZERO_BYTES, stream);
    Args a{};
    for (int i = 0; i < N_IN; ++i) a.in[i] = (const float*)d_in[i];
    a.out = (float*)d_out; a.ws = (unsigned char*)d_ws;
    a.ph_lo = 0; a.ph_hi = 0;
#ifndef MULTI_LAUNCH
    { static bool attr = false; if (!attr) { (void)hipFuncSetAttribute((const void*)mega, hipFuncAttributeMaxDynamicSharedMemorySize, LDS_BYTES); attr = true; }
      hipLaunchKernelGGL(mega, dim3(grid), dim3(512), LDS_BYTES, stream, a); return; }
#endif
    int nl = 0;
#ifndef STOP_AFTER
#define STOP_AFTER 1000
#endif
#define LS(k) do { if (nl++ < STOP_AFTER) launch_slot<k>(a, grid, stream); } while (0)
    LS(0); LS(1);
    for (int l = 0; l < 2; ++l) { a.ph_lo = l;
        LS(2); LS(3); LS(4); LS(5); LS(6); LS(7); LS(8); LS(9); LS(10); LS(11); LS(12); LS(13); LS(14); }
#ifdef DIAG_YBR
    hipLaunchKernelGGL(k_diag, dim3(1024), dim3(256), 0, stream, a);
#endif
}
```

```cpp
#include <hip/hip_runtime.h>
#include <cstdio>
#include <cstdint>
namespace pg8 {
#define PG8_LAS __attribute__((address_space(3)))
typedef unsigned short bf16_t;
typedef short bf16x8 __attribute__((ext_vector_type(8)));
typedef float f32x4 __attribute__((ext_vector_type(4)));
typedef unsigned u32x4 __attribute__((ext_vector_type(4)));
constexpr int BM = 256, BK = 64, HALF = 128, HTB = HALF * BK * 2  , STAGE_BYTES = 8 * HTB, NXCD = 8, WGM = 8;

__host__ __device__ __forceinline__ int lds_byte(int r, int c) { const int st = (r >> 4) * 2 + (c >> 5), rr = r & 15, cc = c & 31, ob = rr * 64 + cc * 2; return st * 1024 + (ob ^ (((ob >> 9) & 1) << 5)); }
__host__ __device__ __forceinline__ void stage_rc(int b, int& R, int& C) { const int st = b / 1024, sb = b % 1024, swz = sb ^ (((sb >> 9) & 1) << 5); R = (st >> 1) * 16 + swz / 64; C = (st & 1) * 32 + (swz % 64) / 2; }
__host__ __device__ __forceinline__ int perm32(int rho) { const int n = rho >> 4, i = rho & 15; return 8 * (i >> 2) + 4 * n + (i & 3); }

struct Unit { int pm, pn; };
struct Gemm { const bf16_t* A; const bf16_t* Bt; int M, N, K; };

struct StaticOrder {
    int nM, nN, nwg, G, c;
    __host__ __device__ void init(int M, int N, int G_, int c_) { nM = M / BM; nN = N / BM; nwg = nM * nN; G = G_; c = c_; }
    __host__ __device__ bool next(int i, Unit& u) const {
        const long L = (long)i * G + c; if (L >= nwg) return false;
        int wgid = (int)L; { const int q = nwg / NXCD, r = nwg % NXCD, xcd = wgid % NXCD, off = wgid / NXCD; wgid = (xcd < r ? xcd * (q + 1) : r * (q + 1) + (xcd - r) * q) + off; }
        const int nig = WGM * nN, gid = wgid / nig, fm = gid * WGM, gsz = (nM - fm) < WGM ? (nM - fm) : WGM;
        u.pm = fm + ((wgid % nig) % gsz); u.pn = (wgid % nig) / gsz; return true;
    }
    __device__ __forceinline__ void a_ready(const Unit&) const {}
    __device__ __forceinline__ void done(const Unit&) const {}
};
typedef __bf16 bf16x2n __attribute__((ext_vector_type(2)));
typedef float f32x2n __attribute__((ext_vector_type(2)));
__device__ __forceinline__ unsigned cvt_pk_bf16(float lo, float hi) { f32x2n v = {lo, hi}; bf16x2n b = __builtin_convertvector(v, bf16x2n); return __builtin_bit_cast(unsigned, b); }
typedef float f32x2 __attribute__((ext_vector_type(2)));
typedef unsigned u32x2 __attribute__((ext_vector_type(2)));
__device__ __forceinline__ float fast_sigmoid(float a) { return __builtin_amdgcn_rcpf(1.0f + __expf(-a)); }
__device__ __forceinline__ float bf_lo(unsigned u) { return __uint_as_float(u << 16); }
__device__ __forceinline__ float bf_hi(unsigned u) { return __uint_as_float(u & 0xffff0000u); }

struct EpiSwiGLU {
    static constexpr bool PERM = true, AFTER_DRAIN = false;
    bf16_t* O; int ldo;
    __device__ __forceinline__ void operator()(const f32x4 (&acc)[2][2][4][2], const Unit& u, int wr, int wc, int fr, int fq) const {
        const int row0 = u.pm * BM + wr * 64 + fr, col0 = u.pn * HALF + wc * 32 + 8 * fq;
#pragma unroll
        for (int ai = 0; ai < 2; ++ai)
#pragma unroll
            for (int m = 0; m < 4; ++m) { bf16_t* rowp = O + (size_t)(row0 + ai * HALF + m * 16) * ldo + col0;
                f32x4 v0, v1;
#pragma unroll
                for (int j = 0; j < 4; ++j) { const float a0 = acc[ai][0][m][0][j], a1 = acc[ai][0][m][1][j];
                    v0[j] = a0 * fast_sigmoid(a0) * acc[ai][1][m][0][j]; v1[j] = a1 * fast_sigmoid(a1) * acc[ai][1][m][1][j]; }
                u32x4 w; w.x = cvt_pk_bf16(v0[0], v0[1]); w.y = cvt_pk_bf16(v0[2], v0[3]); w.z = cvt_pk_bf16(v1[0], v1[1]); w.w = cvt_pk_bf16(v1[2], v1[3]);
                *(u32x4*)rowp = w; }
    }
};
struct EpiResid {
    static constexpr bool PERM = false, AFTER_DRAIN = false;
    float* X; const float* gate; float coef;
    __device__ __forceinline__ void operator()(const f32x4 (&acc)[2][2][4][2], const Unit& u, int wr, int wc, int fr, int fq) const {
        const int row0 = u.pm * BM + wr * 64 + fr, col0 = u.pn * BM + wc * 32 + 4 * fq;
        const int mr = u.pm < 32 ? 0 : 1 + ((u.pm - 32) >> 2);
        const float* gp = gate + (size_t)mr * 9216 + col0;
        f32x4 gv[2][2];
#pragma unroll
        for (int bj = 0; bj < 2; ++bj)
#pragma unroll
            for (int n = 0; n < 2; ++n) gv[bj][n] = *(const f32x4*)(gp + bj * HALF + n * 16) * coef;
#pragma unroll
        for (int ai = 0; ai < 2; ++ai)
#pragma unroll
            for (int m = 0; m < 4; ++m) { float* rowp = X + (size_t)(row0 + ai * HALF + m * 16) * 1024 + col0;
#pragma unroll
                for (int bj = 0; bj < 2; ++bj)
#pragma unroll
                    for (int n = 0; n < 2; ++n) { f32x4* p = (f32x4*)(rowp + bj * HALF + n * 16); *p = *p + gv[bj][n] * acc[ai][bj][m][n]; } }
    }
};
template <int ACT> struct EpiStore {
    static constexpr bool PERM = true, AFTER_DRAIN = false;
    bf16_t* O; int ldo;
    __device__ __forceinline__ void operator()(const f32x4 (&acc)[2][2][4][2], const Unit& u, int wr, int wc, int fr, int fq) const {
        const int row0 = u.pm * BM + wr * 64 + fr, col0 = u.pn * BM + wc * 32 + 8 * fq;
#pragma unroll
        for (int ai = 0; ai < 2; ++ai)
#pragma unroll
            for (int m = 0; m < 4; ++m) { bf16_t* rowp = O + (size_t)(row0 + ai * HALF + m * 16) * ldo + col0;
#pragma unroll
                for (int bj = 0; bj < 2; ++bj) { f32x4 v0 = acc[ai][bj][m][0], v1 = acc[ai][bj][m][1];
                    if (ACT == 1) {
#pragma unroll
                        for (int j = 0; j < 4; ++j) { v0[j] = fast_sigmoid(v0[j]); v1[j] = fast_sigmoid(v1[j]); } }
                    u32x4 w; w.x = cvt_pk_bf16(v0[0], v0[1]); w.y = cvt_pk_bf16(v0[2], v0[3]); w.z = cvt_pk_bf16(v1[0], v1[1]); w.w = cvt_pk_bf16(v1[2], v1[3]);
                    *(u32x4*)(rowp + bj * HALF) = w; } }
    }
};
struct EpiMerge {
    static constexpr bool PERM = false, AFTER_DRAIN = false;
    float* P; const bf16_t* G; bf16_t* O; int goff; int mode;
    __device__ __forceinline__ void operator()(const f32x4 (&acc)[2][2][4][2], const Unit& u, int wr, int wc, int fr, int fq) const {
        const int row0 = u.pm * BM + wr * 64 + fr, col0 = u.pn * BM + wc * 32 + 4 * fq;
#pragma unroll
        for (int ai = 0; ai < 2; ++ai)
#pragma unroll
            for (int m = 0; m < 4; ++m) { const size_t r = (size_t)(row0 + ai * HALF + m * 16);
#pragma unroll
                for (int bj = 0; bj < 2; ++bj)
#pragma unroll
                    for (int n = 0; n < 2; ++n) { const int c = col0 + bj * HALF + n * 16;
                        const u32x2 gw = *(const u32x2*)(G + r * 4096 + goff + c);
                        f32x4 g; g[0] = bf_lo(gw.x); g[1] = bf_hi(gw.x); g[2] = bf_lo(gw.y); g[3] = bf_hi(gw.y);
                        f32x4 v = g * acc[ai][bj][m][n];
                        f32x4* pp = (f32x4*)(P + r * 1024 + c);
                        if (mode != 0) v = v + *pp;
                        if (mode != 2) *pp = v;
                        else { u32x2 w; w.x = cvt_pk_bf16(v[0], v[1]); w.y = cvt_pk_bf16(v[2], v[3]); *(u32x2*)(O + r * 1024 + c) = w; } } }
    }
};
template <class Epi, class Sched, bool STAMP = false>
__device__ __forceinline__ void gemm_phase(PG8_LAS unsigned char* lds, const Gemm g, const Sched& S, const Epi& E, unsigned long long* stamps, const int tid) {
    const int wid = __builtin_amdgcn_readfirstlane(tid >> 6), lane = tid & 63, wr = wid >> 2, wc = wid & 3, fr = lane & 15, fq = lane >> 4;
    const int K = g.K, nt = K / BK;
    int ts_lo = 0, ts_hi = 0, nts = 0; const unsigned long long rt_entry = STAMP ? (unsigned long long)wall_clock64() : 0ull;
#define PG8_STAMP() do { if (STAMP && wid == 0 && nts < 64) { const unsigned long long _c = (unsigned long long)clock64(); \
        ts_lo = (lane == nts) ? (int)(unsigned)_c : ts_lo; ts_hi = (lane == nts) ? (int)(unsigned)(_c >> 32) : ts_hi; ++nts; } } while (0)
    PG8_STAMP();
    unsigned voffA[2], voffB[2];
#pragma unroll
    for (int i = 0; i < 2; ++i) { int R, C; stage_rc(tid * 16 + i * 8192, R, C); const int Rb = Epi::PERM ? ((R & ~31) + perm32(R & 31)) : R;
        voffA[i] = (unsigned)(R * K + C) * 2u; voffB[i] = (unsigned)(Rb * K + C) * 2u; }
    const size_t kstep = (size_t)(BK * 2);
    const size_t hstep = (size_t)HALF * K * 2;
    const size_t tstep = 2 * hstep;
    const unsigned ldsw = (unsigned)wid * 1024u;
    const int aoff = lds_byte(wr * 64 + fr, fq * 8), boff = lds_byte(wc * 32 + fr, fq * 8);
#define PG8_SA(b, h) (((b) * 2 + (h)) * HTB)
#define PG8_SB(b, h) ((4 + (b) * 2 + (h)) * HTB)
#define PG8_STAGE(bufoff, gbase, voff) do { _Pragma("unroll") for (int _i = 0; _i < 2; ++_i) \
        __builtin_amdgcn_global_load_lds((const unsigned*)((const char*)(gbase) + (voff)[_i]), (PG8_LAS unsigned*)(lds + (bufoff) + ldsw + _i * 8192), 16, 0, 0); } while (0)
#define PG8_LDA(dst, b, h) do { _Pragma("unroll") for (int m = 0; m < 4; ++m) _Pragma("unroll") for (int k = 0; k < 2; ++k) dst[m][k] = *(const PG8_LAS bf16x8*)(lds + PG8_SA(b, h) + aoff + m * 2048 + k * 1024); } while (0)
#define PG8_LDB(dst, b, h) do { _Pragma("unroll") for (int n = 0; n < 2; ++n) _Pragma("unroll") for (int k = 0; k < 2; ++k) dst[n][k] = *(const PG8_LAS bf16x8*)(lds + PG8_SB(b, h) + boff + n * 2048 + k * 1024); } while (0)
#define PG8_MMA(ai, bj, At, Bt) do { __builtin_amdgcn_s_setprio(1); _Pragma("unroll") for (int m = 0; m < 4; ++m) _Pragma("unroll") for (int n = 0; n < 2; ++n) _Pragma("unroll") for (int k = 0; k < 2; ++k) \
        acc[ai][bj][m][n] = __builtin_amdgcn_mfma_f32_16x16x32_bf16(Bt[n][k], At[m][k], acc[ai][bj][m][n], 0, 0, 0); __builtin_amdgcn_s_setprio(0); } while (0)
#define PG8_WAIT_V(n) asm volatile("s_waitcnt vmcnt(" #n ")" ::: "memory")
#define PG8_WAIT_L(n) asm volatile("s_waitcnt lgkmcnt(" #n ")" ::: "memory")
#define PG8_BAR __builtin_amdgcn_s_barrier()
#define PG8_SCHED __builtin_amdgcn_sched_barrier(0)
    Unit cur, nxt; int ui = 0;
    if (!S.next(0, cur)) return;
    f32x4 acc[2][2][4][2];
#pragma unroll
    for (int a = 0; a < 2; ++a)
#pragma unroll
        for (int b = 0; b < 2; ++b)
#pragma unroll
            for (int m = 0; m < 4; ++m)
#pragma unroll
                for (int n = 0; n < 2; ++n) acc[a][b][m][n] = (f32x4){0.f, 0.f, 0.f, 0.f};
    bf16x8 At[4][2], B0[2][2], B1[2][2];
    const char* cA = (const char*)g.A + (size_t)cur.pm * tstep; const char* cB = (const char*)g.Bt + (size_t)cur.pn * tstep;
    S.a_ready(cur);
    PG8_STAGE(PG8_SB(0, 0), cB, voffB); PG8_STAGE(PG8_SA(0, 0), cA, voffA); PG8_STAGE(PG8_SB(0, 1), cB + hstep, voffB); PG8_STAGE(PG8_SA(0, 1), cA + hstep, voffA);
    if (wr == 1) PG8_BAR;
    PG8_WAIT_V(4); PG8_BAR;
    PG8_STAGE(PG8_SB(1, 0), cB + kstep, voffB); PG8_STAGE(PG8_SA(1, 0), cA + kstep, voffA); PG8_STAGE(PG8_SB(1, 1), cB + hstep + kstep, voffB);
    PG8_WAIT_V(6); PG8_BAR;
    PG8_STAMP();
    for (;;) {
        const bool has_next = S.next(ui + 1, nxt);
        const char* nA = has_next ? (const char*)g.A + (size_t)nxt.pm * tstep : cA; const char* nB = has_next ? (const char*)g.Bt + (size_t)nxt.pn * tstep : cB;
        for (int t = 0; t < nt; t += 2) {
            const bool last = (t == nt - 2);
            const char* a1 = cA + (size_t)(t + 1) * kstep;
            const char* a2 = last ? nA : cA + (size_t)(t + 2) * kstep; const char* b2 = last ? nB : cB + (size_t)(t + 2) * kstep;
            const char* a3 = a2 + kstep; const char* b3 = b2 + kstep;
            if (last && has_next) S.a_ready(nxt);
            PG8_LDB(B0, 0, 0); PG8_SCHED; PG8_LDA(At, 0, 0); PG8_STAGE(PG8_SA(1, 1), a1 + hstep, voffA);
            PG8_WAIT_L(8); PG8_BAR; PG8_WAIT_L(0); PG8_MMA(0, 0, At, B0); PG8_BAR; PG8_SCHED;
            PG8_LDB(B1, 0, 1); PG8_STAGE(PG8_SB(0, 0), b2, voffB);
            PG8_BAR; PG8_WAIT_L(0); PG8_MMA(0, 1, At, B1); PG8_BAR;
            PG8_LDA(At, 0, 1); PG8_STAGE(PG8_SA(0, 0), a2, voffA);
            PG8_BAR; PG8_WAIT_L(0); PG8_MMA(1, 0, At, B0); PG8_BAR; PG8_SCHED;
            PG8_STAGE(PG8_SB(0, 1), b2 + hstep, voffB);
            PG8_WAIT_V(6); PG8_BAR; PG8_MMA(1, 1, At, B1); PG8_BAR;
            PG8_LDB(B0, 1, 0); PG8_SCHED; PG8_LDA(At, 1, 0); PG8_STAGE(PG8_SA(0, 1), a2 + hstep, voffA);
            PG8_WAIT_L(8); PG8_BAR; PG8_WAIT_L(0); PG8_MMA(0, 0, At, B0); PG8_BAR; PG8_SCHED;
            PG8_LDB(B1, 1, 1); PG8_STAGE(PG8_SB(1, 0), b3, voffB);
            PG8_BAR; PG8_WAIT_L(0); PG8_MMA(0, 1, At, B1); PG8_BAR;
            PG8_LDA(At, 1, 1); PG8_STAGE(PG8_SA(1, 0), a3, voffA);
            PG8_BAR; PG8_WAIT_L(0); PG8_MMA(1, 0, At, B0); PG8_BAR; PG8_SCHED;
            PG8_STAGE(PG8_SB(1, 1), b3 + hstep, voffB);
            PG8_WAIT_V(6); PG8_BAR; PG8_MMA(1, 1, At, B1); PG8_BAR;
        }
        PG8_STAMP();
        if constexpr (!Epi::AFTER_DRAIN) { E(acc, cur, wr, wc, fr, fq); S.done(cur); }
        PG8_STAMP();
        if (!has_next) break;
#pragma unroll
        for (int a = 0; a < 2; ++a)
#pragma unroll
            for (int b = 0; b < 2; ++b)
#pragma unroll
                for (int m = 0; m < 4; ++m)
#pragma unroll
                    for (int n = 0; n < 2; ++n) acc[a][b][m][n] = (f32x4){0.f, 0.f, 0.f, 0.f};
        cur = nxt; cA = nA; cB = nB; ++ui;
    }
    PG8_WAIT_V(0);
    if (wr == 0) PG8_BAR;
    PG8_BAR;
    if constexpr (Epi::AFTER_DRAIN) { E.fused(acc, cur, wr, wc, fr, fq, lds, wid, lane); S.done(cur); }
    PG8_STAMP();
    if (STAMP && wid == 0) { stamps[lane] = lane < nts ? (((unsigned long long)(unsigned)ts_hi << 32) | (unsigned)ts_lo) : 0ull;
        if (lane == 62) stamps[62] = rt_entry; if (lane == 63) stamps[63] = (unsigned long long)wall_clock64(); }
#undef PG8_STAMP
#undef PG8_SA
#undef PG8_SB
#undef PG8_STAGE
#undef PG8_LDA
#undef PG8_LDB
#undef PG8_MMA
#undef PG8_WAIT_V
#undef PG8_WAIT_L
#undef PG8_BAR
#undef PG8_SCHED
}
}
#define LAS __attribute__((address_space(3)))
typedef pg8::bf16_t bf16_t;
typedef pg8::f32x4 f32x4;
typedef pg8::u32x4 u32x4;
typedef pg8::u32x2 u32x2;
using pg8::bf_lo; using pg8::bf_hi; using pg8::cvt_pk_bf16;
constexpr int D = 1024, M = 16384, DFF = 2816, NMIX = 5376, NGATE = 4096;
constexpr float EPS = 1e-6f;
constexpr int C_HY = 0, C_DQ = 1536, C_DK = 2048, C_DV = 2560, C_WQ = 3072, C_WK = 3584, C_WV = 3712, C_RQ = 3840, C_RK = 4096, C_RV = 4352, C_RG = 4864;
constexpr size_t O_DK = 16777216, O_DV = 25165824, O_WK = 33554432, O_WV = 35651584, O_RF = 37748736, O_RB = 39845888, O_END = 41943040;
constexpr size_t MiB = 1u << 20;
constexpr size_t WS_CTL = 0, CTL_ZERO_BYTES = 1 * MiB;
constexpr size_t WS_MODP = 1 * MiB, WS_MOD = 7 * MiB, WS_Z2 = 8 * MiB, WS_FILT = 9 * MiB, WS_W = 20 * MiB, WS_H = 78 * MiB, WS_BIG = 110 * MiB, WS_YBR = 302 * MiB, WS_ZB = 366 * MiB, WS_END = 398 * MiB;
constexpr size_t WS_KDC = 1 * MiB, WS_KWC = 5 * MiB, WS_ST = 6 * MiB;
constexpr size_t WS_KTR = 9 * MiB;
constexpr size_t WS_GRT = 403 * MiB;
constexpr size_t WS_VTWL = 398 * MiB, WS_VTWC = 401 * MiB;
constexpr size_t WS_VTRL = 382 * MiB, WS_VTRC = 390 * MiB;
constexpr size_t WS_VTDL = WS_BIG + 168 * MiB, WS_VTDC = WS_VTDL + 12 * MiB;
constexpr size_t W_FA_IN = 0, W_FA_OUT = 11534336, W_FB_IN = 17301504, W_FB_OUT = 28835840, W_IN = 34603008, W_BR = 54001664, W_OUT = 58195968, W_END = 60293120;
static_assert(WS_W + W_END <= WS_H, "weights fit");
constexpr int NPHASE = 28;
enum InIdx { I_XP = 0, I_XS, I_C, I_CDK, I_CDV, I_CWK, I_CWV, I_SRF, I_SRB, I_CCTX, I_NFA, I_NMIX, I_NFB, I_WADA, I_BADA, I_WFAI, I_WFAO, I_WFBI, I_WFBO, I_WIN, I_HCW, I_HCB,
             I_HW1, I_HB1, I_HW2, I_HB2, I_HW3, I_HSKIP, I_DQN, I_DKN, I_DLAM, I_DSUB, I_WQN, I_WKN, I_WSINK, I_RDF, I_RDB, I_WBR, I_WOUT, N_IN };
struct Args { const float* in[N_IN]; float* out; unsigned char* ws; int ph_lo, ph_hi; };
struct Ctx { const LAS unsigned long long* tab; float* out; unsigned char* ws; };
constexpr int LDS_BYTES = 147456;
constexpr int LDS_TAB_OFF = LDS_BYTES - 1024, LDS_ST_OFF = LDS_BYTES - 64;
__device__ __forceinline__ const float* inp(const Ctx& c, int i) { const unsigned long long v = c.tab[i];
    const unsigned lo = __builtin_amdgcn_readfirstlane((unsigned)v), hi = __builtin_amdgcn_readfirstlane((unsigned)(v >> 32)); return (const float*)(((unsigned long long)hi << 32) | lo); }
__device__ __forceinline__ Ctx make_ctx(const Args& a, LAS unsigned char* lds, int tid) {
    LAS unsigned long long* tab = (LAS unsigned long long*)(lds + LDS_TAB_OFF);
    if (tid < N_IN) tab[tid] = (unsigned long long)a.in[tid];
    if (tid >= 64 && tid < 80) ((LAS unsigned*)(lds + LDS_ST_OFF))[tid - 64] = 0u;
    __syncthreads();
    Ctx c; c.tab = tab; c.out = a.out; c.ws = a.ws; return c; }


#define LDS_WAIT() asm volatile("s_waitcnt lgkmcnt(0)" ::: "memory")
__device__ __forceinline__ float wave_sum(float v) {
#pragma unroll
    for (int o = 1; o < 64; o <<= 1) v += __shfl_xor(v, o);
    return v;
}
__device__ __forceinline__ unsigned f2bf(float f) { unsigned u = __float_as_uint(f); return (u + 0x7fffu + ((u >> 16) & 1u)) >> 16; }
__device__ __forceinline__ unsigned pk2(float lo, float hi) { return cvt_pk_bf16(lo, hi); }
__device__ __forceinline__ float bf2f(bf16_t b) { return __uint_as_float(((unsigned)b) << 16); }

__device__ __forceinline__ void ld64bf(const bf16_t* p, float (&x)[64]) {
    const uint4* q = (const uint4*)p;
#pragma unroll
    for (int i = 0; i < 8; ++i) { const uint4 u = q[i]; x[8 * i + 0] = bf_lo(u.x); x[8 * i + 1] = bf_hi(u.x); x[8 * i + 2] = bf_lo(u.y); x[8 * i + 3] = bf_hi(u.y);
        x[8 * i + 4] = bf_lo(u.z); x[8 * i + 5] = bf_hi(u.z); x[8 * i + 6] = bf_lo(u.w); x[8 * i + 7] = bf_hi(u.w); }
}
__device__ __forceinline__ void st64bf(bf16_t* p, const float (&x)[64]) {
    uint4* q = (uint4*)p;
#pragma unroll
    for (int i = 0; i < 8; ++i) { uint4 u; u.x = pk2(x[8 * i + 0], x[8 * i + 1]); u.y = pk2(x[8 * i + 2], x[8 * i + 3]); u.z = pk2(x[8 * i + 4], x[8 * i + 5]); u.w = pk2(x[8 * i + 6], x[8 * i + 7]); q[i] = u; }
}
__device__ __forceinline__ float dot64bf(const bf16_t* p, const float (&q)[64]) {
    const uint4* r = (const uint4*)p; float s0 = 0.f, s1 = 0.f, s2 = 0.f, s3 = 0.f;
#pragma unroll
    for (int i = 0; i < 8; ++i) { const uint4 u = r[i];
        s0 += bf_lo(u.x) * q[8 * i + 0]; s1 += bf_hi(u.x) * q[8 * i + 1]; s2 += bf_lo(u.y) * q[8 * i + 2]; s3 += bf_hi(u.y) * q[8 * i + 3];
        s0 += bf_lo(u.z) * q[8 * i + 4]; s1 += bf_hi(u.z) * q[8 * i + 5]; s2 += bf_lo(u.w) * q[8 * i + 6]; s3 += bf_hi(u.w) * q[8 * i + 7]; }
    return (s0 + s1) + (s2 + s3);
}
__device__ __forceinline__ float dot64f(const float* p, const float (&q)[64]) {
    const float4* r = (const float4*)p; float s0 = 0.f, s1 = 0.f, s2 = 0.f, s3 = 0.f;
#pragma unroll
    for (int i = 0; i < 16; ++i) { const float4 u = r[i]; s0 += u.x * q[4 * i + 0]; s1 += u.y * q[4 * i + 1]; s2 += u.z * q[4 * i + 2]; s3 += u.w * q[4 * i + 3]; }
    return (s0 + s1) + (s2 + s3);
}
__device__ __forceinline__ void axpy64bf(float a, const bf16_t* p, float (&acc)[64]) {
    const uint4* r = (const uint4*)p;
#pragma unroll
    for (int i = 0; i < 8; ++i) { const uint4 u = r[i];
        acc[8 * i + 0] += a * bf_lo(u.x); acc[8 * i + 1] += a * bf_hi(u.x); acc[8 * i + 2] += a * bf_lo(u.y); acc[8 * i + 3] += a * bf_hi(u.y);
        acc[8 * i + 4] += a * bf_lo(u.z); acc[8 * i + 5] += a * bf_hi(u.z); acc[8 * i + 6] += a * bf_lo(u.w); acc[8 * i + 7] += a * bf_hi(u.w); }
}
__device__ __forceinline__ void axpy64f(float a, const float* p, float (&acc)[64]) {
    const float4* r = (const float4*)p;
#pragma unroll
    for (int i = 0; i < 16; ++i) { const float4 u = r[i]; acc[4 * i + 0] += a * u.x; acc[4 * i + 1] += a * u.y; acc[4 * i + 2] += a * u.z; acc[4 * i + 3] += a * u.w; }
}
#define ONLINE_UPDATE(s, AXPY) do { if ((s) > m) { const float f_ = __expf(m - (s)); lsum *= f_; _Pragma("unroll") for (int i_ = 0; i_ < 64; ++i_) acc[i_] *= f_; m = (s); } \
    const float p_ = __expf((s) - m); lsum += p_; AXPY; } while (0)

__device__ __forceinline__ void transpose_item(const float* W, int K, int N, bf16_t* WT, bool swi, LAS float* scr, int item, int lane) {
    const int nblk = N / 32, kb = item / nblk, nb = item % nblk, k0 = 64 * kb, d0 = 32 * nb;
    int n0 = d0;
    if (swi) { const int tile = d0 >> 8, w = d0 & 255; n0 = (w < 128) ? (tile * 128 + w) : (DFF + tile * 128 + (w - 128)); }
#pragma unroll 8
    for (int i = 0; i < 32; ++i) { const int kk = 2 * i + (lane >> 5); scr[kk * 33 + (lane & 31)] = W[(size_t)(k0 + kk) * N + n0 + (lane & 31)]; }
    LDS_WAIT(); asm volatile("" ::: "memory");
    const int c = lane & 7;
#pragma unroll
    for (int j = 0; j < 4; ++j) { const int n = (lane >> 3) + 8 * j; const LAS float* s = scr + (8 * c) * 33 + n;
        uint4 o; o.x = pk2(s[0 * 33], s[1 * 33]); o.y = pk2(s[2 * 33], s[3 * 33]); o.z = pk2(s[4 * 33], s[5 * 33]); o.w = pk2(s[6 * 33], s[7 * 33]);
        *(uint4*)(WT + (size_t)(d0 + n) * K + k0 + 8 * c) = o; }
    LDS_WAIT(); asm volatile("" ::: "memory");
}
__device__ __forceinline__ void convert_weights(const Ctx& a, int l, LAS unsigned char* lds, int gw, int NGW, int wave, int lane) {
    LAS float* scr = (LAS float*)(lds + wave * 16384);
    bf16_t* wb = (bf16_t*)(a.ws + WS_W);
    constexpr int I0 = 16 * 176, I1 = 44 * 32, I4 = 16 * 296, I5 = 8 * 32, I9 = 16 * 32;
    constexpr int NITEMS = 2 * I0 + 2 * I1 + I4 + 4 * I5 + I9;
    for (int it = gw; it < NITEMS; it += NGW) {
        int r = it;
        if (r < I0) { transpose_item(inp(a, I_WFAI) + (size_t)l * D * 2 * DFF, D, 2 * DFF, (bf16_t*)((unsigned char*)wb + W_FA_IN), true, scr, r, lane); continue; } r -= I0;
        if (r < I1) { transpose_item(inp(a, I_WFAO) + (size_t)l * DFF * D, DFF, D, (bf16_t*)((unsigned char*)wb + W_FA_OUT), false, scr, r, lane); continue; } r -= I1;
        if (r < I0) { transpose_item(inp(a, I_WFBI) + (size_t)l * D * 2 * DFF, D, 2 * DFF, (bf16_t*)((unsigned char*)wb + W_FB_IN), true, scr, r, lane); continue; } r -= I0;
        if (r < I1) { transpose_item(inp(a, I_WFBO) + (size_t)l * DFF * D, DFF, D, (bf16_t*)((unsigned char*)wb + W_FB_OUT), false, scr, r, lane); continue; } r -= I1;
        if (r < I4) { transpose_item(inp(a, I_WIN) + (size_t)l * D * 9472, D, 9472, (bf16_t*)((unsigned char*)wb + W_IN), false, scr, r, lane); continue; } r -= I4;
        if (r < 4 * I5) { const int b = r / I5; transpose_item(inp(a, I_WBR) + ((size_t)l * 4 + b) * 512 * D, 512, D, (bf16_t*)((unsigned char*)wb + W_BR) + (size_t)b * D * 512, false, scr, r % I5, lane); continue; } r -= 4 * I5;
        transpose_item(inp(a, I_WOUT) + (size_t)l * D * D, D, D, (bf16_t*)((unsigned char*)wb + W_OUT), false, scr, r, lane);
    }
}
__device__ __forceinline__ void phase_p0a(const Ctx& a, LAS unsigned char* lds, int bid, int nblk, int tid) {
    const int lane = tid & 63, wave = tid >> 6, gtid = bid * 512 + tid, NT = nblk * 512;
    { const float4* s0 = (const float4*)inp(a, I_XP); const float4* s1 = (const float4*)inp(a, I_XS); float4* o = (float4*)a.out;
      for (int i = gtid; i < 4194304; i += NT) o[i] = i < 2097152 ? s0[i] : s1[i - 2097152]; }
    { LAS float* sc = (LAS float*)lds;
      for (int i = tid; i < 9216; i += 512) { const int r = i >> 10, k = i & 1023; const float v = r == 0 ? inp(a, I_CCTX)[k] : inp(a, I_C)[(r - 1) * 1024 + k]; sc[i] = v / (1.0f + expf(-v)); }
      __syncthreads();
      float* modp = (float*)(a.ws + WS_MODP);
      for (int idx = gtid; idx < 2 * 8 * 9216; idx += NT) { const int n = idx % 9216, kc = (idx / 9216) % 8, l = idx / (9216 * 8);
          const float* w = inp(a, I_WADA) + ((size_t)l * 1024 + kc * 128) * 9216 + n; float acc[9];
#pragma unroll
          for (int r = 0; r < 9; ++r) acc[r] = 0.f;
          for (int k = 0; k < 128; ++k) { const float wv = w[(size_t)k * 9216];
#pragma unroll
              for (int r = 0; r < 9; ++r) acc[r] += sc[r * 1024 + kc * 128 + k] * wv; }
#pragma unroll
          for (int r = 0; r < 9; ++r) modp[((size_t)(l * 8 + kc) * 9 + r) * 9216 + n] = acc[r]; }
      __syncthreads(); }
    { LAS float* fe = (LAS float*)lds; LAS float* z1 = fe + 8 * 33; float* z2g = (float*)(a.ws + WS_Z2);
      for (int it = bid; it < 320; it += nblk) { const int l = it / 160, tg = it % 160, tt = tid >> 6, j = tid & 63, tglob = tg * 8 + tt;
          const int L = tglob < 256 ? 256 : 1024, tpos = tglob < 256 ? tglob : tglob - 256; const float tf = (float)tpos / (float)L;
          if (j < 33) { float v; if (j == 0) v = tf; else if (j <= 16) v = sinf((6.2831853071795864769f * tf) * (float)j); else v = cosf((6.2831853071795864769f * tf) * (float)(j - 16)); fe[tt * 33 + j] = v; }
          __syncthreads();
          float s = inp(a, I_HB1)[l * 64 + j];
          for (int i = 0; i < 33; ++i) s += fe[tt * 33 + i] * inp(a, I_HW1)[(l * 33 + i) * 64 + j];
          z1[tt * 64 + j] = sinf(s);
          __syncthreads();
          float s2 = inp(a, I_HB2)[l * 64 + j];
          for (int i = 0; i < 64; ++i) s2 += z1[tt * 64 + i] * inp(a, I_HW2)[(l * 64 + i) * 64 + j];
          z2g[((size_t)l * 1280 + tglob) * 64 + j] = sinf(s2);
          __syncthreads(); } }
    convert_weights(a, 0, lds, bid * 8 + wave, nblk * 8, wave, lane);
}
__device__ __forceinline__ void phase_p0b(const Ctx& a, LAS unsigned char* lds, int bid, int nblk, int tid) {
    const int gtid = bid * 512 + tid, NT = nblk * 512;
    { const float* modp = (const float*)(a.ws + WS_MODP); float* mod = (float*)(a.ws + WS_MOD);
      for (int idx = gtid; idx < 2 * 9 * 9216; idx += NT) { const int n = idx % 9216, r = (idx / 9216) % 9, l = idx / (9216 * 9); float s = inp(a, I_BADA)[l * 9216 + n];
#pragma unroll
          for (int kc = 0; kc < 8; ++kc) s += modp[((size_t)(l * 8 + kc) * 9 + r) * 9216 + n];
          mod[idx] = s; } }
    { LAS float* red = (LAS float*)lds; const float* z2g = (const float*)(a.ws + WS_Z2); float* filt = (float*)(a.ws + WS_FILT);
      const float dmin = logf(0.01f) / 1.5f, dmax = logf(0.01f) / 0.3f;
      for (int it = bid; it < 128; it += nblk) { const int l = it >> 6, ls = (it >> 5) & 1, cg = it & 31, ci = tid & 15, tl = tid >> 4, c = cg * 16 + ci;
          const int L = ls ? 1024 : 256, toff = ls ? 256 : 0; float* G = filt + (size_t)l * (2560 * 512) + (ls ? 512 * 512 : 0);
          const float ad = fabsf(dmin + (dmax - dmin) * ((float)c / 511.0f)); const float* w3 = inp(a, I_HW3) + (size_t)l * 64 * 1024;
          float asum = 0.f;
          for (int t = tl; t < L; t += 32) { const float* zp = z2g + ((size_t)l * 1280 + toff + t) * 64; float zf = 0.f, zb = 0.f;
              for (int j = 0; j < 64; ++j) { const float z = zp[j]; zf += z * w3[j * 1024 + c]; zb += z * w3[j * 1024 + 512 + c]; }
              const float win = expf(-((float)t / (float)L) * ad); const float hf = zf * win, hb = zb * win; asum += fabsf(hf) + fabsf(hb);
              G[(size_t)(L - 1 + t) * 512 + c] = hf; if (t >= 1) G[(size_t)(L - 1 - t) * 512 + c] = hb; }
          red[tl * 16 + ci] = asum; __syncthreads();
          float tot = 0.f;
          for (int i = 0; i < 32; ++i) tot += red[i * 16 + ci];
          const float inv = 1.0f / tot;
          bf16_t* GT = (bf16_t*)(a.ws + WS_GRT) + (size_t)l * (512 * 2560) + (ls ? 512 * 512 : 0) + (size_t)c * (2 * L);
          for (int t = tl; t < L; t += 32) { const float hf = G[(size_t)(L - 1 + t) * 512 + c] * inv; G[(size_t)(L - 1 + t) * 512 + c] = hf; GT[L - 1 - t] = (bf16_t)f2bf(hf);
              if (t >= 1) { const float hb = G[(size_t)(L - 1 - t) * 512 + c] * inv; G[(size_t)(L - 1 - t) * 512 + c] = hb; GT[L - 1 + t] = (bf16_t)f2bf(hb); } }
          if (tl == 0) GT[2 * L - 1] = 0;
          __syncthreads(); } }
}
__device__ __forceinline__ void phase_norm(const Ctx& a, int l, int gidx  , int sidx  , int bid, int nblk, int tid) {
    const int lane = tid & 63, gw = bid * 8 + (tid >> 6), NGW = nblk * 8;
    const float* gain = inp(a, gidx) + l * 1024; const float* modl = (const float*)(a.ws + WS_MOD) + (size_t)l * 9 * 9216; bf16_t* H = (bf16_t*)(a.ws + WS_H);
    for (int row = gw; row < M; row += NGW) { const int r = row < 8192 ? 0 : 1 + ((row - 8192) >> 10);
        const f32x4* xr = (const f32x4*)(a.out + (size_t)row * 1024) + lane; f32x4 v[4]; float ss = 0.f;
#pragma unroll
        for (int j = 0; j < 4; ++j) { v[j] = xr[64 * j]; ss += (v[j].x * v[j].x + v[j].y * v[j].y) + (v[j].z * v[j].z + v[j].w * v[j].w); }
        const float rstd = 1.0f / sqrtf(wave_sum(ss) * (1.0f / 1024.0f) + EPS);
#pragma unroll
        for (int j = 0; j < 4; ++j) { const int col = 4 * lane + 256 * j; const f32x4 g = *(const f32x4*)(gain + col), sh = *(const f32x4*)(modl + (size_t)r * 9216 + sidx * 1024 + col), sc = *(const f32x4*)(modl + (size_t)r * 9216 + (sidx + 1) * 1024 + col);
            const f32x4 y = (v[j] * rstd) * g; const f32x4 h = y * (sc + 1.0f) + sh;
            u32x2 w; w.x = pk2(h.x, h.y); w.y = pk2(h.z, h.w); *(u32x2*)(H + (size_t)row * 1024 + col) = w; } }
}
__device__ __forceinline__ void phase_prep(const Ctx& a, int l, int bid, int nblk, int tid) {
    const int gtid = bid * 512 + tid, NT = nblk * 512; bf16_t* cols = (bf16_t*)(a.ws + WS_BIG);
    { const int sub = gtid & 7;
#pragma unroll 1
      for (int T = gtid >> 3; T < M * 36; T += NT >> 3) { const int row = T / 36, vt = T % 36; const bool lat = row >= 8192; bf16_t* cr = cols + (size_t)row * NMIX;
        const int bc = row >> 8, tc = row & 255;
        if (vt < 26) { int col; const float* gn; float* so = nullptr;
            if (vt < 8) { col = C_DQ + 64 * vt; gn = inp(a, I_DQN) + l * 64; }
            else if (vt < 16) { col = C_DK + 64 * (vt - 8); gn = inp(a, I_DKN) + l * 64; if (!lat) so = a.out + O_DK + ((((size_t)bc * 2 + l) * 256 + tc) * 8 + (vt - 8)) * 64; }
            else if (vt < 24) { col = C_WQ + 64 * (vt - 16); gn = inp(a, I_WQN) + l * 64; }
            else { col = C_WK + 64 * (vt - 24); gn = inp(a, I_WKN) + l * 64; if (!lat) so = a.out + O_WK + ((((size_t)bc * 2 + l) * 256 + tc) * 2 + (vt - 24)) * 64; }
            const uint4 u = *(const uint4*)(cr + col + 8 * sub);
            float x[8] = {bf_lo(u.x), bf_hi(u.x), bf_lo(u.y), bf_hi(u.y), bf_lo(u.z), bf_hi(u.z), bf_lo(u.w), bf_hi(u.w)};
            float ss = 0.f;
#pragma unroll
            for (int i = 0; i < 8; ++i) ss += x[i] * x[i];
            ss += __shfl_xor(ss, 1); ss += __shfl_xor(ss, 2); ss += __shfl_xor(ss, 4);
            const float rs = 1.0f / sqrtf(ss * (1.0f / 64.0f) + EPS);
            const float4 g0 = *(const float4*)(gn + 8 * sub), g1 = *(const float4*)(gn + 8 * sub + 4);
            x[0] *= rs * g0.x; x[1] *= rs * g0.y; x[2] *= rs * g0.z; x[3] *= rs * g0.w; x[4] *= rs * g1.x; x[5] *= rs * g1.y; x[6] *= rs * g1.z; x[7] *= rs * g1.w;
            if (so) { ((float4*)(so + 8 * sub))[0] = make_float4(x[0], x[1], x[2], x[3]); ((float4*)(so + 8 * sub))[1] = make_float4(x[4], x[5], x[6], x[7]); }
            if (lat) { const int t = (row - 8192) & 1023; const float pos = (sub & 4) ? (float)(t & 63) : (float)(t >> 6); const bool second = (sub & 2) != 0;
#pragma unroll
                for (int i = 0; i < 8; ++i) { const float y = __shfl_xor(x[i], 2); const float invf = exp2f(-(float)((sub & 1) * 8 + i) * (13.287712379549449f / 16.0f));
                    const float ang = pos * invf, sn = __sinf(ang), cs = __cosf(ang);
                    x[i] = second ? (y * sn + x[i] * cs) : (x[i] * cs - y * sn); } }
            uint4 o; o.x = pk2(x[0], x[1]); o.y = pk2(x[2], x[3]); o.z = pk2(x[4], x[5]); o.w = pk2(x[6], x[7]);
            *(uint4*)(cr + col + 8 * sub) = o;
        } else if (!lat) { const int v = vt < 34 ? vt - 26 : vt - 34; const bf16_t* src = cr + (vt < 34 ? C_DV : C_WV) + 64 * v + 8 * sub;
            float* dst = (vt < 34 ? a.out + O_DV + (((size_t)bc * 2 + l) * 256 + tc) * 512 + 64 * v : a.out + O_WV + (((size_t)bc * 2 + l) * 256 + tc) * 128 + 64 * v) + 8 * sub;
            const uint4 u = *(const uint4*)src;
            ((float4*)dst)[0] = make_float4(bf_lo(u.x), bf_hi(u.x), bf_lo(u.y), bf_hi(u.y)); ((float4*)dst)[1] = make_float4(bf_lo(u.z), bf_hi(u.z), bf_lo(u.w), bf_hi(u.w)); }
      } }
}
__device__ __forceinline__ void prep_hy(const Ctx& a, int l, LAS unsigned char* lds, int bid, int nblk, int tid) {
    const int lane = tid & 63, wave = __builtin_amdgcn_readfirstlane(tid >> 6), gw = bid * 8 + wave, NGW = nblk * 8;
    LAS float* scr = (LAS float*)(lds + wave * 16640);
    const bf16_t* cols = (const bf16_t*)(a.ws + WS_BIG); bf16_t* ztl = (bf16_t*)(a.ws + WS_ZB); bf16_t* ztc = ztl + (size_t)512 * 8 * 1024;
    const float* cw = inp(a, I_HCW) + l * 3 * 1536; const float* cb = inp(a, I_HCB) + l * 1536;
#pragma unroll 1
    for (int it = gw; it < 2048; it += NGW) { const int rblk = it >> 3, c = (it & 7) * 64 + lane, row0 = rblk * 64; const bool lat = row0 >= 8192;
        const int L = lat ? 1024 : 256, t0 = lat ? ((row0 - 8192) & 1023) : (row0 & 255), b = lat ? ((row0 - 8192) >> 10) : (row0 >> 8);
        const float wv0 = cw[c], wv1 = cw[1536 + c], wv2 = cw[3072 + c], bv = cb[c], wx0 = cw[1024 + c], wx1 = cw[1536 + 1024 + c], wx2 = cw[3072 + 1024 + c], bx = cb[1024 + c];
        const bf16_t* p = cols + (size_t)row0 * NMIX + c;
        float vm = t0 > 0 ? bf2f(p[-NMIX]) : 0.f, xm = t0 > 0 ? bf2f(p[1024 - NMIX]) : 0.f, v0 = bf2f(p[0]), x0 = bf2f(p[1024]);
#pragma unroll 4
        for (int i = 0; i < 64; ++i) { const bool hp = t0 + i < L - 1; const float vp = hp ? bf2f(p[(size_t)(i + 1) * NMIX]) : 0.f, xp = hp ? bf2f(p[(size_t)(i + 1) * NMIX + 1024]) : 0.f;
            const float v = vm * wv0 + v0 * wv1 + vp * wv2 + bv, x1 = xm * wx0 + x0 * wx1 + xp * wx2 + bx;
            scr[i * 65 + lane] = v * x1; vm = v0; v0 = vp; xm = x0; x0 = xp; }
        LDS_WAIT(); asm volatile("" ::: "memory");
        bf16_t* dst = (lat ? ztl + ((size_t)c * 8 + b) * 1024 : ztc + ((size_t)c * 32 + b) * 256) + t0; uint4* o = (uint4*)dst;
#pragma unroll
        for (int i = 0; i < 8; ++i) { const LAS float* q = scr + (8 * i) * 65 + lane; uint4 w;
            w.x = pk2(q[0], q[65]); w.y = pk2(q[2 * 65], q[3 * 65]); w.z = pk2(q[4 * 65], q[5 * 65]); w.w = pk2(q[6 * 65], q[7 * 65]); o[i] = w; }
        LDS_WAIT(); asm volatile("" ::: "memory"); }
}
__device__ __forceinline__ void diff_item(const Ctx& a, int l, int grp, int h, int qb, int lane) {
    const bf16_t* cols = (const bf16_t*)(a.ws + WS_BIG); bf16_t* yo = (bf16_t*)(a.ws + WS_YBR) + (size_t)1 * M * 512;
    const bool lat = grp >= 32; const int b = lat ? grp - 32 : grp, L = lat ? 1024 : 256, rb = lat ? 8192 + b * 1024 : b * 256;
    const int qi = lane >> 2, eq = lane & 3, t = qb * 16 + qi, row = rb + t;
    const float* dl = inp(a, I_DLAM) + l * 256; float s01 = 0.f, s23 = 0.f;
    for (int i = 0; i < 64; ++i) { s01 += dl[i] * dl[64 + i]; s23 += dl[128 + i] * dl[192 + i]; }
    const float lam_init = 0.8f - 0.6f * expf(-0.3f * (float)l), lam = expf(s01) - expf(s23) + lam_init;
    float out[32];
#pragma unroll 1
    for (int c = 0; c < 2; ++c) {
        float q[64]; ld64bf(cols + (size_t)row * NMIX + C_DQ + (h * 2 + c) * 64, q);
        float acc[32];
#pragma unroll
        for (int i = 0; i < 32; ++i) acc[i] = 0.f;
        float m = -1e30f, lsum = 0.f;
#pragma unroll 1
        for (int j = 0; j < L; ++j) { const bf16_t* kr = cols + (size_t)(rb + j) * NMIX; const float s = dot64bf(kr + C_DK + (h * 2 + c) * 64, q) * 0.125f;
            if (s > m) { const float f_ = __expf(m - s); lsum *= f_;
#pragma unroll
                for (int i = 0; i < 32; ++i) acc[i] *= f_;
                m = s; }
            const float p_ = __expf(s - m); lsum += p_;
            const uint4* r = (const uint4*)(kr + C_DV + h * 128 + eq * 32);
#pragma unroll
            for (int i = 0; i < 4; ++i) { const uint4 u = r[i];
                acc[8 * i + 0] += p_ * bf_lo(u.x); acc[8 * i + 1] += p_ * bf_hi(u.x); acc[8 * i + 2] += p_ * bf_lo(u.y); acc[8 * i + 3] += p_ * bf_hi(u.y);
                acc[8 * i + 4] += p_ * bf_lo(u.z); acc[8 * i + 5] += p_ * bf_hi(u.z); acc[8 * i + 6] += p_ * bf_lo(u.w); acc[8 * i + 7] += p_ * bf_hi(u.w); } }
        if (lat) {
#pragma unroll 1
            for (int j = 0; j < 512; ++j) { const float* kp = inp(a, I_CDK) + (((((size_t)b * 2 + l) * 512 + j) * 4 + h) * 2 + c) * 64; const float4* vp = (const float4*)(inp(a, I_CDV) + ((((size_t)b * 2 + l) * 512 + j) * 4 + h) * 128 + eq * 32);
                const float s = dot64f(kp, q) * 0.125f;
                if (s > m) { const float f_ = __expf(m - s); lsum *= f_;
#pragma unroll
                    for (int i = 0; i < 32; ++i) acc[i] *= f_;
                    m = s; }
                const float p_ = __expf(s - m); lsum += p_;
#pragma unroll
                for (int i = 0; i < 8; ++i) { const float4 u = vp[i]; acc[4 * i + 0] += p_ * u.x; acc[4 * i + 1] += p_ * u.y; acc[4 * i + 2] += p_ * u.z; acc[4 * i + 3] += p_ * u.w; } } }
        const float inv = 1.0f / lsum;
        if (c == 0) {
#pragma unroll
            for (int i = 0; i < 32; ++i) out[i] = acc[i] * inv; }
        else {
#pragma unroll
            for (int i = 0; i < 32; ++i) out[i] -= lam * (acc[i] * inv); }
    }
    float ss = 0.f;
#pragma unroll
    for (int i = 0; i < 32; ++i) ss += out[i] * out[i];
    ss += __shfl_xor(ss, 1); ss += __shfl_xor(ss, 2);
    const float rs = (1.0f / sqrtf(ss * (1.0f / 128.0f) + EPS)) * (1.0f - lam_init); const float* sg = inp(a, I_DSUB) + l * 128 + eq * 32;
    uint4* dst = (uint4*)(yo + (size_t)row * 512 + h * 128 + eq * 32);
#pragma unroll
    for (int i = 0; i < 4; ++i) { uint4 u; u.x = pk2(out[8 * i + 0] * rs * sg[8 * i + 0], out[8 * i + 1] * rs * sg[8 * i + 1]); u.y = pk2(out[8 * i + 2] * rs * sg[8 * i + 2], out[8 * i + 3] * rs * sg[8 * i + 3]);
        u.z = pk2(out[8 * i + 4] * rs * sg[8 * i + 4], out[8 * i + 5] * rs * sg[8 * i + 5]); u.w = pk2(out[8 * i + 6] * rs * sg[8 * i + 6], out[8 * i + 7] * rs * sg[8 * i + 7]); dst[i] = u; }
}
__device__ __forceinline__ void win_item(const Ctx& a, int l, int grp, int hq, int qb, int lane) {
    const bf16_t* cols = (const bf16_t*)(a.ws + WS_BIG); bf16_t* yo = (bf16_t*)(a.ws + WS_YBR) + (size_t)2 * M * 512;
    const bool lat = grp >= 32; const int b = lat ? grp - 32 : grp, L = lat ? 1024 : 256, rb = lat ? 8192 + b * 1024 : b * 256;
    const int t = qb * 64 + lane, row = rb + t, hkv = hq >> 2;
    float q[64]; ld64bf(cols + (size_t)row * NMIX + C_WQ + hq * 64, q);
    float acc[64];
#pragma unroll
    for (int i = 0; i < 64; ++i) acc[i] = 0.f;
    float m = inp(a, I_WSINK)[l * 8 + hq], lsum = 1.0f;
    const int jlo = lat ? max(0, qb * 64 - 128) : 0, jhi = lat ? min(L - 1, qb * 64 + 63 + 128) : L - 1;
    for (int j = jlo; j <= jhi; ++j) { const bf16_t* kr = cols + (size_t)(rb + j) * NMIX; const float s = dot64bf(kr + C_WK + hkv * 64, q) * 0.125f;
        const int dd = t - j; const bool ok = !lat || (dd <= 128 && dd >= -128);
        if (ok) { ONLINE_UPDATE(s, axpy64bf(p_, kr + C_WV + hkv * 64, acc)); } }
    if (lat) for (int j = 0; j < 512; ++j) { const size_t o = ((((size_t)b * 2 + l) * 512 + j) * 2 + hkv) * 64; const float s = dot64f(inp(a, I_CWK) + o, q) * 0.125f; ONLINE_UPDATE(s, axpy64f(p_, inp(a, I_CWV) + o, acc)); }
    const float inv = 1.0f / lsum;
#pragma unroll
    for (int i = 0; i < 64; ++i) acc[i] *= inv;
    st64bf(yo + (size_t)row * 512 + hq * 64, acc);
}
__device__ __forceinline__ void ret_item(const Ctx& a, int l, int grp, int h, int qb, int lane, LAS float* qs  ) {
    const bf16_t* cols = (const bf16_t*)(a.ws + WS_BIG); bf16_t* yo = (bf16_t*)(a.ws + WS_YBR) + (size_t)3 * M * 512;
    const bool lat = grp >= 32; const int b = lat ? grp - 32 : grp, L = lat ? 1024 : 256, rb = lat ? 8192 + b * 1024 : b * 256;
    const int qi = lane >> 1, eh = lane & 1, t = qb * 32 + qi, row = rb + t;
    const float lgf = -log1pf(expf(-inp(a, I_RDF)[l * 4 + h])), lgb = -log1pf(expf(-inp(a, I_RDB)[l * 4 + h]));
    float q[64]; ld64bf(cols + (size_t)row * NMIX + C_RQ + h * 64, q);
    float acc[64];
#pragma unroll
    for (int i = 0; i < 64; ++i) acc[i] = 0.f;
    for (int s = 0; s < L; ++s) { const bf16_t* kr = cols + (size_t)(rb + s) * NMIX; const int d = t - s;
        const float w = (d >= 0 ? __expf((float)d * lgf) : 0.f) + (d <= 0 ? __expf((float)(-d) * lgb) : 0.f);
        const float dt = dot64bf(kr + C_RK + h * 64, q) * 0.125f; axpy64bf(w * dt, kr + C_RV + h * 128 + eh * 64, acc); }
    if (lat) { const float* Sf = inp(a, I_SRF) + ((((size_t)b * 2 + l) * 4 + h) * 64) * 128 + eh * 64; const float* Sb = inp(a, I_SRB) + ((((size_t)b * 2 + l) * 4 + h) * 64) * 128 + eh * 64;
        const float wf = expf((float)(t + 1) * lgf), wb = expf((float)(L - t) * lgb);
#pragma unroll
        for (int i = 0; i < 64; ++i) qs[lane * 65 + i] = q[i];
        LDS_WAIT(); asm volatile("" ::: "memory");
#pragma unroll 1
        for (int d = 0; d < 64; ++d) { const float qd = qs[lane * 65 + d]; const float qf = qd * wf, qb2 = qd * wb; const float4* pf = (const float4*)(Sf + (size_t)d * 128); const float4* pb = (const float4*)(Sb + (size_t)d * 128);
#pragma unroll
            for (int i = 0; i < 16; ++i) { const float4 u = pf[i], v = pb[i]; acc[4 * i + 0] += qf * u.x + qb2 * v.x; acc[4 * i + 1] += qf * u.y + qb2 * v.y; acc[4 * i + 2] += qf * u.z + qb2 * v.z; acc[4 * i + 3] += qf * u.w + qb2 * v.w;
                if ((i & 3) == 3) asm volatile("" ::: "memory"); } }
        LDS_WAIT(); asm volatile("" ::: "memory"); }
    float ss = 0.f;
#pragma unroll
    for (int i = 0; i < 64; ++i) ss += acc[i] * acc[i];
    ss += __shfl_xor(ss, 1);
    const float rs = 1.0f / sqrtf(ss * (1.0f / 128.0f) + EPS);
    float g[64]; ld64bf(cols + (size_t)row * NMIX + C_RG + h * 128 + eh * 64, g);
#pragma unroll
    for (int i = 0; i < 64; ++i) { const float gv = g[i]; acc[i] = acc[i] * rs * (gv / (1.0f + __expf(-gv))); }
    st64bf(yo + (size_t)row * 512 + h * 128 + eh * 64, acc);
}
__device__ __forceinline__ void retstate_thread(const Ctx& a, int l, int idx) {
    const bf16_t* cols = (const bf16_t*)(a.ws + WS_BIG);
    const int e = idx & 127, d = (idx >> 7) & 63, h = (idx >> 13) & 3, b = idx >> 15;
    const float lgf = -log1pf(expf(-inp(a, I_RDF)[l * 4 + h])), lgb = -log1pf(expf(-inp(a, I_RDB)[l * 4 + h]));
    float sf = 0.f, sb = 0.f;
    for (int s = 0; s < 256; ++s) { const bf16_t* kr = cols + (size_t)(b * 256 + s) * NMIX; const float kv = bf2f(kr[C_RK + h * 64 + d]) * 0.125f * bf2f(kr[C_RV + h * 128 + e]);
        sf += __expf((float)(255 - s) * lgf) * kv; sb += __expf((float)s * lgb) * kv; }
    const size_t o = ((((size_t)b * 2 + l) * 4 + h) * 64 + d) * 128 + e;
    a.out[O_RF + o] = sf; a.out[O_RB + o] = sb;
}
__device__ __forceinline__ void hy2_thread(const Ctx& a, int l, int idx) {
    const bf16_t* cols = (const bf16_t*)(a.ws + WS_BIG); bf16_t* yo = (bf16_t*)(a.ws + WS_YBR);
    const bool lat = idx >= 524288; const int i2 = lat ? idx - 524288 : idx, c = i2 & 511, L = lat ? 1024 : 256, ng = L >> 3, tg = (i2 >> 9) % ng, b = (i2 >> 9) / ng;
    const int rb = lat ? 8192 + b * 1024 : b * 256, t0 = tg * 8;
    const float* G = (const float*)(a.ws + WS_FILT) + (size_t)l * (2560 * 512) + (lat ? 512 * 512 : 0) + c;
    const bf16_t* Z = (const bf16_t*)(a.ws + WS_ZB) + (size_t)rb * 512 + c;
    float w[8], acc[8];
#pragma unroll
    for (int i = 0; i < 8; ++i) { acc[i] = 0.f; w[i] = G[(size_t)(t0 + i + L - 1) * 512]; }
#pragma unroll 8
    for (int s = 0; s < L; ++s) { const float z = bf2f(Z[(size_t)s * 512]);
#pragma unroll
        for (int i = 0; i < 8; ++i) acc[i] += w[i] * z;
#pragma unroll
        for (int i = 7; i >= 1; --i) w[i] = w[i - 1];
        const int jn = t0 - (s + 1) + L - 1; w[0] = G[(size_t)(jn < 0 ? 0 : jn) * 512]; }
    const float* cw = inp(a, I_HCW) + l * 3 * 1536; const float cb = inp(a, I_HCB)[l * 1536 + 512 + c], sk = inp(a, I_HSKIP)[l * 512 + c];
    const float w0 = cw[512 + c], w1 = cw[1536 + 512 + c], w2 = cw[3072 + 512 + c];
#pragma unroll
    for (int i = 0; i < 8; ++i) { const int t = t0 + i; const bf16_t* p = cols + (size_t)(rb + t) * NMIX + 512 + c;
        const float xm = t > 0 ? bf2f(p[-NMIX]) : 0.f, x0 = bf2f(p[0]), xp = t < L - 1 ? bf2f(p[NMIX]) : 0.f;
        const float x0c = xm * w0 + x0 * w1 + xp * w2 + cb; const float y = acc[i] + sk * bf2f(Z[(size_t)t * 512]);
        yo[(size_t)(rb + t) * 512 + c] = (bf16_t)f2bf(x0c * y); }
}

typedef pg8::bf16x8 bf16x8;
__device__ __forceinline__ bf16x8 ldfrag(const bf16_t* p) { return *(const bf16x8*)p; }
__device__ __forceinline__ bf16x8 pack8(const float (&p)[8]) { u32x4 w; w.x = cvt_pk_bf16(p[0], p[1]); w.y = cvt_pk_bf16(p[2], p[3]); w.z = cvt_pk_bf16(p[4], p[5]); w.w = cvt_pk_bf16(p[6], p[7]); return __builtin_bit_cast(bf16x8, w); }
#define MFMA16(a, b, c) __builtin_amdgcn_mfma_f32_16x16x32_bf16((a), (b), (c), 0, 0, 0)
template <bool F32SRC> __device__ __forceinline__ void transpose64(const void* src, size_t sp, bf16_t* dst, size_t dp, LAS float* scr, int lane, size_t hp = 32) {
    if (F32SRC) { const float4* p = (const float4*)((const float*)src + (size_t)lane * sp);
#pragma unroll
        for (int i = 0; i < 16; ++i) { const float4 u = p[i]; scr[lane * 65 + 4 * i + 0] = u.x; scr[lane * 65 + 4 * i + 1] = u.y; scr[lane * 65 + 4 * i + 2] = u.z; scr[lane * 65 + 4 * i + 3] = u.w; } }
    else { const uint4* p = (const uint4*)((const bf16_t*)src + (size_t)lane * sp);
#pragma unroll
        for (int i = 0; i < 8; ++i) { const uint4 u = p[i]; LAS float* d = scr + lane * 65 + 8 * i;
            d[0] = bf_lo(u.x); d[1] = bf_hi(u.x); d[2] = bf_lo(u.y); d[3] = bf_hi(u.y); d[4] = bf_lo(u.z); d[5] = bf_hi(u.z); d[6] = bf_lo(u.w); d[7] = bf_hi(u.w); } }
    LDS_WAIT(); asm volatile("" ::: "memory");
#pragma unroll
    for (int i = 0; i < 8; ++i) { const LAS float* c = scr + (8 * i) * 65 + lane; uint4 w;
        w.x = pk2(c[0], c[65]); w.y = pk2(c[2 * 65], c[3 * 65]); w.z = pk2(c[4 * 65], c[5 * 65]); w.w = pk2(c[6 * 65], c[7 * 65]);
        *(uint4*)(dst + (size_t)lane * dp + (size_t)(i >> 2) * hp + (i & 3) * 8) = w; }
    LDS_WAIT(); asm volatile("" ::: "memory");
}
__device__ __forceinline__ void prep_diff(const Ctx& a, int l, LAS unsigned char* lds, int bid, int nblk, int tid) {
    const int lane = tid & 63, wave = __builtin_amdgcn_readfirstlane(tid >> 6), gw = bid * 8 + wave, NGW = nblk * 8, gtid = bid * 512 + tid, NT = nblk * 512;
    LAS float* scr = (LAS float*)(lds + wave * 16640);
    const bf16_t* cols = (const bf16_t*)(a.ws + WS_BIG); bf16_t* vtl = (bf16_t*)(a.ws + WS_VTDL); bf16_t* vtc = (bf16_t*)(a.ws + WS_VTDC);
#pragma unroll 1
    for (int it = gw; it < 2560; it += NGW) {
        if (it < 1024) { const int b = it >> 7, h = (it >> 5) & 3, tb = (it >> 1) & 15, eb = it & 1;
            transpose64<false>(cols + (size_t)(8192 + b * 1024 + tb * 64) * NMIX + C_DV + h * 128 + eb * 64, NMIX, vtl + (size_t)(b * 4 + h) * 128 * 1536 + ((size_t)(2 * tb) * 128 + eb * 64) * 32, 32, scr, lane, 128 * 32); }
        else if (it < 1536) { const int q = it - 1024, b = q >> 6, h = (q >> 4) & 3, jb = (q >> 1) & 7, eb = q & 1;
            transpose64<true>(inp(a, I_CDV) + ((((size_t)b * 2 + l) * 512 + jb * 64) * 4 + h) * 128 + eb * 64, 512, vtl + (size_t)(b * 4 + h) * 128 * 1536 + ((size_t)(32 + 2 * jb) * 128 + eb * 64) * 32, 32, scr, lane, 128 * 32); }
        else { const int q = it - 1536, b = q >> 5, h = (q >> 3) & 3, tb = (q >> 1) & 3, eb = q & 1;
            transpose64<false>(cols + (size_t)(b * 256 + tb * 64) * NMIX + C_DV + h * 128 + eb * 64, NMIX, vtc + (size_t)(b * 4 + h) * 128 * 256 + ((size_t)(2 * tb) * 128 + eb * 64) * 32, 32, scr, lane, 128 * 32); }
    }
    { bf16_t* kdc = (bf16_t*)(a.ws + WS_KDC); const float* ck = inp(a, I_CDK);
      for (int i = gtid; i < 8 * 4 * 2 * 512 * 8; i += NT) { const int d8 = i & 7, j = (i >> 3) & 511, c = (i >> 12) & 1, h = (i >> 13) & 3, b = i >> 15;
          const float4* p = (const float4*)(ck + (((((size_t)b * 2 + l) * 512 + j) * 4 + h) * 2 + c) * 64 + d8 * 8); const float4 u = p[0], v = p[1];
          uint4 w; w.x = pk2(u.x, u.y); w.y = pk2(u.z, u.w); w.z = pk2(v.x, v.y); w.w = pk2(v.z, v.w);
          *(uint4*)(kdc + ((((size_t)b * 4 + h) * 2 + c) * 512 + j) * 64 + d8 * 8) = w; } }
}
__device__ __forceinline__ void diff_map(const bf16_t* cols, const bf16_t* kdc_bh  , const bf16_t* vt  , int nk, int L, int rb, int h, int c, int q0, int lane, f32x4 (&O)[2][8]) {
    const int q16 = lane & 15, g = lane >> 4;
    bf16x8 bq[2][2];
#pragma unroll
    for (int qt = 0; qt < 2; ++qt)
#pragma unroll
        for (int kd = 0; kd < 2; ++kd) bq[qt][kd] = ldfrag(cols + (size_t)(rb + q0 + 16 * qt + q16) * NMIX + C_DQ + (h * 2 + c) * 64 + 32 * kd + 8 * g);
    float m[2] = {-1e30f, -1e30f}, ls[2] = {0.f, 0.f};
#pragma unroll
    for (int qt = 0; qt < 2; ++qt)
#pragma unroll
        for (int et = 0; et < 8; ++et) O[qt][et] = (f32x4){0.f, 0.f, 0.f, 0.f};
    const int nkb = nk >> 5, nkt = L >> 5, kr = 8 * (q16 >> 2) + (q16 & 3);
    const float sc2 = 0.125f * 1.44269504088896f;
    const bf16_t* ktok = cols + (size_t)(rb + kr) * NMIX + C_DK + (h * 2 + c) * 64 + 8 * g; const bf16_t* kcac = kdc_bh + ((size_t)c * 512 + kr) * 64 + 8 * g;
#define DKP(kb_) ((kb_) < nkt ? ktok + (size_t)(kb_) * 32 * NMIX : kcac + (size_t)((kb_) - nkt) * 32 * 64)
#define DKS(kb_) ((kb_) < nkt ? 4 * NMIX : 4 * 64)
    bf16x8 ak00, ak01, ak10, ak11;
    { const bf16_t* kp = DKP(0); const int st = DKS(0); ak00 = ldfrag(kp); ak01 = ldfrag(kp + 32); ak10 = ldfrag(kp + st); ak11 = ldfrag(kp + st + 32); }
#pragma unroll 1
    for (int kb = 0; kb < nkb; ++kb) {
        bf16x8 av[8];
#pragma unroll
        for (int et = 0; et < 8; ++et) av[et] = ldfrag(vt + ((size_t)kb * 128 + 16 * et + q16) * 32 + 8 * g);
        const int kn = kb + 1 < nkb ? kb + 1 : kb; const bf16_t* kp = DKP(kn); const int st = DKS(kn);
        const bf16x8 n00 = ldfrag(kp), n01 = ldfrag(kp + 32), n10 = ldfrag(kp + st), n11 = ldfrag(kp + st + 32);
        bf16x8 pb[2];
#pragma unroll
        for (int qt = 0; qt < 2; ++qt) {
            f32x4 s0 = MFMA16(ak00, bq[qt][0], ((f32x4){0.f, 0.f, 0.f, 0.f})); s0 = MFMA16(ak01, bq[qt][1], s0);
            f32x4 s1 = MFMA16(ak10, bq[qt][0], ((f32x4){0.f, 0.f, 0.f, 0.f})); s1 = MFMA16(ak11, bq[qt][1], s1);
            float x[8] = {s0[0] * sc2, s0[1] * sc2, s0[2] * sc2, s0[3] * sc2, s1[0] * sc2, s1[1] * sc2, s1[2] * sc2, s1[3] * sc2};
            float ml = fmaxf(fmaxf(fmaxf(x[0], x[1]), fmaxf(x[2], x[3])), fmaxf(fmaxf(x[4], x[5]), fmaxf(x[6], x[7])));
            ml = fmaxf(ml, __shfl_xor(ml, 16)); ml = fmaxf(ml, __shfl_xor(ml, 32));
            const float mn = fmaxf(m[qt], ml), alpha = __builtin_amdgcn_exp2f(m[qt] - mn); m[qt] = mn;
            float p[8], psum = 0.f;
#pragma unroll
            for (int j = 0; j < 8; ++j) { p[j] = __builtin_amdgcn_exp2f(x[j] - mn); psum += p[j]; }
            ls[qt] = ls[qt] * alpha + psum;
#pragma unroll
            for (int et = 0; et < 8; ++et) O[qt][et] = O[qt][et] * alpha;
            pb[qt] = pack8(p);
        }
#pragma unroll
        for (int et = 0; et < 8; ++et) { O[0][et] = MFMA16(av[et], pb[0], O[0][et]); O[1][et] = MFMA16(av[et], pb[1], O[1][et]); }
        ak00 = n00; ak01 = n01; ak10 = n10; ak11 = n11;
    }
#undef DKP
#undef DKS
#pragma unroll
    for (int qt = 0; qt < 2; ++qt) { float lt = ls[qt]; lt += __shfl_xor(lt, 16); lt += __shfl_xor(lt, 32); const float inv = 1.0f / lt;
#pragma unroll
        for (int et = 0; et < 8; ++et) O[qt][et] = O[qt][et] * inv; }
}
__device__ __forceinline__ void diff_mfma_item(const Ctx& a, int l, int grp, int h, int qb, int lane, LAS float* scr) {
    const bf16_t* cols = (const bf16_t*)(a.ws + WS_BIG); bf16_t* yo = (bf16_t*)(a.ws + WS_YBR) + (size_t)1 * M * 512;
    const bool lat = grp >= 32; const int b = lat ? grp - 32 : grp, L = lat ? 1024 : 256, rb = lat ? 8192 + b * 1024 : b * 256, nk = lat ? 1536 : 256;
    const int q16 = lane & 15, g = lane >> 4, q0 = qb * 32;
    const bf16_t* vt = lat ? (const bf16_t*)(a.ws + WS_VTDL) + (size_t)((b * 4 + h) * 128) * 1536 : (const bf16_t*)(a.ws + WS_VTDC) + (size_t)((b * 4 + h) * 128) * 256;
    const bf16_t* kdc = (const bf16_t*)(a.ws + WS_KDC) + (size_t)((b * 4 + h) * 2) * 512 * 64;
    const float* dl = inp(a, I_DLAM) + l * 256; float s01 = 0.f, s23 = 0.f;
    for (int i = 0; i < 64; ++i) { s01 += dl[i] * dl[64 + i]; s23 += dl[128 + i] * dl[192 + i]; }
    const float lam_init = 0.8f - 0.6f * expf(-0.3f * (float)l), lam = expf(s01) - expf(s23) + lam_init;
    f32x4 o0[2][8], o1[2][8];
    diff_map(cols, kdc, vt, nk, L, rb, h, 0, q0, lane, o0);
#pragma unroll
    for (int qt = 0; qt < 2; ++qt)
#pragma unroll
        for (int et = 0; et < 8; ++et) *(LAS f32x4*)(scr + ((qt * 8 + et) * 64 + lane) * 4) = o0[qt][et];
    asm volatile("" ::: "memory");
    diff_map(cols, kdc, vt, nk, L, rb, h, 1, q0, lane, o1);
    LDS_WAIT(); asm volatile("" ::: "memory");
#pragma unroll
    for (int qt = 0; qt < 2; ++qt)
#pragma unroll
        for (int et = 0; et < 8; ++et) o0[qt][et] = *(const LAS f32x4*)(scr + ((qt * 8 + et) * 64 + lane) * 4);
    LDS_WAIT(); asm volatile("" ::: "memory");
    const float* sg = inp(a, I_DSUB) + l * 128;
#pragma unroll
    for (int qt = 0; qt < 2; ++qt) { float ss = 0.f;
#pragma unroll
        for (int et = 0; et < 8; ++et) { o0[qt][et] = o0[qt][et] - o1[qt][et] * lam; const f32x4 v = o0[qt][et]; ss += (v[0] * v[0] + v[1] * v[1]) + (v[2] * v[2] + v[3] * v[3]); }
        ss += __shfl_xor(ss, 16); ss += __shfl_xor(ss, 32);
        const float rs = (1.0f / sqrtf(ss * (1.0f / 128.0f) + EPS)) * (1.0f - lam_init);
        bf16_t* orow = yo + (size_t)(rb + q0 + 16 * qt + q16) * 512 + h * 128 + 4 * g;
#pragma unroll
        for (int et = 0; et < 8; ++et) { const f32x4 gn = *(const f32x4*)(sg + 16 * et + 4 * g); const f32x4 v = o0[qt][et] * rs * gn;
            u32x2 w; w.x = cvt_pk_bf16(v[0], v[1]); w.y = cvt_pk_bf16(v[2], v[3]); *(u32x2*)(orow + 16 * et) = w; } }
}

__device__ __forceinline__ void prep_ret(const Ctx& a, int l, LAS unsigned char* lds, int bid, int nblk, int tid) {
    const int lane = tid & 63, wave = __builtin_amdgcn_readfirstlane(tid >> 6), gw = bid * 8 + wave, NGW = nblk * 8;
    LAS float* scr = (LAS float*)(lds + wave * 16640);
    const bf16_t* cols = (const bf16_t*)(a.ws + WS_BIG); bf16_t* vtl = (bf16_t*)(a.ws + WS_VTRL); bf16_t* vtc = (bf16_t*)(a.ws + WS_VTRC); bf16_t* st = (bf16_t*)(a.ws + WS_ST);
#pragma unroll 1
    for (int it = gw; it < 2048 + 128 + 512; it += NGW) {
        if (it >= 2048 + 128) { const int q = it - 2176, b = q >> 4, h = (q >> 2) & 3, tb = q & 3;
            transpose64<false>(cols + (size_t)(b * 256 + tb * 64) * NMIX + C_RK + h * 64, NMIX, (bf16_t*)(a.ws + WS_KTR) + (size_t)((b * 4 + h) * 64) * 256 + tb * 64, 256, scr, lane); }
        else if (it < 1024) { const int b = it >> 7, h = (it >> 5) & 3, tb = (it >> 1) & 15, eb = it & 1;
            transpose64<false>(cols + (size_t)(8192 + b * 1024 + tb * 64) * NMIX + C_RV + h * 128 + eb * 64, NMIX, vtl + (size_t)(b * 4 + h) * 128 * 1024 + ((size_t)(2 * tb) * 128 + eb * 64) * 32, 32, scr, lane, 128 * 32); }
        else if (it < 2048) { const int q = it - 1024, b = q >> 5, h = (q >> 3) & 3, tb = (q >> 1) & 3, eb = q & 1;
            transpose64<false>(cols + (size_t)(b * 256 + tb * 64) * NMIX + C_RV + h * 128 + eb * 64, NMIX, vtc + (size_t)(b * 4 + h) * 128 * 256 + ((size_t)(2 * tb) * 128 + eb * 64) * 32, 32, scr, lane, 128 * 32); }
        else { const int q = it - 2048, b = q >> 4, h = (q >> 2) & 3, dir = (q >> 1) & 1, eb = q & 1;
            const float* src = inp(a, dir ? I_SRB : I_SRF) + ((((size_t)b * 2 + l) * 4 + h) * 64) * 128 + eb * 64;
            transpose64<true>(src, 128, st + ((size_t)((b * 4 + h) * 2 + dir) * 128 + eb * 64) * 64, 64, scr, lane); }
    }
}
__device__ __forceinline__ bf16x8 scale8(bf16x8 v, float w) { const u32x4 u = __builtin_bit_cast(u32x4, v); float p[8] = {bf_lo(u.x) * w, bf_hi(u.x) * w, bf_lo(u.y) * w, bf_hi(u.y) * w, bf_lo(u.z) * w, bf_hi(u.z) * w, bf_lo(u.w) * w, bf_hi(u.w) * w}; return pack8(p); }
__device__ __forceinline__ void ret_mfma_item(const Ctx& a, int l, int grp, int h, int qb, int lane) {
    const bf16_t* cols = (const bf16_t*)(a.ws + WS_BIG); bf16_t* yo = (bf16_t*)(a.ws + WS_YBR) + (size_t)3 * M * 512;
    const bool lat = grp >= 32; const int b = lat ? grp - 32 : grp, L = lat ? 1024 : 256, rb = lat ? 8192 + b * 1024 : b * 256;
    const int q16 = lane & 15, g = lane >> 4, q0 = qb * 32;
    const bf16_t* vt = lat ? (const bf16_t*)(a.ws + WS_VTRL) + (size_t)((b * 4 + h) * 128) * 1024 : (const bf16_t*)(a.ws + WS_VTRC) + (size_t)((b * 4 + h) * 128) * 256;
    const float lgf2 = -log1pf(expf(-inp(a, I_RDF)[l * 4 + h])) * 1.44269504088896f, lgb2 = -log1pf(expf(-inp(a, I_RDB)[l * 4 + h])) * 1.44269504088896f;
    bf16x8 bq[2][2];
#pragma unroll
    for (int qt = 0; qt < 2; ++qt)
#pragma unroll
        for (int kd = 0; kd < 2; ++kd) bq[qt][kd] = ldfrag(cols + (size_t)(rb + q0 + 16 * qt + q16) * NMIX + C_RQ + h * 64 + 32 * kd + 8 * g);
    f32x4 O[2][8];
#pragma unroll
    for (int qt = 0; qt < 2; ++qt)
#pragma unroll
        for (int et = 0; et < 8; ++et) O[qt][et] = (f32x4){0.f, 0.f, 0.f, 0.f};
    const int nkb = L >> 5, kr = 8 * (q16 >> 2) + (q16 & 3);
    const bf16_t* kbase = cols + (size_t)(rb + kr) * NMIX + C_RK + h * 64 + 8 * g;
    bf16x8 ak00 = ldfrag(kbase), ak01 = ldfrag(kbase + 32), ak10 = ldfrag(kbase + 4 * NMIX), ak11 = ldfrag(kbase + 4 * NMIX + 32);
#pragma unroll 1
    for (int kb = 0; kb < nkb; ++kb) {
        bf16x8 av[8];
#pragma unroll
        for (int et = 0; et < 8; ++et) av[et] = ldfrag(vt + ((size_t)kb * 128 + 16 * et + q16) * 32 + 8 * g);
        const bf16_t* kp = kbase + (size_t)(kb + 1 < nkb ? kb + 1 : kb) * 32 * NMIX;
        const bf16x8 n00 = ldfrag(kp), n01 = ldfrag(kp + 32), n10 = ldfrag(kp + 4 * NMIX), n11 = ldfrag(kp + 4 * NMIX + 32);
        bf16x8 pb[2];
#pragma unroll
        for (int qt = 0; qt < 2; ++qt) {
            f32x4 s0 = MFMA16(ak00, bq[qt][0], ((f32x4){0.f, 0.f, 0.f, 0.f})); s0 = MFMA16(ak01, bq[qt][1], s0);
            f32x4 s1 = MFMA16(ak10, bq[qt][0], ((f32x4){0.f, 0.f, 0.f, 0.f})); s1 = MFMA16(ak11, bq[qt][1], s1);
            const float x[8] = {s0[0], s0[1], s0[2], s0[3], s1[0], s1[1], s1[2], s1[3]};
            const int d0 = (q0 + 16 * qt + q16) - (kb * 32 + 8 * g);
            float p[8];
#pragma unroll
            for (int j = 0; j < 8; ++j) { const int d = d0 - j; const float wf = d >= 0 ? __builtin_amdgcn_exp2f((float)d * lgf2) : 0.f, wb = d <= 0 ? __builtin_amdgcn_exp2f((float)(-d) * lgb2) : 0.f;
                p[j] = x[j] * 0.125f * (wf + wb); }
            pb[qt] = pack8(p);
        }
#pragma unroll
        for (int et = 0; et < 8; ++et) { O[0][et] = MFMA16(av[et], pb[0], O[0][et]); O[1][et] = MFMA16(av[et], pb[1], O[1][et]); }
        ak00 = n00; ak01 = n01; ak10 = n10; ak11 = n11;
    }
    if (lat) { const bf16_t* stf = (const bf16_t*)(a.ws + WS_ST) + (size_t)((b * 4 + h) * 2) * 128 * 64; const bf16_t* stb = stf + 128 * 64;
        bf16x8 qf[2][2], qk[2][2];
#pragma unroll
        for (int qt = 0; qt < 2; ++qt) { const int t = q0 + 16 * qt + q16; const float wf = __builtin_amdgcn_exp2f((float)(t + 1) * lgf2), wb = __builtin_amdgcn_exp2f((float)(L - t) * lgb2);
#pragma unroll
            for (int kd = 0; kd < 2; ++kd) { qf[qt][kd] = scale8(bq[qt][kd], wf); qk[qt][kd] = scale8(bq[qt][kd], wb); } }
#pragma unroll
        for (int et = 0; et < 8; ++et) { const bf16_t* pf = stf + (size_t)(16 * et + q16) * 64 + 8 * g; const bf16_t* pb2 = stb + (size_t)(16 * et + q16) * 64 + 8 * g;
            const bf16x8 f0 = ldfrag(pf), f1 = ldfrag(pf + 32), b0 = ldfrag(pb2), b1 = ldfrag(pb2 + 32);
#pragma unroll
            for (int qt = 0; qt < 2; ++qt) { O[qt][et] = MFMA16(f0, qf[qt][0], O[qt][et]); O[qt][et] = MFMA16(f1, qf[qt][1], O[qt][et]); O[qt][et] = MFMA16(b0, qk[qt][0], O[qt][et]); O[qt][et] = MFMA16(b1, qk[qt][1], O[qt][et]); }
            asm volatile("" ::: "memory"); } }
#pragma unroll
    for (int qt = 0; qt < 2; ++qt) { float ss = 0.f;
#pragma unroll
        for (int et = 0; et < 8; ++et) { const f32x4 v = O[qt][et]; ss += (v[0] * v[0] + v[1] * v[1]) + (v[2] * v[2] + v[3] * v[3]); }
        ss += __shfl_xor(ss, 16); ss += __shfl_xor(ss, 32);
        const float rs = 1.0f / sqrtf(ss * (1.0f / 128.0f) + EPS);
        const size_t row = (size_t)(rb + q0 + 16 * qt + q16);
        const bf16_t* rg = cols + row * NMIX + C_RG + h * 128 + 4 * g; bf16_t* orow = yo + row * 512 + h * 128 + 4 * g;
#pragma unroll
        for (int et = 0; et < 8; ++et) { const u32x2 gw2 = *(const u32x2*)(rg + 16 * et); const float g0 = bf_lo(gw2.x), g1 = bf_hi(gw2.x), g2 = bf_lo(gw2.y), g3 = bf_hi(gw2.y);
            const f32x4 v = O[qt][et] * rs;
            u32x2 w; w.x = cvt_pk_bf16(v[0] * (g0 / (1.0f + __expf(-g0))), v[1] * (g1 / (1.0f + __expf(-g1)))); w.y = cvt_pk_bf16(v[2] * (g2 / (1.0f + __expf(-g2))), v[3] * (g3 / (1.0f + __expf(-g3))));
            *(u32x2*)(orow + 16 * et) = w; } }
}

__device__ __forceinline__ void prep_win(const Ctx& a, int l, LAS unsigned char* lds, int bid, int nblk, int tid) {
    const int lane = tid & 63, wave = __builtin_amdgcn_readfirstlane(tid >> 6), gw = bid * 8 + wave, NGW = nblk * 8, gtid = bid * 512 + tid, NT = nblk * 512;
    LAS float* scr = (LAS float*)(lds + wave * 16640);
    const bf16_t* cols = (const bf16_t*)(a.ws + WS_BIG); bf16_t* vtl = (bf16_t*)(a.ws + WS_VTWL); bf16_t* vtc = (bf16_t*)(a.ws + WS_VTWC);
#pragma unroll 1
    for (int it = gw; it < 640; it += NGW) {
        if (it < 256) { const int b = it >> 5, hk = (it >> 4) & 1, tb = it & 15;
            transpose64<false>(cols + (size_t)(8192 + b * 1024 + tb * 64) * NMIX + C_WV + hk * 64, NMIX, vtl + (size_t)(b * 2 + hk) * 64 * 1536 + (size_t)(2 * tb) * 64 * 32, 32, scr, lane, 64 * 32); }
        else if (it < 384) { const int q = it - 256, b = q >> 4, hk = (q >> 3) & 1, jb = q & 7;
            transpose64<true>(inp(a, I_CWV) + ((((size_t)b * 2 + l) * 512 + jb * 64) * 2 + hk) * 64, 128, vtl + (size_t)(b * 2 + hk) * 64 * 1536 + (size_t)(32 + 2 * jb) * 64 * 32, 32, scr, lane, 64 * 32); }
        else { const int q = it - 384, b = q >> 3, hk = (q >> 2) & 1, tb = q & 3;
            transpose64<false>(cols + (size_t)(b * 256 + tb * 64) * NMIX + C_WV + hk * 64, NMIX, vtc + (size_t)(b * 2 + hk) * 64 * 256 + (size_t)(2 * tb) * 64 * 32, 32, scr, lane, 64 * 32); }
    }
    { bf16_t* kwc = (bf16_t*)(a.ws + WS_KWC); const float* ck = inp(a, I_CWK);
      for (int i = gtid; i < 8 * 2 * 512 * 8; i += NT) { const int d8 = i & 7, j = (i >> 3) & 511, hk = (i >> 12) & 1, b = i >> 13;
          const float4* p = (const float4*)(ck + ((((size_t)b * 2 + l) * 512 + j) * 2 + hk) * 64 + d8 * 8); const float4 u = p[0], v = p[1];
          uint4 w; w.x = pk2(u.x, u.y); w.y = pk2(u.z, u.w); w.z = pk2(v.x, v.y); w.w = pk2(v.z, v.w);
          *(uint4*)(kwc + (((size_t)b * 2 + hk) * 512 + j) * 64 + d8 * 8) = w; } }
}
__device__ __forceinline__ void win_mfma_item(const Ctx& a, int l, int grp, int hk, int tb, int lane) {
    const bf16_t* cols = (const bf16_t*)(a.ws + WS_BIG); bf16_t* yo = (bf16_t*)(a.ws + WS_YBR) + (size_t)2 * M * 512;
    const bool lat = grp >= 32; const int b = lat ? grp - 32 : grp, L = lat ? 1024 : 256, rb = lat ? 8192 + b * 1024 : b * 256, nk = lat ? 1536 : 256;
    const int q16 = lane & 15, g = lane >> 4, t0 = tb * 16, t = t0 + q16;
    const bf16_t* vt = lat ? (const bf16_t*)(a.ws + WS_VTWL) + (size_t)((b * 2 + hk) * 64) * 1536 : (const bf16_t*)(a.ws + WS_VTWC) + (size_t)((b * 2 + hk) * 64) * 256;
    const bf16_t* kwc = (const bf16_t*)(a.ws + WS_KWC) + (size_t)(b * 2 + hk) * 512 * 64;
    bf16x8 bq[4][2]; float m[4], ls[4]; f32x4 O[4][4];
#pragma unroll
    for (int qh = 0; qh < 4; ++qh) { m[qh] = inp(a, I_WSINK)[l * 8 + hk * 4 + qh] * 1.44269504088896f; ls[qh] = g == 0 ? 1.0f : 0.0f;
#pragma unroll
        for (int kd = 0; kd < 2; ++kd) bq[qh][kd] = ldfrag(cols + (size_t)(rb + t) * NMIX + C_WQ + (hk * 4 + qh) * 64 + 32 * kd + 8 * g);
#pragma unroll
        for (int et = 0; et < 4; ++et) O[qh][et] = (f32x4){0.f, 0.f, 0.f, 0.f}; }
    const int kr = 8 * (q16 >> 2) + (q16 & 3); const float sc2 = 0.125f * 1.44269504088896f;
    const int kb_lo = lat ? max(0, (t0 - 128) >> 5) : 0, kb_hi = lat ? min(31, (t0 + 143) >> 5) : 7, ncache = lat ? 16 : 0, nblocks = (kb_hi - kb_lo + 1) + ncache;
    const int ntokb = kb_hi - kb_lo + 1;
    const bf16_t* ktok = cols + (size_t)(rb + kr) * NMIX + C_WK + hk * 64 + 8 * g; const bf16_t* kcac = kwc + (size_t)kr * 64 + 8 * g;
#define WKP(ib_) ((ib_) < ntokb ? ktok + (size_t)(kb_lo + (ib_)) * 32 * NMIX : kcac + (size_t)((ib_) - ntokb) * 32 * 64)
#define WKS(ib_) ((ib_) < ntokb ? 4 * NMIX : 4 * 64)
    bf16x8 ak00, ak01, ak10, ak11;
    { const bf16_t* kp = WKP(0); const int st = WKS(0); ak00 = ldfrag(kp); ak01 = ldfrag(kp + 32); ak10 = ldfrag(kp + st); ak11 = ldfrag(kp + st + 32); }
#pragma unroll 1
    for (int ib = 0; ib < nblocks; ++ib) {
        const bool tok = ib < ntokb; const int kb = tok ? kb_lo + ib : ib - ntokb;
        const int vcol = tok ? kb * 32 : 1024 + kb * 32;
        bf16x8 av[4];
#pragma unroll
        for (int et = 0; et < 4; ++et) av[et] = ldfrag(vt + ((size_t)(vcol >> 5) * 64 + 16 * et + q16) * 32 + 8 * g);
        const int in = ib + 1 < nblocks ? ib + 1 : ib; const bf16_t* kp = WKP(in); const int st = WKS(in);
        const bf16x8 n00 = ldfrag(kp), n01 = ldfrag(kp + 32), n10 = ldfrag(kp + st), n11 = ldfrag(kp + st + 32);
        const bool domask = lat && tok; const int dk0 = t - (kb * 32 + 8 * g);
        bf16x8 pb[4];
#pragma unroll
        for (int qh = 0; qh < 4; ++qh) {
            f32x4 s0 = MFMA16(ak00, bq[qh][0], ((f32x4){0.f, 0.f, 0.f, 0.f})); s0 = MFMA16(ak01, bq[qh][1], s0);
            f32x4 s1 = MFMA16(ak10, bq[qh][0], ((f32x4){0.f, 0.f, 0.f, 0.f})); s1 = MFMA16(ak11, bq[qh][1], s1);
            float x[8] = {s0[0] * sc2, s0[1] * sc2, s0[2] * sc2, s0[3] * sc2, s1[0] * sc2, s1[1] * sc2, s1[2] * sc2, s1[3] * sc2};
            if (domask) {
#pragma unroll
                for (int j = 0; j < 8; ++j) { const int d = dk0 - j; if (d > 128 || d < -128) x[j] = -1e30f; } }
            float ml = fmaxf(fmaxf(fmaxf(x[0], x[1]), fmaxf(x[2], x[3])), fmaxf(fmaxf(x[4], x[5]), fmaxf(x[6], x[7])));
            ml = fmaxf(ml, __shfl_xor(ml, 16)); ml = fmaxf(ml, __shfl_xor(ml, 32));
            const float mn = fmaxf(m[qh], ml), alpha = __builtin_amdgcn_exp2f(m[qh] - mn); m[qh] = mn;
            float p[8], psum = 0.f;
#pragma unroll
            for (int j = 0; j < 8; ++j) { p[j] = __builtin_amdgcn_exp2f(x[j] - mn); psum += p[j]; }
            ls[qh] = ls[qh] * alpha + psum;
#pragma unroll
            for (int et = 0; et < 4; ++et) O[qh][et] = O[qh][et] * alpha;
            pb[qh] = pack8(p);
        }
#pragma unroll
        for (int et = 0; et < 4; ++et) {
#pragma unroll
            for (int qh = 0; qh < 4; ++qh) O[qh][et] = MFMA16(av[et], pb[qh], O[qh][et]); }
        ak00 = n00; ak01 = n01; ak10 = n10; ak11 = n11;
    }
#undef WKP
#undef WKS
#pragma unroll
    for (int qh = 0; qh < 4; ++qh) { float lt = ls[qh]; lt += __shfl_xor(lt, 16); lt += __shfl_xor(lt, 32); const float inv = 1.0f / lt;
        bf16_t* orow = yo + (size_t)(rb + t) * 512 + (hk * 4 + qh) * 64 + 4 * g;
#pragma unroll
        for (int et = 0; et < 4; ++et) { const f32x4 v = O[qh][et] * inv; u32x2 w; w.x = cvt_pk_bf16(v[0], v[1]); w.y = cvt_pk_bf16(v[2], v[3]); *(u32x2*)(orow + 16 * et) = w; } }
}

__device__ __forceinline__ void hy_mfma_item(const Ctx& a, int l, int it, int lane, LAS unsigned* fl  ) {
    const bf16_t* cols = (const bf16_t*)(a.ws + WS_BIG); bf16_t* yo = (bf16_t*)(a.ws + WS_YBR);
    const bool lat = it < 2048; const int c = lat ? it >> 2 : (it - 2048) >> 1, sub = lat ? it & 3 : (it - 2048) & 1;
    const int L = lat ? 1024 : 256, NB = lat ? 8 : 32, tg0 = lat ? sub * 256 : 0, b0 = lat ? 0 : sub * 16;
    const int tl = lane & 15, g = lane >> 4;
    const bf16_t* gt = (const bf16_t*)(a.ws + WS_GRT) + (size_t)l * (512 * 2560) + (lat ? 512 * 512 : 0) + (size_t)c * (2 * L);
    { const u32x4* src = (const u32x4*)gt; LAS u32x4* dst = (LAS u32x4*)fl;
      for (int i = lane; i < (2 * L) / 8; i += 64) dst[i] = src[i];
      LDS_WAIT(); asm volatile("" ::: "memory"); }
    const bf16_t* zt = (const bf16_t*)(a.ws + WS_ZB) + (lat ? ((size_t)c * 8 + (tl & 7)) * 1024 : (size_t)512 * 8 * 1024 + ((size_t)c * 32 + b0 + tl) * 256) + 8 * g;
    f32x4 acc[16];
#pragma unroll
    for (int tt = 0; tt < 16; ++tt) acc[tt] = (f32x4){0.f, 0.f, 0.f, 0.f};
#pragma unroll 1
    for (int s0 = 0; s0 < L; s0 += 32) { const bf16x8 zf = ldfrag(zt + s0);
        const int idx0 = L - 1 - (tg0 + tl) + s0 + 8 * g;
#pragma unroll
        for (int tt = 0; tt < 16; ++tt) { const int idx = idx0 - 16 * tt; const unsigned sh = (unsigned)(idx & 1) * 16u; const LAS unsigned* q = fl + (idx >> 1);
            const unsigned d0 = q[0], d1 = q[1], d2 = q[2], d3 = q[3], d4 = q[4];
            u32x4 w; w.x = __builtin_amdgcn_alignbit(d1, d0, sh); w.y = __builtin_amdgcn_alignbit(d2, d1, sh); w.z = __builtin_amdgcn_alignbit(d3, d2, sh); w.w = __builtin_amdgcn_alignbit(d4, d3, sh);
            acc[tt] = MFMA16(zf, __builtin_bit_cast(bf16x8, w), acc[tt]); } }
    const float* cw = inp(a, I_HCW) + l * 3 * 1536; const float cb = inp(a, I_HCB)[l * 1536 + 512 + c], sk = inp(a, I_HSKIP)[l * 512 + c];
    const float w0 = cw[512 + c], w1 = cw[1536 + 512 + c], w2 = cw[3072 + 512 + c];
    if (!lat || g < 2) {
#pragma unroll
        for (int tt = 0; tt < 16; ++tt) { const int t = tg0 + 16 * tt + tl;
#pragma unroll
            for (int r = 0; r < 4; ++r) { const int bb = b0 + 4 * g + r; const size_t row = (lat ? 8192 + (size_t)bb * 1024 : (size_t)bb * 256) + t; const bf16_t* p = cols + row * NMIX + 512 + c;
                const float xm = t > 0 ? bf2f(p[-NMIX]) : 0.f, x0 = bf2f(p[0]), xp = t < L - 1 ? bf2f(p[NMIX]) : 0.f;
                const float z = bf2f(((const bf16_t*)(a.ws + WS_ZB))[(lat ? ((size_t)c * 8 + bb) * 1024 : (size_t)512 * 8 * 1024 + ((size_t)c * 32 + bb) * 256) + t]);
                yo[row * 512 + c] = (bf16_t)f2bf((xm * w0 + x0 * w1 + xp * w2 + cb) * (acc[tt][r] + sk * z)); } } }
    LDS_WAIT(); asm volatile("" ::: "memory");
}

__device__ __forceinline__ void retstate_mfma_item(const Ctx& a, int l, int it, int lane) {
    const int dt = it & 3, dir = (it >> 2) & 1, h = (it >> 3) & 3, b = it >> 5, q16 = lane & 15, g = lane >> 4;
    const float lg2 = -log1pf(expf(-inp(a, dir ? I_RDB : I_RDF)[l * 4 + h])) * 1.44269504088896f;
    const bf16_t* kt = (const bf16_t*)(a.ws + WS_KTR) + (size_t)((b * 4 + h) * 64 + dt * 16 + q16) * 256 + 8 * g;
    const bf16_t* vt = (const bf16_t*)(a.ws + WS_VTRC) + (size_t)(b * 4 + h) * 128 * 256 + (size_t)q16 * 32 + 8 * g;
    f32x4 S[8];
#pragma unroll
    for (int et = 0; et < 8; ++et) S[et] = (f32x4){0.f, 0.f, 0.f, 0.f};
#pragma unroll 1
    for (int s0 = 0; s0 < 256; s0 += 32) { const u32x4 u = __builtin_bit_cast(u32x4, ldfrag(kt + s0)); const int sb = s0 + 8 * g;
        float p[8] = {bf_lo(u.x), bf_hi(u.x), bf_lo(u.y), bf_hi(u.y), bf_lo(u.z), bf_hi(u.z), bf_lo(u.w), bf_hi(u.w)};
#pragma unroll
        for (int j = 0; j < 8; ++j) { const int sp = sb + j; p[j] *= 0.125f * __builtin_amdgcn_exp2f((float)(dir ? sp : 255 - sp) * lg2); }
        const bf16x8 ka = pack8(p);
#pragma unroll
        for (int et = 0; et < 8; ++et) S[et] = MFMA16(ka, ldfrag(vt + ((size_t)(s0 >> 5) * 128 + 16 * et) * 32), S[et]); }
    float* o = a.out + (dir ? O_RB : O_RF) + ((((size_t)b * 2 + l) * 4 + h) * 64 + dt * 16 + 4 * g) * 128 + q16;
#pragma unroll
    for (int et = 0; et < 8; ++et)
#pragma unroll
        for (int r = 0; r < 4; ++r) o[(size_t)r * 128 + 16 * et] = S[et][r];
}
#define LAUNDER_MIX() do { unsigned long long w_ = (unsigned long long)a.ws, o_ = (unsigned long long)a.out; unsigned t_ = (unsigned)(size_t)a.tab; \
    asm volatile("" : "+s"(w_), "+s"(o_), "+s"(t_), "+s"(l), "+s"(gw), "+s"(NGW)); asm volatile("" : "+v"(lane)); a.ws = (unsigned char*)w_; a.out = (float*)o_; a.tab = (const LAS unsigned long long*)(size_t)t_; } while (0)
__device__ __forceinline__ void phase_mix(const Ctx& a0, int l, LAS unsigned char* lds, int bid, int nblk, int tid) {
    int lane = tid & 63; const int wave = __builtin_amdgcn_readfirstlane(tid >> 6); int gw = bid * 8 + wave, NGW = nblk * 8;
    LAS float* qs = (LAS float*)(lds + wave * 16640);
    Ctx a = a0;
    LAUNDER_MIX();
#pragma unroll 1
    for (int r = gw; r < 2048; r += NGW) { if (r < 1024) diff_mfma_item(a, l, 32 + (r >> 7), (r >> 5) & 3, r & 31, lane, qs); else { const int q = r - 1024; diff_mfma_item(a, l, q >> 5, (q >> 3) & 3, q & 7, lane, qs); } }
    LAUNDER_MIX();
#pragma unroll 1
    for (int r0 = gw; r0 < 2048; r0 += NGW) { const int r = (r0 + 1024) & 2047; if (r < 1024) ret_mfma_item(a, l, 32 + (r >> 7), (r >> 5) & 3, r & 31, lane); else { const int q = r - 1024; ret_mfma_item(a, l, q >> 5, (q >> 3) & 3, q & 7, lane); } }
    LAUNDER_MIX();
#pragma unroll 1
    for (int r0 = gw; r0 < 2048; r0 += NGW) { const int r = (r0 + 1024) & 2047; if (r < 1024) win_mfma_item(a, l, 32 + (r >> 7), (r >> 6) & 1, r & 63, lane); else { const int q = r - 1024; win_mfma_item(a, l, q >> 5, (q >> 4) & 1, q & 15, lane); } }
    LAUNDER_MIX();
#pragma unroll 1
    for (int r0 = gw; r0 < 2048; r0 += NGW) {
        if (r0 < 1024) hy_mfma_item(a, l, 2048 + r0, lane, (LAS unsigned*)qs);
        else { hy_mfma_item(a, l, 2 * (r0 - 1024), lane, (LAS unsigned*)qs); hy_mfma_item(a, l, 2 * (r0 - 1024) + 1, lane, (LAS unsigned*)qs); } }
    LAUNDER_MIX();
#pragma unroll 1
    for (int r = gw; r < 1024; r += NGW) retstate_mfma_item(a, l, r, lane);
}
template <class Epi> __device__ __forceinline__ void run_gemm(LAS unsigned char* lds, const bf16_t* A, const bf16_t* Bt, int N, int K, const Epi& E, int bid, int nblk, int tid) {
    pg8::Gemm g{A, Bt, M, N, K}; pg8::StaticOrder S; S.init(M, N, nblk, bid);
    pg8::gemm_phase<Epi, pg8::StaticOrder, false>(lds, g, S, E, nullptr, tid);
}
#define XB_TMO      128
#define XB_XCNT(j)  (256  + 64 * (j))
#define XB_XSUB(j)  (1280 + 64 * (j))
#define XB_XGEN(j)  (2304 + 64 * (j))
#define XB_TOP      3328
#define XB_TOPGEN   3392
#define XCD_BAR_WORDS 3456
#define XB_SPIN_CAP (1u << 18)

__device__ __forceinline__ unsigned xb_ld(unsigned* p)              { return __hip_atomic_load(p, __ATOMIC_RELAXED, __HIP_MEMORY_SCOPE_AGENT); }
__device__ __forceinline__ unsigned xb_add(unsigned* p, unsigned v) { return __hip_atomic_fetch_add(p, v, __ATOMIC_RELAXED, __HIP_MEMORY_SCOPE_AGENT); }
__device__ __forceinline__ unsigned xb_xcc_id() { return (unsigned)__builtin_amdgcn_s_getreg((3 << 11) | 20) & 0xFu; }
#define XB_SPIN(cond, bar) do { unsigned _sp = 0; while (cond) { __builtin_amdgcn_s_sleep(1); \
    if ((++_sp & 255u) == 0u) { if (xb_ld(&(bar)[XB_TMO])) break; if (_sp > XB_SPIN_CAP) { atomicAdd(&(bar)[XB_TMO], 1u); break; } } } } while (0)

struct XcdBarrier {
    unsigned* bar; unsigned x;
    volatile LAS unsigned* st;
};

__device__ __forceinline__ XcdBarrier xcd_barrier_post(unsigned* bar, volatile LAS unsigned* st) {
    XcdBarrier b; b.bar = bar; b.x = xb_xcc_id(); b.st = st;
    if (threadIdx.x == 0) (void)xb_add(&bar[XB_XCNT(b.x)], 1u);
    return b;
}
__device__ __forceinline__ void xcd_barrier_complete(unsigned* bar, unsigned x, unsigned& nloc, unsigned& nx) {
    const unsigned G = gridDim.x * gridDim.y * gridDim.z;
    unsigned sum, cnt, mine, sp = 0u;
    for (;;) {
        sum = 0u; cnt = 0u; mine = 0u;
#pragma unroll
        for (unsigned j = 0; j < 16; ++j) { const unsigned c = xb_ld(&bar[XB_XCNT(j)]); sum += c; cnt += (c > 0u) ? 1u : 0u; mine = (j == x) ? c : mine; }
        if (sum == G) break;
        __builtin_amdgcn_s_sleep(1);
        if ((++sp & 255u) == 0u) { if (xb_ld(&bar[XB_TMO])) break; if (sp > XB_SPIN_CAP) { atomicAdd(&bar[XB_TMO], 1u); break; } }
    }
    nloc = mine > 0u ? mine : 1u; nx = cnt > 0u ? cnt : 1u;
}

__device__ __forceinline__ void xcd_barrier(const XcdBarrier& b) {
    asm volatile("s_waitcnt vmcnt(0)" ::: "memory");
    __syncthreads();
    if (threadIdx.x == 0) {
        unsigned* bar = b.bar;
        __builtin_amdgcn_s_waitcnt(0);
        unsigned nloc = b.st[0], nx = b.st[1];
        if (nloc == 0u) { xcd_barrier_complete(bar, b.x, nloc, nx); b.st[0] = nloc; b.st[1] = nx; }
        const unsigned old = xb_add(&bar[XB_XSUB(b.x)], 1u);
        const unsigned gen = old / nloc;
        if (old + 1u == (gen + 1u) * nloc) {
            __builtin_amdgcn_fence(__ATOMIC_RELEASE, "agent");
            asm volatile("s_waitcnt vmcnt(0)" ::: "memory");
            const unsigned og = xb_add(&bar[XB_TOP], 1u);
            const unsigned tg = og / nx;
            if (og + 1u == (tg + 1u) * nx) xb_add(&bar[XB_TOPGEN], 1u);
            else XB_SPIN(xb_ld(&bar[XB_TOPGEN]) == tg, bar);
            __builtin_amdgcn_fence(__ATOMIC_ACQUIRE, "agent");
            xb_add(&bar[XB_XGEN(b.x)], 1u);
            asm volatile("s_waitcnt vmcnt(0)" ::: "memory");
        } else {
            XB_SPIN(xb_ld(&bar[XB_XGEN(b.x)]) == gen, bar);
            __builtin_amdgcn_fence(__ATOMIC_ACQUIRE, "agent");
            asm volatile("s_waitcnt vmcnt(0)" ::: "memory");
        }
    }
    __syncthreads();
}

template <int SL> __device__ __forceinline__ void run_slot(const Ctx& a0, int l, LAS unsigned char* lds, int bid, int nblk, int tid) {
    Ctx a = a0;
    { unsigned long long w = (unsigned long long)a.ws, o = (unsigned long long)a.out; unsigned t = (unsigned)(size_t)a.tab, ld = (unsigned)(size_t)lds;
      asm volatile("" : "+s"(w), "+s"(o), "+s"(t), "+s"(ld), "+s"(l), "+s"(bid), "+s"(nblk)); asm volatile("" : "+v"(tid));
      a.ws = (unsigned char*)w; a.out = (float*)o; a.tab = (const LAS unsigned long long*)(size_t)t; lds = (LAS unsigned char*)(size_t)ld; }
    unsigned char* ws = a.ws; unsigned char* wb = ws + WS_W;
    bf16_t* H = (bf16_t*)(ws + WS_H); bf16_t* BIG = (bf16_t*)(ws + WS_BIG); bf16_t* YBR = (bf16_t*)(ws + WS_YBR);
    float* MERGEP = (float*)(ws + WS_BIG + 128 * MiB);
    const float* modl = (const float*)(ws + WS_MOD) + (size_t)l * 9 * 9216;
    if constexpr (SL == 0) phase_p0a(a, lds, bid, nblk, tid);
    if constexpr (SL == 1) phase_p0b(a, lds, bid, nblk, tid);
    if constexpr (SL == 2) { if (l == 1) convert_weights(a, 1, lds, bid * 8 + (tid >> 6), nblk * 8, tid >> 6, tid & 63); phase_norm(a, l, I_NFA, 0, bid, nblk, tid); }
    if constexpr (SL == 3) run_gemm(lds, H, (const bf16_t*)(wb + W_FA_IN), 2 * DFF, D, pg8::EpiSwiGLU{BIG, DFF}, bid, nblk, tid);
    if constexpr (SL == 4) run_gemm(lds, BIG, (const bf16_t*)(wb + W_FA_OUT), D, DFF, pg8::EpiResid{a.out, modl + 2 * 1024, 0.5f}, bid, nblk, tid);
    if constexpr (SL == 5) phase_norm(a, l, I_NMIX, 3, bid, nblk, tid);
    if constexpr (SL == 6) run_gemm(lds, H, (const bf16_t*)(wb + W_IN), NMIX, D, pg8::EpiStore<0>{BIG, NMIX}, bid, nblk, tid);
    if constexpr (SL == 7) { phase_prep(a, l, bid, nblk, tid); prep_diff(a, l, lds, bid, nblk, tid); prep_ret(a, l, lds, bid, nblk, tid); prep_win(a, l, lds, bid, nblk, tid); prep_hy(a, l, lds, bid, nblk, tid); }
    if constexpr (SL == 8) phase_mix(a, l, lds, bid, nblk, tid);
    if constexpr (SL == 9) run_gemm(lds, H, (const bf16_t*)(wb + W_IN) + (size_t)NMIX * D, NGATE, D, pg8::EpiStore<1>{BIG, NGATE}, bid, nblk, tid);
    if constexpr (SL == 10) {
#pragma unroll 1
        for (int b = 0; b < 4; ++b) run_gemm(lds, YBR + (size_t)b * M * 512, (const bf16_t*)(wb + W_BR) + (size_t)b * D * 512, D, 512, pg8::EpiMerge{MERGEP, BIG, H, b * 1024, b == 0 ? 0 : (b == 3 ? 2 : 1)}, bid, nblk, tid); }
    if constexpr (SL == 11) run_gemm(lds, H, (const bf16_t*)(wb + W_OUT), D, D, pg8::EpiResid{a.out, modl + 5 * 1024, 1.0f}, bid, nblk, tid);
    if constexpr (SL == 12) phase_norm(a, l, I_NFB, 6, bid, nblk, tid);
    if constexpr (SL == 13) run_gemm(lds, H, (const bf16_t*)(wb + W_FB_IN), 2 * DFF, D, pg8::EpiSwiGLU{BIG, DFF}, bid, nblk, tid);
    if constexpr (SL == 14) run_gemm(lds, BIG, (const bf16_t*)(wb + W_FB_OUT), D, DFF, pg8::EpiResid{a.out, modl + 8 * 1024, 0.5f}, bid, nblk, tid);
}
template <int SL> __global__ void __launch_bounds__(512, 2) k_slot(Args a) {
    extern __shared__ __attribute__((aligned(16))) unsigned char lds_raw[];
    const Ctx c = make_ctx(a, (LAS unsigned char*)lds_raw, threadIdx.x);
    run_slot<SL>(c, a.ph_lo, (LAS unsigned char*)lds_raw, blockIdx.x, gridDim.x, threadIdx.x);
}

constexpr int CW_BAR = 4096;
__global__ void __launch_bounds__(512, 2) mega(Args a) {
    extern __shared__ __attribute__((aligned(16))) unsigned char lds_raw[];
    LAS unsigned char* lds = (LAS unsigned char*)lds_raw;
    const int tid = threadIdx.x, bid = blockIdx.x, nblk = gridDim.x;
    volatile LAS unsigned* st = (volatile LAS unsigned*)(lds + LDS_ST_OFF);
    const Ctx c = make_ctx(a, lds, tid);
    const XcdBarrier bar = xcd_barrier_post((unsigned*)(a.ws + WS_CTL) + CW_BAR, st);
#define GB() do { XcdBarrier b_ = bar; unsigned long long bp_ = (unsigned long long)b_.bar; unsigned bx_ = b_.x; asm volatile("" : "+s"(bp_), "+s"(bx_)); b_.bar = (unsigned*)bp_; b_.x = bx_; xcd_barrier(b_); } while (0)
#ifndef MEGA_MASK
#define MEGA_MASK 0x7fff
#endif
#ifndef PROBE_DUP
#define PROBE_DUP 0
#endif
#define RS(k) if constexpr ((PROBE_DUP >> k) & 1) { run_slot<k>(c, (k < 2 ? 0 : l_), lds, bid, nblk, tid); GB(); } if constexpr ((MEGA_MASK >> k) & 1) run_slot<k>
    int l_ = 0;
    RS(0)(c, 0, lds, bid, nblk, tid); GB();
    RS(1)(c, 0, lds, bid, nblk, tid); GB();
#pragma unroll 1
    for (int l = 0; l < 2; ++l) { l_ = l;
        RS(2)(c, l, lds, bid, nblk, tid); GB();
        RS(3)(c, l, lds, bid, nblk, tid); GB();
        RS(4)(c, l, lds, bid, nblk, tid); GB();
        RS(5)(c, l, lds, bid, nblk, tid); GB();
        RS(6)(c, l, lds, bid, nblk, tid); GB();
        RS(7)(c, l, lds, bid, nblk, tid); GB();
        RS(8)(c, l, lds, bid, nblk, tid); GB();
        RS(9)(c, l, lds, bid, nblk, tid); GB();
        RS(10)(c, l, lds, bid, nblk, tid); GB();
        RS(11)(c, l, lds, bid, nblk, tid); GB();
        RS(12)(c, l, lds, bid, nblk, tid); GB();
        RS(13)(c, l, lds, bid, nblk, tid); GB();
        RS(14)(c, l, lds, bid, nblk, tid); if (l == 0) GB();
    }
#undef GB
#undef RS
}
template <int SL> static void launch_slot(const Args& a, int grid, hipStream_t stream) {
    static bool attr = false;
    if (!attr) { (void)hipFuncSetAttribute((const void*)k_slot<SL>, hipFuncAttributeMaxDynamicSharedMemorySize, LDS_BYTES); attr = true; }
    hipLaunchKernelGGL(k_slot<SL>, dim3(grid), dim3(512), LDS_BYTES, stream, a);
}

#ifdef DIAG_YBR
__global__ void k_diag(Args a) {
    for (size_t i = (size_t)blockIdx.x * blockDim.x + threadIdx.x; i < (size_t)M * 1024; i += (size_t)gridDim.x * blockDim.x) { const size_t row = i >> 10, c = i & 1023;
#if DIAG_YBR < 4
        const bf16_t* y = (const bf16_t*)(a.ws + WS_YBR) + (size_t)DIAG_YBR * M * 512;
        a.out[i] = bf2f(y[(c >> 9) * (size_t)M * 512 + row * 512 + (c & 511)]);
#elif DIAG_YBR == 4
        a.out[i] = bf2f(((const bf16_t*)(a.ws + WS_H))[i]);
#elif DIAG_YBR >= 5 && DIAG_YBR < 9
        a.out[i] = bf2f(((const bf16_t*)(a.ws + WS_BIG))[row * 4096 + (DIAG_YBR - 5) * 1024 + c]);
#elif DIAG_YBR == 9
        a.out[i] = ((const float*)(a.ws + WS_BIG + 128 * MiB))[i];
#elif DIAG_YBR >= 10 && DIAG_YBR < 15
        a.out[i] = bf2f(((const bf16_t*)(a.ws + WS_BIG))[row * 5376 + (DIAG_YBR - 10) * 1024 + c]);
#elif DIAG_YBR >= 15 && DIAG_YBR < 17
        a.out[i] = bf2f(((const bf16_t*)(a.ws + WS_BIG))[row * 2816 + (DIAG_YBR - 15) * 1024 + c]);
#endif
    }
}
#endif
extern "C" void kernel_launch(void* const* d_in, const int* in_sizes, int n_in, void* d_out, int out_size, void* d_ws, size_t ws_size, hipStream_t stream) {
    static int grid = 0;
    if (grid == 0) {
        if (n_in != N_IN || out_size != (int)O_END || ws_size < WS_END) { fprintf(stderr, "kernel_launch: unexpected shapes: n_in %d out %d ws %zu (need %zu)\n", n_in, out_size, ws_size, (size_t)WS_END); grid = -1; return; }
        int dev = 0, cus = 0;
        if (hipGetDevice(&dev) != hipSuccess || hipDeviceGetAttribute(&cus, hipDeviceAttributeMultiprocessorCount, dev) != hipSuccess) { grid = -1; return; }
        grid = cus > 0 ? cus : 256;
    }
    if (grid < 0) return;
    (void)hipMemsetAsync((char*)d_ws + WS_CTL, 0, CTL_ZERO_BYTES, stream);
    Args a{};
    for (int i = 0; i < N_IN; ++i) a.in[i] = (const float*)d_in[i];
    a.out = (float*)d_out; a.ws = (unsigned char*)d_ws;
    a.ph_lo = 0; a.ph_hi = 0;
#ifndef MULTI_LAUNCH
    { static bool attr = false; if (!attr) { (void)hipFuncSetAttribute((const void*)mega, hipFuncAttributeMaxDynamicSharedMemorySize, LDS_BYTES); attr = true; }
      hipLaunchKernelGGL(mega, dim3(grid), dim3(512), LDS_BYTES, stream, a); return; }
#endif
    int nl = 0;
#ifndef STOP_AFTER
#define STOP_AFTER 1000
#endif
#define LS(k) do { if (nl++ < STOP_AFTER) launch_slot<k>(a, grid, stream); } while (0)
    LS(0); LS(1);
    for (int l = 0; l < 2; ++l) { a.ph_lo = l;
        LS(2); LS(3); LS(4); LS(5); LS(6); LS(7); LS(8); LS(9); LS(10); LS(11); LS(12); LS(13); LS(14); }
#ifdef DIAG_YBR
    hipLaunchKernelGGL(k_diag, dim3(1024), dim3(256), 0, stream, a);
#endif
}
```

```cpp
#include <hip/hip_runtime.h>
#include <cstdio>
#include <cstdint>
namespace pg8 {
#define PG8_LAS __attribute__((address_space(3)))
typedef unsigned short bf16_t;
typedef short bf16x8 __attribute__((ext_vector_type(8)));
typedef float f32x4 __attribute__((ext_vector_type(4)));
typedef unsigned u32x4 __attribute__((ext_vector_type(4)));
constexpr int BM = 256, BK = 64, HALF = 128, HTB = HALF * BK * 2  , STAGE_BYTES = 8 * HTB, NXCD = 8, WGM = 8;

__host__ __device__ __forceinline__ int lds_byte(int r, int c) { const int st = (r >> 4) * 2 + (c >> 5), rr = r & 15, cc = c & 31, ob = rr * 64 + cc * 2; return st * 1024 + (ob ^ (((ob >> 9) & 1) << 5)); }
__host__ __device__ __forceinline__ void stage_rc(int b, int& R, int& C) { const int st = b / 1024, sb = b % 1024, swz = sb ^ (((sb >> 9) & 1) << 5); R = (st >> 1) * 16 + swz / 64; C = (st & 1) * 32 + (swz % 64) / 2; }
__host__ __device__ __forceinline__ int perm32(int rho) { const int n = rho >> 4, i = rho & 15; return 8 * (i >> 2) + 4 * n + (i & 3); }

struct Unit { int pm, pn; };
struct Gemm { const bf16_t* A; const bf16_t* Bt; int M, N, K; };

struct StaticOrder {
    int nM, nN, nwg, G, c;
    __host__ __device__ void init(int M, int N, int G_, int c_) { nM = M / BM; nN = N / BM; nwg = nM * nN; G = G_; c = c_; }
    __host__ __device__ bool next(int i, Unit& u) const {
        const long L = (long)i * G + c; if (L >= nwg) return false;
        int wgid = (int)L; { const int q = nwg / NXCD, r = nwg % NXCD, xcd = wgid % NXCD, off = wgid / NXCD; wgid = (xcd < r ? xcd * (q + 1) : r * (q + 1) + (xcd - r) * q) + off; }
        const int nig = WGM * nN, gid = wgid / nig, fm = gid * WGM, gsz = (nM - fm) < WGM ? (nM - fm) : WGM;
        u.pm = fm + ((wgid % nig) % gsz); u.pn = (wgid % nig) / gsz; return true;
    }
    __device__ __forceinline__ void a_ready(const Unit&) const {}
    __device__ __forceinline__ void done(const Unit&) const {}
};
typedef __bf16 bf16x2n __attribute__((ext_vector_type(2)));
typedef float f32x2n __attribute__((ext_vector_type(2)));
__device__ __forceinline__ unsigned cvt_pk_bf16(float lo, float hi) { f32x2n v = {lo, hi}; bf16x2n b = __builtin_convertvector(v, bf16x2n); return __builtin_bit_cast(unsigned, b); }
typedef float f32x2 __attribute__((ext_vector_type(2)));
typedef unsigned u32x2 __attribute__((ext_vector_type(2)));
__device__ __forceinline__ float fast_sigmoid(float a) { return __builtin_amdgcn_rcpf(1.0f + __expf(-a)); }
__device__ __forceinline__ float bf_lo(unsigned u) { return __uint_as_float(u << 16); }
__device__ __forceinline__ float bf_hi(unsigned u) { return __uint_as_float(u & 0xffff0000u); }

struct EpiSwiGLU {
    static constexpr bool PERM = true, AFTER_DRAIN = false;
    bf16_t* O; int ldo;
    __device__ __forceinline__ void operator()(const f32x4 (&acc)[2][2][4][2], const Unit& u, int wr, int wc, int fr, int fq) const {
        const int row0 = u.pm * BM + wr * 64 + fr, col0 = u.pn * HALF + wc * 32 + 8 * fq;
#pragma unroll
        for (int ai = 0; ai < 2; ++ai)
#pragma unroll
            for (int m = 0; m < 4; ++m) { bf16_t* rowp = O + (size_t)(row0 + ai * HALF + m * 16) * ldo + col0;
                f32x4 v0, v1;
#pragma unroll
                for (int j = 0; j < 4; ++j) { const float a0 = acc[ai][0][m][0][j], a1 = acc[ai][0][m][1][j];
                    v0[j] = a0 * fast_sigmoid(a0) * acc[ai][1][m][0][j]; v1[j] = a1 * fast_sigmoid(a1) * acc[ai][1][m][1][j]; }
                u32x4 w; w.x = cvt_pk_bf16(v0[0], v0[1]); w.y = cvt_pk_bf16(v0[2], v0[3]); w.z = cvt_pk_bf16(v1[0], v1[1]); w.w = cvt_pk_bf16(v1[2], v1[3]);
                *(u32x4*)rowp = w; }
    }
};
struct EpiResid {
    static constexpr bool PERM = false, AFTER_DRAIN = false;
    float* X; const float* S0; const float* S1; const float* gate; float coef;
    __device__ __forceinline__ void operator()(const f32x4 (&acc)[2][2][4][2], const Unit& u, int wr, int wc, int fr, int fq) const {
        const int row0 = u.pm * BM + wr * 64 + fr, col0 = u.pn * BM + wc * 32 + 4 * fq;
        const int mr = u.pm < 32 ? 0 : 1 + ((u.pm - 32) >> 2);
        const float* gp = gate + (size_t)mr * 9216 + col0;
        f32x4 gv[2][2];
#pragma unroll
        for (int bj = 0; bj < 2; ++bj)
#pragma unroll
            for (int n = 0; n < 2; ++n) gv[bj][n] = *(const f32x4*)(gp + bj * HALF + n * 16) * coef;
#pragma unroll
        for (int ai = 0; ai < 2; ++ai)
#pragma unroll
            for (int m = 0; m < 4; ++m) { const int row = row0 + ai * HALF + m * 16; float* rowp = X + (size_t)row * 1024 + col0;
                const float* srcp = (u.pm < 32 ? S0 + (size_t)row * 1024 : S1 + (size_t)(row - 8192) * 1024) + col0;
#pragma unroll
                for (int bj = 0; bj < 2; ++bj)
#pragma unroll
                    for (int n = 0; n < 2; ++n) *(f32x4*)(rowp + bj * HALF + n * 16) = *(const f32x4*)(srcp + bj * HALF + n * 16) + gv[bj][n] * acc[ai][bj][m][n]; }
    }
};
template <int ACT> struct EpiStore {
    static constexpr bool PERM = true, AFTER_DRAIN = false;
    bf16_t* O; int ldo;
    __device__ __forceinline__ void operator()(const f32x4 (&acc)[2][2][4][2], const Unit& u, int wr, int wc, int fr, int fq) const {
        const int row0 = u.pm * BM + wr * 64 + fr, col0 = u.pn * BM + wc * 32 + 8 * fq;
#pragma unroll
        for (int ai = 0; ai < 2; ++ai)
#pragma unroll
            for (int m = 0; m < 4; ++m) { bf16_t* rowp = O + (size_t)(row0 + ai * HALF + m * 16) * ldo + col0;
#pragma unroll
                for (int bj = 0; bj < 2; ++bj) { f32x4 v0 = acc[ai][bj][m][0], v1 = acc[ai][bj][m][1];
                    if (ACT == 1) {
#pragma unroll
                        for (int j = 0; j < 4; ++j) { v0[j] = fast_sigmoid(v0[j]); v1[j] = fast_sigmoid(v1[j]); } }
                    u32x4 w; w.x = cvt_pk_bf16(v0[0], v0[1]); w.y = cvt_pk_bf16(v0[2], v0[3]); w.z = cvt_pk_bf16(v1[0], v1[1]); w.w = cvt_pk_bf16(v1[2], v1[3]);
                    *(u32x4*)(rowp + bj * HALF) = w; } }
    }
};
struct EpiMerge {
    static constexpr bool PERM = false, AFTER_DRAIN = false;
    const bf16_t* G; bf16_t* O;
    __device__ __forceinline__ void operator()(const f32x4 (&acc)[2][2][4][2], const Unit& u, int wr, int wc, int fr, int fq) const {
        const int b = u.pn >> 2, pn = u.pn & 3, pm = u.pm & 63;
        const int row0 = pm * BM + wr * 64 + fr, col0 = pn * BM + wc * 32 + 4 * fq;
#pragma unroll
        for (int ai = 0; ai < 2; ++ai)
#pragma unroll
            for (int m = 0; m < 4; ++m) { const size_t r = (size_t)(row0 + ai * HALF + m * 16);
#pragma unroll
                for (int bj = 0; bj < 2; ++bj)
#pragma unroll
                    for (int n = 0; n < 2; ++n) { const int c = col0 + bj * HALF + n * 16;
                        const u32x2 gw = *(const u32x2*)(G + r * 4096 + b * 1024 + c);
                        f32x4 g; g[0] = bf_lo(gw.x); g[1] = bf_hi(gw.x); g[2] = bf_lo(gw.y); g[3] = bf_hi(gw.y);
                        f32x4 v = g * acc[ai][bj][m][n];
                        u32x2* pp = (u32x2*)(O + r * 1024 + c);
                        if (b != 0) { const u32x2 pw = *pp; v[0] += bf_lo(pw.x); v[1] += bf_hi(pw.x); v[2] += bf_lo(pw.y); v[3] += bf_hi(pw.y); }
                        u32x2 w; w.x = cvt_pk_bf16(v[0], v[1]); w.y = cvt_pk_bf16(v[2], v[3]); *pp = w; } }
    }
};
struct MergeOrder {
    StaticOrder base;
    __host__ __device__ void init(int M_, int G_, int c_) { base.init(M_, 1024, G_, c_); }
    __host__ __device__ bool next(int i, Unit& u) const { Unit u0; if (!base.next(i >> 2, u0)) return false; const int b = i & 3; u.pm = u0.pm + 64 * b; u.pn = u0.pn + 4 * b; return true; }
    __device__ __forceinline__ void a_ready(const Unit&) const {}
    __device__ __forceinline__ void done(const Unit&) const {}
};
template <class Epi, class Sched, bool STAMP = false>
__device__ __forceinline__ void gemm_phase(PG8_LAS unsigned char* lds, const Gemm g, const Sched& S, const Epi& E, unsigned long long* stamps, const int tid) {
    const int wid = __builtin_amdgcn_readfirstlane(tid >> 6), lane = tid & 63, wr = wid >> 2, wc = wid & 3, fr = lane & 15, fq = lane >> 4;
    const int K = g.K, nt = K / BK;
    int ts_lo = 0, ts_hi = 0, nts = 0; const unsigned long long rt_entry = STAMP ? (unsigned long long)wall_clock64() : 0ull;
#define PG8_STAMP() do { if (STAMP && wid == 0 && nts < 64) { const unsigned long long _c = (unsigned long long)clock64(); \
        ts_lo = (lane == nts) ? (int)(unsigned)_c : ts_lo; ts_hi = (lane == nts) ? (int)(unsigned)(_c >> 32) : ts_hi; ++nts; } } while (0)
    PG8_STAMP();
    unsigned voffA[2], voffB[2];
#pragma unroll
    for (int i = 0; i < 2; ++i) { int R, C; stage_rc(tid * 16 + i * 8192, R, C); const int Rb = Epi::PERM ? ((R & ~31) + perm32(R & 31)) : R;
        voffA[i] = (unsigned)(R * K + C) * 2u; voffB[i] = (unsigned)(Rb * K + C) * 2u; }
    const size_t kstep = (size_t)(BK * 2);
    const size_t hstep = (size_t)HALF * K * 2;
    const size_t tstep = 2 * hstep;
    const unsigned ldsw = (unsigned)wid * 1024u;
    const int aoff = lds_byte(wr * 64 + fr, fq * 8), boff = lds_byte(wc * 32 + fr, fq * 8);
#define PG8_SA(b, h) (((b) * 2 + (h)) * HTB)
#define PG8_SB(b, h) ((4 + (b) * 2 + (h)) * HTB)
#define PG8_STAGE(bufoff, gbase, voff) do { _Pragma("unroll") for (int _i = 0; _i < 2; ++_i) \
        __builtin_amdgcn_global_load_lds((const unsigned*)((const char*)(gbase) + (voff)[_i]), (PG8_LAS unsigned*)(lds + (bufoff) + ldsw + _i * 8192), 16, 0, 0); } while (0)
#define PG8_LDA(dst, b, h) do { _Pragma("unroll") for (int m = 0; m < 4; ++m) _Pragma("unroll") for (int k = 0; k < 2; ++k) dst[m][k] = *(const PG8_LAS bf16x8*)(lds + PG8_SA(b, h) + aoff + m * 2048 + k * 1024); } while (0)
#define PG8_LDB(dst, b, h) do { _Pragma("unroll") for (int n = 0; n < 2; ++n) _Pragma("unroll") for (int k = 0; k < 2; ++k) dst[n][k] = *(const PG8_LAS bf16x8*)(lds + PG8_SB(b, h) + boff + n * 2048 + k * 1024); } while (0)
#define PG8_MMA(ai, bj, At, Bt) do { __builtin_amdgcn_s_setprio(1); _Pragma("unroll") for (int m = 0; m < 4; ++m) _Pragma("unroll") for (int n = 0; n < 2; ++n) _Pragma("unroll") for (int k = 0; k < 2; ++k) \
        acc[ai][bj][m][n] = __builtin_amdgcn_mfma_f32_16x16x32_bf16(Bt[n][k], At[m][k], acc[ai][bj][m][n], 0, 0, 0); __builtin_amdgcn_s_setprio(0); } while (0)
#define PG8_WAIT_V(n) asm volatile("s_waitcnt vmcnt(" #n ")" ::: "memory")
#define PG8_WAIT_L(n) asm volatile("s_waitcnt lgkmcnt(" #n ")" ::: "memory")
#define PG8_BAR __builtin_amdgcn_s_barrier()
#define PG8_SCHED __builtin_amdgcn_sched_barrier(0)
    Unit cur, nxt; int ui = 0;
    if (!S.next(0, cur)) return;
    f32x4 acc[2][2][4][2];
#pragma unroll
    for (int a = 0; a < 2; ++a)
#pragma unroll
        for (int b = 0; b < 2; ++b)
#pragma unroll
            for (int m = 0; m < 4; ++m)
#pragma unroll
                for (int n = 0; n < 2; ++n) acc[a][b][m][n] = (f32x4){0.f, 0.f, 0.f, 0.f};
    bf16x8 At[4][2], B0[2][2], B1[2][2];
    const char* cA = (const char*)g.A + (size_t)cur.pm * tstep; const char* cB = (const char*)g.Bt + (size_t)cur.pn * tstep;
    S.a_ready(cur);
    PG8_STAGE(PG8_SB(0, 0), cB, voffB); PG8_STAGE(PG8_SA(0, 0), cA, voffA); PG8_STAGE(PG8_SB(0, 1), cB + hstep, voffB); PG8_STAGE(PG8_SA(0, 1), cA + hstep, voffA);
    if (wr == 1) PG8_BAR;
    PG8_WAIT_V(4); PG8_BAR;
    PG8_STAGE(PG8_SB(1, 0), cB + kstep, voffB); PG8_STAGE(PG8_SA(1, 0), cA + kstep, voffA); PG8_STAGE(PG8_SB(1, 1), cB + hstep + kstep, voffB);
    PG8_WAIT_V(6); PG8_BAR;
    PG8_STAMP();
    for (;;) {
        const bool has_next = S.next(ui + 1, nxt);
        const char* nA = has_next ? (const char*)g.A + (size_t)nxt.pm * tstep : cA; const char* nB = has_next ? (const char*)g.Bt + (size_t)nxt.pn * tstep : cB;
        for (int t = 0; t < nt; t += 2) {
            const bool last = (t == nt - 2);
            const char* a1 = cA + (size_t)(t + 1) * kstep;
            const char* a2 = last ? nA : cA + (size_t)(t + 2) * kstep; const char* b2 = last ? nB : cB + (size_t)(t + 2) * kstep;
            const char* a3 = a2 + kstep; const char* b3 = b2 + kstep;
            if (last && has_next) S.a_ready(nxt);
            PG8_LDB(B0, 0, 0); PG8_SCHED; PG8_LDA(At, 0, 0); PG8_STAGE(PG8_SA(1, 1), a1 + hstep, voffA);
            PG8_WAIT_L(8); PG8_BAR; PG8_WAIT_L(0); PG8_MMA(0, 0, At, B0); PG8_BAR; PG8_SCHED;
            PG8_LDB(B1, 0, 1); PG8_STAGE(PG8_SB(0, 0), b2, voffB);
            PG8_BAR; PG8_WAIT_L(0); PG8_MMA(0, 1, At, B1); PG8_BAR;
            PG8_LDA(At, 0, 1); PG8_STAGE(PG8_SA(0, 0), a2, voffA);
            PG8_BAR; PG8_WAIT_L(0); PG8_MMA(1, 0, At, B0); PG8_BAR; PG8_SCHED;
            PG8_STAGE(PG8_SB(0, 1), b2 + hstep, voffB);
            PG8_WAIT_V(6); PG8_BAR; PG8_MMA(1, 1, At, B1); PG8_BAR;
            PG8_LDB(B0, 1, 0); PG8_SCHED; PG8_LDA(At, 1, 0); PG8_STAGE(PG8_SA(0, 1), a2 + hstep, voffA);
            PG8_WAIT_L(8); PG8_BAR; PG8_WAIT_L(0); PG8_MMA(0, 0, At, B0); PG8_BAR; PG8_SCHED;
            PG8_LDB(B1, 1, 1); PG8_STAGE(PG8_SB(1, 0), b3, voffB);
            PG8_BAR; PG8_WAIT_L(0); PG8_MMA(0, 1, At, B1); PG8_BAR;
            PG8_LDA(At, 1, 1); PG8_STAGE(PG8_SA(1, 0), a3, voffA);
            PG8_BAR; PG8_WAIT_L(0); PG8_MMA(1, 0, At, B0); PG8_BAR; PG8_SCHED;
            PG8_STAGE(PG8_SB(1, 1), b3 + hstep, voffB);
            PG8_WAIT_V(6); PG8_BAR; PG8_MMA(1, 1, At, B1); PG8_BAR;
        }
        PG8_STAMP();
        if constexpr (!Epi::AFTER_DRAIN) { E(acc, cur, wr, wc, fr, fq); S.done(cur); }
        PG8_STAMP();
        if (!has_next) break;
#pragma unroll
        for (int a = 0; a < 2; ++a)
#pragma unroll
            for (int b = 0; b < 2; ++b)
#pragma unroll
                for (int m = 0; m < 4; ++m)
#pragma unroll
                    for (int n = 0; n < 2; ++n) acc[a][b][m][n] = (f32x4){0.f, 0.f, 0.f, 0.f};
        cur = nxt; cA = nA; cB = nB; ++ui;
    }
    PG8_WAIT_V(0);
    if (wr == 0) PG8_BAR;
    PG8_BAR;
    if constexpr (Epi::AFTER_DRAIN) { E.fused(acc, cur, wr, wc, fr, fq, lds, wid, lane); S.done(cur); }
    PG8_STAMP();
    if (STAMP && wid == 0) { stamps[lane] = lane < nts ? (((unsigned long long)(unsigned)ts_hi << 32) | (unsigned)ts_lo) : 0ull;
        if (lane == 62) stamps[62] = rt_entry; if (lane == 63) stamps[63] = (unsigned long long)wall_clock64(); }
#undef PG8_STAMP
#undef PG8_SA
#undef PG8_SB
#undef PG8_STAGE
#undef PG8_LDA
#undef PG8_LDB
#undef PG8_MMA
#undef PG8_WAIT_V
#undef PG8_WAIT_L
#undef PG8_BAR
#undef PG8_SCHED
}
}
#define LAS __attribute__((address_space(3)))
typedef pg8::bf16_t bf16_t;
typedef pg8::f32x4 f32x4;
typedef pg8::u32x4 u32x4;
typedef pg8::u32x2 u32x2;
using pg8::bf_lo; using pg8::bf_hi; using pg8::cvt_pk_bf16;
constexpr int D = 1024, M = 16384, DFF = 2816, NMIX = 5376, NGATE = 4096;
constexpr float EPS = 1e-6f;
constexpr int C_HY = 0, C_DQ = 1536, C_DK = 2048, C_DV = 2560, C_WQ = 3072, C_WK = 3584, C_WV = 3712, C_RQ = 3840, C_RK = 4096, C_RV = 4352, C_RG = 4864;
constexpr size_t O_DK = 16777216, O_DV = 25165824, O_WK = 33554432, O_WV = 35651584, O_RF = 37748736, O_RB = 39845888, O_END = 41943040;
constexpr size_t MiB = 1u << 20;
constexpr size_t WS_CTL = 0, CTL_ZERO_BYTES = 1 * MiB;
constexpr size_t WS_MODP = 1 * MiB, WS_MOD = 7 * MiB, WS_Z2 = 8 * MiB, WS_FILT = 9 * MiB, WS_W = 20 * MiB, WS_H = 78 * MiB, WS_BIG = 110 * MiB, WS_YBR = 302 * MiB, WS_ZB = 366 * MiB, WS_END = 398 * MiB;
constexpr size_t WS_KDC = 1 * MiB, WS_KWC = 5 * MiB, WS_ST = 6 * MiB;
constexpr size_t WS_KTR = 9 * MiB;
constexpr size_t WS_GRT = 403 * MiB;
constexpr size_t WS_VTWL = 398 * MiB, WS_VTWC = 401 * MiB;
constexpr size_t WS_VTRL = 382 * MiB, WS_VTRC = 390 * MiB;
constexpr size_t WS_VTDL = WS_BIG + 168 * MiB, WS_VTDC = WS_VTDL + 12 * MiB;
constexpr size_t W_FA_IN = 0, W_FA_OUT = 11534336, W_FB_IN = 17301504, W_FB_OUT = 28835840, W_IN = 34603008, W_BR = 54001664, W_OUT = 58195968, W_END = 60293120;
static_assert(WS_W + W_END <= WS_H, "weights fit");
constexpr int NPHASE = 28;
enum InIdx { I_XP = 0, I_XS, I_C, I_CDK, I_CDV, I_CWK, I_CWV, I_SRF, I_SRB, I_CCTX, I_NFA, I_NMIX, I_NFB, I_WADA, I_BADA, I_WFAI, I_WFAO, I_WFBI, I_WFBO, I_WIN, I_HCW, I_HCB,
             I_HW1, I_HB1, I_HW2, I_HB2, I_HW3, I_HSKIP, I_DQN, I_DKN, I_DLAM, I_DSUB, I_WQN, I_WKN, I_WSINK, I_RDF, I_RDB, I_WBR, I_WOUT, N_IN };
struct Args { const float* in[N_IN]; float* out; unsigned char* ws; int ph_lo, ph_hi; };
struct Ctx { const LAS unsigned long long* tab; float* out; unsigned char* ws; };
constexpr int LDS_BYTES = 147456;
constexpr int LDS_TAB_OFF = LDS_BYTES - 1024, LDS_ST_OFF = LDS_BYTES - 64;
__device__ __forceinline__ const float* inp(const Ctx& c, int i) { const unsigned long long v = c.tab[i];
    const unsigned lo = __builtin_amdgcn_readfirstlane((unsigned)v), hi = __builtin_amdgcn_readfirstlane((unsigned)(v >> 32)); return (const float*)(const __attribute__((address_space(1))) float*)(((unsigned long long)hi << 32) | lo); }
__device__ __forceinline__ Ctx make_ctx(const Args& a, LAS unsigned char* lds, int tid) {
    LAS unsigned long long* tab = (LAS unsigned long long*)(lds + LDS_TAB_OFF);
    if (tid < N_IN) tab[tid] = (unsigned long long)a.in[tid];
    if (tid >= 64 && tid < 80) ((LAS unsigned*)(lds + LDS_ST_OFF))[tid - 64] = 0u;
    __syncthreads();
    Ctx c; c.tab = tab; c.out = a.out; c.ws = a.ws; return c; }


#define LDS_WAIT() asm volatile("s_waitcnt lgkmcnt(0)" ::: "memory")
template <int MASK> __device__ __forceinline__ float shx(float v) {
    if constexpr (MASK < 32) return __builtin_bit_cast(float, __builtin_amdgcn_ds_swizzle(__builtin_bit_cast(int, v), 0x1f | (MASK << 10)));
    else { const unsigned u = __builtin_bit_cast(unsigned, v); auto r = __builtin_amdgcn_permlane32_swap(u, u, false, false);
        return __builtin_bit_cast(float, (threadIdx.x & 32) ? r[0] : r[1]); }
}
__device__ __forceinline__ float wave_sum(float v) { v += shx<1>(v); v += shx<2>(v); v += shx<4>(v); v += shx<8>(v); v += shx<16>(v); v += shx<32>(v); return v; }
__device__ __forceinline__ unsigned f2bf(float f) { unsigned u = __float_as_uint(f); return (u + 0x7fffu + ((u >> 16) & 1u)) >> 16; }
__device__ __forceinline__ unsigned pk2(float lo, float hi) { return cvt_pk_bf16(lo, hi); }
__device__ __forceinline__ float bf2f(bf16_t b) { return __uint_as_float(((unsigned)b) << 16); }

__device__ __forceinline__ void ld64bf(const bf16_t* p, float (&x)[64]) {
    const uint4* q = (const uint4*)p;
#pragma unroll
    for (int i = 0; i < 8; ++i) { const uint4 u = q[i]; x[8 * i + 0] = bf_lo(u.x); x[8 * i + 1] = bf_hi(u.x); x[8 * i + 2] = bf_lo(u.y); x[8 * i + 3] = bf_hi(u.y);
        x[8 * i + 4] = bf_lo(u.z); x[8 * i + 5] = bf_hi(u.z); x[8 * i + 6] = bf_lo(u.w); x[8 * i + 7] = bf_hi(u.w); }
}
__device__ __forceinline__ void st64bf(bf16_t* p, const float (&x)[64]) {
    uint4* q = (uint4*)p;
#pragma unroll
    for (int i = 0; i < 8; ++i) { uint4 u; u.x = pk2(x[8 * i + 0], x[8 * i + 1]); u.y = pk2(x[8 * i + 2], x[8 * i + 3]); u.z = pk2(x[8 * i + 4], x[8 * i + 5]); u.w = pk2(x[8 * i + 6], x[8 * i + 7]); q[i] = u; }
}
__device__ __forceinline__ float dot64bf(const bf16_t* p, const float (&q)[64]) {
    const uint4* r = (const uint4*)p; float s0 = 0.f, s1 = 0.f, s2 = 0.f, s3 = 0.f;
#pragma unroll
    for (int i = 0; i < 8; ++i) { const uint4 u = r[i];
        s0 += bf_lo(u.x) * q[8 * i + 0]; s1 += bf_hi(u.x) * q[8 * i + 1]; s2 += bf_lo(u.y) * q[8 * i + 2]; s3 += bf_hi(u.y) * q[8 * i + 3];
        s0 += bf_lo(u.z) * q[8 * i + 4]; s1 += bf_hi(u.z) * q[8 * i + 5]; s2 += bf_lo(u.w) * q[8 * i + 6]; s3 += bf_hi(u.w) * q[8 * i + 7]; }
    return (s0 + s1) + (s2 + s3);
}
__device__ __forceinline__ float dot64f(const float* p, const float (&q)[64]) {
    const float4* r = (const float4*)p; float s0 = 0.f, s1 = 0.f, s2 = 0.f, s3 = 0.f;
#pragma unroll
    for (int i = 0; i < 16; ++i) { const float4 u = r[i]; s0 += u.x * q[4 * i + 0]; s1 += u.y * q[4 * i + 1]; s2 += u.z * q[4 * i + 2]; s3 += u.w * q[4 * i + 3]; }
    return (s0 + s1) + (s2 + s3);
}
__device__ __forceinline__ void axpy64bf(float a, const bf16_t* p, float (&acc)[64]) {
    const uint4* r = (const uint4*)p;
#pragma unroll
    for (int i = 0; i < 8; ++i) { const uint4 u = r[i];
        acc[8 * i + 0] += a * bf_lo(u.x); acc[8 * i + 1] += a * bf_hi(u.x); acc[8 * i + 2] += a * bf_lo(u.y); acc[8 * i + 3] += a * bf_hi(u.y);
        acc[8 * i + 4] += a * bf_lo(u.z); acc[8 * i + 5] += a * bf_hi(u.z); acc[8 * i + 6] += a * bf_lo(u.w); acc[8 * i + 7] += a * bf_hi(u.w); }
}
__device__ __forceinline__ void axpy64f(float a, const float* p, float (&acc)[64]) {
    const float4* r = (const float4*)p;
#pragma unroll
    for (int i = 0; i < 16; ++i) { const float4 u = r[i]; acc[4 * i + 0] += a * u.x; acc[4 * i + 1] += a * u.y; acc[4 * i + 2] += a * u.z; acc[4 * i + 3] += a * u.w; }
}
#define ONLINE_UPDATE(s, AXPY) do { if ((s) > m) { const float f_ = __expf(m - (s)); lsum *= f_; _Pragma("unroll") for (int i_ = 0; i_ < 64; ++i_) acc[i_] *= f_; m = (s); } \
    const float p_ = __expf((s) - m); lsum += p_; AXPY; } while (0)

__device__ __forceinline__ void transpose_item(const float* W, int K, int N, bf16_t* WT, bool swi, LAS float* scr, int item, int lane) {
    const int nblk = N / 64, kb = item / nblk, nb = item % nblk, k0 = 64 * kb, d0 = 64 * nb;
    int n0 = d0;
    if (swi) { const int tile = d0 >> 8, w = d0 & 255; n0 = (w < 128) ? (tile * 128 + w) : (DFF + tile * 128 + (w - 128)); }
    const int lr = lane >> 4, lc = (lane & 15) * 4;
#pragma unroll 4
    for (int i = 0; i < 16; ++i) { const int kk = 4 * i + lr; const float4 u = *(const float4*)(W + (size_t)(k0 + kk) * N + n0 + lc);
        LAS float* d = scr + kk * 65 + lc; d[0] = u.x; d[1] = u.y; d[2] = u.z; d[3] = u.w; }
    LDS_WAIT(); asm volatile("" ::: "memory");
    const int c = lane & 7;
#pragma unroll
    for (int j = 0; j < 8; ++j) { const int n = (lane >> 3) + 8 * j; const LAS float* s = scr + (8 * c) * 65 + n;
        uint4 o; o.x = pk2(s[0 * 65], s[1 * 65]); o.y = pk2(s[2 * 65], s[3 * 65]); o.z = pk2(s[4 * 65], s[5 * 65]); o.w = pk2(s[6 * 65], s[7 * 65]);
        *(uint4*)(WT + (size_t)(d0 + n) * K + k0 + 8 * c) = o; }
    LDS_WAIT(); asm volatile("" ::: "memory");
}
__device__ __forceinline__ void convert_weights(const Ctx& a, int l, int part, LAS unsigned char* lds, int gw, int NGW, int wave, int lane) {
    LAS float* scr = (LAS float*)(lds + wave * 16640);
    unsigned char* wb = a.ws + WS_W;
    constexpr int I0 = 16 * 88, I1 = 44 * 16, I4A = 16 * 84, I4B = 16 * 64, I5 = 8 * 16, I9 = 16 * 16;
    if (part == 0) {
#pragma unroll 1
        for (int it = gw; it < I0 + I1 + I4A; it += NGW) { int r = it;
            if (r < I0) { transpose_item(inp(a, I_WFAI) + (size_t)l * D * 2 * DFF, D, 2 * DFF, (bf16_t*)(wb + W_FA_IN), true, scr, r, lane); continue; } r -= I0;
            if (r < I1) { transpose_item(inp(a, I_WFAO) + (size_t)l * DFF * D, DFF, D, (bf16_t*)(wb + W_FA_OUT), false, scr, r, lane); continue; } r -= I1;
            transpose_item(inp(a, I_WIN) + (size_t)l * D * 9472, D, 9472, (bf16_t*)(wb + W_IN), false, scr, (r / 84) * 148 + (r % 84), lane); }
    } else {
#pragma unroll 1
        for (int it = gw; it < I4B + 4 * I5 + I9 + I0 + I1; it += NGW) { int r = it;
            if (r < I4B) { transpose_item(inp(a, I_WIN) + (size_t)l * D * 9472, D, 9472, (bf16_t*)(wb + W_IN), false, scr, (r / 64) * 148 + 84 + (r % 64), lane); continue; } r -= I4B;
            if (r < 4 * I5) { const int b = r / I5; transpose_item(inp(a, I_WBR) + ((size_t)l * 4 + b) * 512 * D, 512, D, (bf16_t*)(wb + W_BR) + (size_t)b * D * 512, false, scr, r % I5, lane); continue; } r -= 4 * I5;
            if (r < I9) { transpose_item(inp(a, I_WOUT) + (size_t)l * D * D, D, D, (bf16_t*)(wb + W_OUT), false, scr, r, lane); continue; } r -= I9;
            if (r < I0) { transpose_item(inp(a, I_WFBI) + (size_t)l * D * 2 * DFF, D, 2 * DFF, (bf16_t*)(wb + W_FB_IN), true, scr, r, lane); continue; } r -= I0;
            transpose_item(inp(a, I_WFBO) + (size_t)l * DFF * D, DFF, D, (bf16_t*)(wb + W_FB_OUT), false, scr, r, lane); }
    }
}
__device__ __forceinline__ void phase_p0a(const Ctx& a, LAS unsigned char* lds, int bid, int nblk, int tid) {
    const int lane = tid & 63, wave = tid >> 6, gtid = bid * 512 + tid, NT = nblk * 512;
    { LAS float* sc = (LAS float*)lds;
      for (int i = tid; i < 9216; i += 512) { const int r = i >> 10, k = i & 1023; const float v = r == 0 ? inp(a, I_CCTX)[k] : inp(a, I_C)[(r - 1) * 1024 + k]; sc[i] = v / (1.0f + expf(-v)); }
      __syncthreads();
      float* modp = (float*)(a.ws + WS_MODP);
      for (int idx = gtid; idx < 2 * 8 * 9216; idx += NT) { const int n = idx % 9216, kc = (idx / 9216) % 8, l = idx / (9216 * 8);
          const float* w = inp(a, I_WADA) + ((size_t)l * 1024 + kc * 128) * 9216 + n; float acc[9];
#pragma unroll
          for (int r = 0; r < 9; ++r) acc[r] = 0.f;
          for (int k = 0; k < 128; ++k) { const float wv = w[(size_t)k * 9216];
#pragma unroll
              for (int r = 0; r < 9; ++r) acc[r] += sc[r * 1024 + kc * 128 + k] * wv; }
#pragma unroll
          for (int r = 0; r < 9; ++r) modp[((size_t)(l * 8 + kc) * 9 + r) * 9216 + n] = acc[r]; }
      __syncthreads(); }
    { LAS float* fe = (LAS float*)lds; LAS float* z1 = fe + 8 * 33; float* z2g = (float*)(a.ws + WS_Z2);
      for (int it = bid; it < 320; it += nblk) { const int l = it / 160, tg = it % 160, tt = tid >> 6, j = tid & 63, tglob = tg * 8 + tt;
          const int L = tglob < 256 ? 256 : 1024, tpos = tglob < 256 ? tglob : tglob - 256; const float tf = (float)tpos / (float)L;
          if (j < 33) { float v; if (j == 0) v = tf; else if (j <= 16) v = sinf((6.2831853071795864769f * tf) * (float)j); else v = cosf((6.2831853071795864769f * tf) * (float)(j - 16)); fe[tt * 33 + j] = v; }
          __syncthreads();
          float s = inp(a, I_HB1)[l * 64 + j];
          for (int i = 0; i < 33; ++i) s += fe[tt * 33 + i] * inp(a, I_HW1)[(l * 33 + i) * 64 + j];
          z1[tt * 64 + j] = sinf(s);
          __syncthreads();
          float s2 = inp(a, I_HB2)[l * 64 + j];
          for (int i = 0; i < 64; ++i) s2 += z1[tt * 64 + i] * inp(a, I_HW2)[(l * 64 + i) * 64 + j];
          z2g[((size_t)l * 1280 + tglob) * 64 + j] = sinf(s2);
          __syncthreads(); } }
    convert_weights(a, 0, 0, lds, bid * 8 + wave, nblk * 8, wave, lane);
}
__device__ __forceinline__ void phase_p0b(const Ctx& a, LAS unsigned char* lds, int bid, int nblk, int tid) {
    const int gtid = bid * 512 + tid, NT = nblk * 512;
    { const float* modp = (const float*)(a.ws + WS_MODP); float* mod = (float*)(a.ws + WS_MOD);
      for (int idx = gtid; idx < 2 * 9 * 9216; idx += NT) { const int n = idx % 9216, r = (idx / 9216) % 9, l = idx / (9216 * 9); float s = inp(a, I_BADA)[l * 9216 + n];
#pragma unroll
          for (int kc = 0; kc < 8; ++kc) s += modp[((size_t)(l * 8 + kc) * 9 + r) * 9216 + n];
          mod[idx] = s; } }
    { LAS float* red = (LAS float*)lds; const float* z2g = (const float*)(a.ws + WS_Z2); float* filt = (float*)(a.ws + WS_FILT);
      const float dmin = logf(0.01f) / 1.5f, dmax = logf(0.01f) / 0.3f;
      for (int it = bid; it < 128; it += nblk) { const int l = it >> 6, ls = (it >> 5) & 1, cg = it & 31, ci = tid & 15, tl = tid >> 4, c = cg * 16 + ci;
          const int L = ls ? 1024 : 256, toff = ls ? 256 : 0; float* G = filt + (size_t)l * (2560 * 512) + (ls ? 512 * 512 : 0);
          const float ad = fabsf(dmin + (dmax - dmin) * ((float)c / 511.0f)); const float* w3 = inp(a, I_HW3) + (size_t)l * 64 * 1024;
          float asum = 0.f;
          for (int t = tl; t < L; t += 32) { const float* zp = z2g + ((size_t)l * 1280 + toff + t) * 64; float zf = 0.f, zb = 0.f;
              for (int j = 0; j < 64; ++j) { const float z = zp[j]; zf += z * w3[j * 1024 + c]; zb += z * w3[j * 1024 + 512 + c]; }
              const float win = expf(-((float)t / (float)L) * ad); const float hf = zf * win, hb = zb * win; asum += fabsf(hf) + fabsf(hb);
              G[(size_t)(L - 1 + t) * 512 + c] = hf; if (t >= 1) G[(size_t)(L - 1 - t) * 512 + c] = hb; }
          red[tl * 16 + ci] = asum; __syncthreads();
          float tot = 0.f;
          for (int i = 0; i < 32; ++i) tot += red[i * 16 + ci];
          const float inv = 1.0f / tot;
          bf16_t* GT = (bf16_t*)(a.ws + WS_GRT) + (size_t)l * (512 * 2560) + (ls ? 512 * 512 : 0) + (size_t)c * (2 * L);
          for (int t = tl; t < L; t += 32) { const float hf = G[(size_t)(L - 1 + t) * 512 + c] * inv; G[(size_t)(L - 1 + t) * 512 + c] = hf; GT[L - 1 - t] = (bf16_t)f2bf(hf);
              if (t >= 1) { const float hb = G[(size_t)(L - 1 - t) * 512 + c] * inv; G[(size_t)(L - 1 - t) * 512 + c] = hb; GT[L - 1 + t] = (bf16_t)f2bf(hb); } }
          if (tl == 0) GT[2 * L - 1] = 0;
          __syncthreads(); } }
}
__device__ __forceinline__ void phase_norm(const Ctx& a, int l, int gidx  , int sidx  , int bid, int nblk, int tid, bool from_inputs = false) {
    const int lane = tid & 63, gw = bid * 8 + (tid >> 6), NGW = nblk * 8;
    const float* gain = inp(a, gidx) + l * 1024; const float* modl = (const float*)(a.ws + WS_MOD) + (size_t)l * 9 * 9216; bf16_t* H = (bf16_t*)(a.ws + WS_H);
    for (int row = gw; row < M; row += NGW) { const int r = row < 8192 ? 0 : 1 + ((row - 8192) >> 10);
        const float* xrow = from_inputs ? (row < 8192 ? inp(a, I_XP) + (size_t)row * 1024 : inp(a, I_XS) + (size_t)(row - 8192) * 1024) : a.out + (size_t)row * 1024;
        const f32x4* xr = (const f32x4*)xrow + lane; f32x4 v[4]; float ss = 0.f;
#pragma unroll
        for (int j = 0; j < 4; ++j) { v[j] = xr[64 * j]; ss += (v[j].x * v[j].x + v[j].y * v[j].y) + (v[j].z * v[j].z + v[j].w * v[j].w); }
        const float rstd = 1.0f / sqrtf(wave_sum(ss) * (1.0f / 1024.0f) + EPS);
#pragma unroll
        for (int j = 0; j < 4; ++j) { const int col = 4 * lane + 256 * j; const f32x4 g = *(const f32x4*)(gain + col), sh = *(const f32x4*)(modl + (size_t)r * 9216 + sidx * 1024 + col), sc = *(const f32x4*)(modl + (size_t)r * 9216 + (sidx + 1) * 1024 + col);
            const f32x4 y = (v[j] * rstd) * g; const f32x4 h = y * (sc + 1.0f) + sh;
            u32x2 w; w.x = pk2(h.x, h.y); w.y = pk2(h.z, h.w); *(u32x2*)(H + (size_t)row * 1024 + col) = w; } }
}
__device__ __forceinline__ void phase_prep(const Ctx& a, int l, int bid, int nblk, int tid) {
    const int gtid = bid * 512 + tid, NT = nblk * 512; bf16_t* cols = (bf16_t*)(a.ws + WS_BIG);
    { const int sub = gtid & 7;
#pragma unroll 1
      for (int T = gtid >> 3; T < M * 36; T += NT >> 3) { const int row = T / 36, vt = T % 36; const bool lat = row >= 8192; bf16_t* cr = cols + (size_t)row * NMIX;
        const int bc = row >> 8, tc = row & 255;
        if (vt < 26) { int col; const float* gn; float* so = nullptr;
            if (vt < 8) { col = C_DQ + 64 * vt; gn = inp(a, I_DQN) + l * 64; }
            else if (vt < 16) { col = C_DK + 64 * (vt - 8); gn = inp(a, I_DKN) + l * 64; if (!lat) so = a.out + O_DK + ((((size_t)bc * 2 + l) * 256 + tc) * 8 + (vt - 8)) * 64; }
            else if (vt < 24) { col = C_WQ + 64 * (vt - 16); gn = inp(a, I_WQN) + l * 64; }
            else { col = C_WK + 64 * (vt - 24); gn = inp(a, I_WKN) + l * 64; if (!lat) so = a.out + O_WK + ((((size_t)bc * 2 + l) * 256 + tc) * 2 + (vt - 24)) * 64; }
            const uint4 u = *(const uint4*)(cr + col + 8 * sub);
            float x[8] = {bf_lo(u.x), bf_hi(u.x), bf_lo(u.y), bf_hi(u.y), bf_lo(u.z), bf_hi(u.z), bf_lo(u.w), bf_hi(u.w)};
            float ss = 0.f;
#pragma unroll
            for (int i = 0; i < 8; ++i) ss += x[i] * x[i];
            ss += shx<1>(ss); ss += shx<2>(ss); ss += shx<4>(ss);
            const float rs = 1.0f / sqrtf(ss * (1.0f / 64.0f) + EPS);
            const float4 g0 = *(const float4*)(gn + 8 * sub), g1 = *(const float4*)(gn + 8 * sub + 4);
            x[0] *= rs * g0.x; x[1] *= rs * g0.y; x[2] *= rs * g0.z; x[3] *= rs * g0.w; x[4] *= rs * g1.x; x[5] *= rs * g1.y; x[6] *= rs * g1.z; x[7] *= rs * g1.w;
            if (so) { ((float4*)(so + 8 * sub))[0] = make_float4(x[0], x[1], x[2], x[3]); ((float4*)(so + 8 * sub))[1] = make_float4(x[4], x[5], x[6], x[7]); }
            if (lat) { const int t = (row - 8192) & 1023; const float pos = (sub & 4) ? (float)(t & 63) : (float)(t >> 6); const bool second = (sub & 2) != 0;
#pragma unroll
                for (int i = 0; i < 8; ++i) { const float y = shx<2>(x[i]); const float invf = exp2f(-(float)((sub & 1) * 8 + i) * (13.287712379549449f / 16.0f));
                    const float ang = pos * invf, sn = __sinf(ang), cs = __cosf(ang);
                    x[i] = second ? (y * sn + x[i] * cs) : (x[i] * cs - y * sn); } }
            uint4 o; o.x = pk2(x[0], x[1]); o.y = pk2(x[2], x[3]); o.z = pk2(x[4], x[5]); o.w = pk2(x[6], x[7]);
            *(uint4*)(cr + col + 8 * sub) = o;
        } else if (!lat) { const int v = vt < 34 ? vt - 26 : vt - 34; const bf16_t* src = cr + (vt < 34 ? C_DV : C_WV) + 64 * v + 8 * sub;
            float* dst = (vt < 34 ? a.out + O_DV + (((size_t)bc * 2 + l) * 256 + tc) * 512 + 64 * v : a.out + O_WV + (((size_t)bc * 2 + l) * 256 + tc) * 128 + 64 * v) + 8 * sub;
            const uint4 u = *(const uint4*)src;
            ((float4*)dst)[0] = make_float4(bf_lo(u.x), bf_hi(u.x), bf_lo(u.y), bf_hi(u.y)); ((float4*)dst)[1] = make_float4(bf_lo(u.z), bf_hi(u.z), bf_lo(u.w), bf_hi(u.w)); }
      } }
}
__device__ __forceinline__ void prep_hy(const Ctx& a, int l, LAS unsigned char* lds, int bid, int nblk, int tid) {
    const int lane = tid & 63, wave = __builtin_amdgcn_readfirstlane(tid >> 6), gw = bid * 8 + wave, NGW = nblk * 8;
    LAS float* scr = (LAS float*)(lds + wave * 16640);
    const bf16_t* cols = (const bf16_t*)(a.ws + WS_BIG); bf16_t* ztl = (bf16_t*)(a.ws + WS_ZB); bf16_t* ztc = ztl + (size_t)512 * 8 * 1024;
    const float* cw = inp(a, I_HCW) + l * 3 * 1536; const float* cb = inp(a, I_HCB) + l * 1536;
#pragma unroll 1
    for (int it = gw; it < 2048; it += NGW) { const int rblk = it >> 3, c = (it & 7) * 64 + lane, row0 = rblk * 64; const bool lat = row0 >= 8192;
        const int L = lat ? 1024 : 256, t0 = lat ? ((row0 - 8192) & 1023) : (row0 & 255), b = lat ? ((row0 - 8192) >> 10) : (row0 >> 8);
        const float wv0 = cw[c], wv1 = cw[1536 + c], wv2 = cw[3072 + c], bv = cb[c], wx0 = cw[1024 + c], wx1 = cw[1536 + 1024 + c], wx2 = cw[3072 + 1024 + c], bx = cb[1024 + c];
        const bf16_t* p = cols + (size_t)row0 * NMIX + c;
        float vm = t0 > 0 ? bf2f(p[-NMIX]) : 0.f, xm = t0 > 0 ? bf2f(p[1024 - NMIX]) : 0.f, v0 = bf2f(p[0]), x0 = bf2f(p[1024]);
#pragma unroll 4
        for (int i = 0; i < 64; ++i) { const bool hp = t0 + i < L - 1; const float vp = hp ? bf2f(p[(size_t)(i + 1) * NMIX]) : 0.f, xp = hp ? bf2f(p[(size_t)(i + 1) * NMIX + 1024]) : 0.f;
            const float v = vm * wv0 + v0 * wv1 + vp * wv2 + bv, x1 = xm * wx0 + x0 * wx1 + xp * wx2 + bx;
            scr[i * 65 + lane] = v * x1; vm = v0; v0 = vp; xm = x0; x0 = xp; }
        LDS_WAIT(); asm volatile("" ::: "memory");
        bf16_t* dst = (lat ? ztl + ((size_t)c * 8 + b) * 1024 : ztc + ((size_t)c * 32 + b) * 256) + t0; uint4* o = (uint4*)dst;
#pragma unroll
        for (int i = 0; i < 8; ++i) { const LAS float* q = scr + (8 * i) * 65 + lane; uint4 w;
            w.x = pk2(q[0], q[65]); w.y = pk2(q[2 * 65], q[3 * 65]); w.z = pk2(q[4 * 65], q[5 * 65]); w.w = pk2(q[6 * 65], q[7 * 65]); o[i] = w; }
        LDS_WAIT(); asm volatile("" ::: "memory"); }
}

typedef pg8::bf16x8 bf16x8;
__device__ __forceinline__ bf16x8 ldfrag(const bf16_t* p) { return *(const bf16x8*)p; }
__device__ __forceinline__ bf16x8 pack8(const float (&p)[8]) { u32x4 w; w.x = cvt_pk_bf16(p[0], p[1]); w.y = cvt_pk_bf16(p[2], p[3]); w.z = cvt_pk_bf16(p[4], p[5]); w.w = cvt_pk_bf16(p[6], p[7]); return __builtin_bit_cast(bf16x8, w); }
#define MFMA16(a, b, c) __builtin_amdgcn_mfma_f32_16x16x32_bf16((a), (b), (c), 0, 0, 0)
template <bool F32SRC> __device__ __forceinline__ void transpose64(const void* src, size_t sp, bf16_t* dst, size_t dp, LAS float* scr, int lane, size_t hp = 32) {
    if (F32SRC) { const float4* p = (const float4*)((const float*)src + (size_t)lane * sp);
#pragma unroll
        for (int i = 0; i < 16; ++i) { const float4 u = p[i]; scr[lane * 65 + 4 * i + 0] = u.x; scr[lane * 65 + 4 * i + 1] = u.y; scr[lane * 65 + 4 * i + 2] = u.z; scr[lane * 65 + 4 * i + 3] = u.w; } }
    else { const uint4* p = (const uint4*)((const bf16_t*)src + (size_t)lane * sp);
#pragma unroll
        for (int i = 0; i < 8; ++i) { const uint4 u = p[i]; LAS float* d = scr + lane * 65 + 8 * i;
            d[0] = bf_lo(u.x); d[1] = bf_hi(u.x); d[2] = bf_lo(u.y); d[3] = bf_hi(u.y); d[4] = bf_lo(u.z); d[5] = bf_hi(u.z); d[6] = bf_lo(u.w); d[7] = bf_hi(u.w); } }
    LDS_WAIT(); asm volatile("" ::: "memory");
#pragma unroll
    for (int i = 0; i < 8; ++i) { const LAS float* c = scr + (8 * i) * 65 + lane; uint4 w;
        w.x = pk2(c[0], c[65]); w.y = pk2(c[2 * 65], c[3 * 65]); w.z = pk2(c[4 * 65], c[5 * 65]); w.w = pk2(c[6 * 65], c[7 * 65]);
        *(uint4*)(dst + (size_t)lane * dp + (size_t)(i >> 2) * hp + (i & 3) * 8) = w; }
    LDS_WAIT(); asm volatile("" ::: "memory");
}
__device__ __forceinline__ void prep_diff(const Ctx& a, int l, LAS unsigned char* lds, int bid, int nblk, int tid) {
    const int lane = tid & 63, wave = __builtin_amdgcn_readfirstlane(tid >> 6), gw = bid * 8 + wave, NGW = nblk * 8, gtid = bid * 512 + tid, NT = nblk * 512;
    LAS float* scr = (LAS float*)(lds + wave * 16640);
    const bf16_t* cols = (const bf16_t*)(a.ws + WS_BIG); bf16_t* vtl = (bf16_t*)(a.ws + WS_VTDL); bf16_t* vtc = (bf16_t*)(a.ws + WS_VTDC);
#pragma unroll 1
    for (int it = gw; it < 2560; it += NGW) {
        if (it < 1024) { const int b = it >> 7, h = (it >> 5) & 3, tb = (it >> 1) & 15, eb = it & 1;
            transpose64<false>(cols + (size_t)(8192 + b * 1024 + tb * 64) * NMIX + C_DV + h * 128 + eb * 64, NMIX, vtl + (size_t)(b * 4 + h) * 128 * 1536 + ((size_t)(2 * tb) * 128 + eb * 64) * 32, 32, scr, lane, 128 * 32); }
        else if (it < 1536) { const int q = it - 1024, b = q >> 6, h = (q >> 4) & 3, jb = (q >> 1) & 7, eb = q & 1;
            transpose64<true>(inp(a, I_CDV) + ((((size_t)b * 2 + l) * 512 + jb * 64) * 4 + h) * 128 + eb * 64, 512, vtl + (size_t)(b * 4 + h) * 128 * 1536 + ((size_t)(32 + 2 * jb) * 128 + eb * 64) * 32, 32, scr, lane, 128 * 32); }
        else { const int q = it - 1536, b = q >> 5, h = (q >> 3) & 3, tb = (q >> 1) & 3, eb = q & 1;
            transpose64<false>(cols + (size_t)(b * 256 + tb * 64) * NMIX + C_DV + h * 128 + eb * 64, NMIX, vtc + (size_t)(b * 4 + h) * 128 * 256 + ((size_t)(2 * tb) * 128 + eb * 64) * 32, 32, scr, lane, 128 * 32); }
    }
    { bf16_t* kdc = (bf16_t*)(a.ws + WS_KDC); const float* ck = inp(a, I_CDK);
      for (int i = gtid; i < 8 * 4 * 2 * 512 * 8; i += NT) { const int d8 = i & 7, j = (i >> 3) & 511, c = (i >> 12) & 1, h = (i >> 13) & 3, b = i >> 15;
          const float4* p = (const float4*)(ck + (((((size_t)b * 2 + l) * 512 + j) * 4 + h) * 2 + c) * 64 + d8 * 8); const float4 u = p[0], v = p[1];
          uint4 w; w.x = pk2(u.x, u.y); w.y = pk2(u.z, u.w); w.z = pk2(v.x, v.y); w.w = pk2(v.z, v.w);
          *(uint4*)(kdc + ((((size_t)b * 4 + h) * 2 + c) * 512 + j) * 64 + d8 * 8) = w; } }
}
__device__ __forceinline__ void diff_map(const bf16_t* cols, const bf16_t* kdc_bh  , const bf16_t* vt  , int nk, int L, int rb, int h, int c, int q0, int lane, f32x4 (&O)[2][8]) {
    const int q16 = lane & 15, g = lane >> 4;
    bf16x8 bq[2][2];
#pragma unroll
    for (int qt = 0; qt < 2; ++qt)
#pragma unroll
        for (int kd = 0; kd < 2; ++kd) bq[qt][kd] = ldfrag(cols + (size_t)(rb + q0 + 16 * qt + q16) * NMIX + C_DQ + (h * 2 + c) * 64 + 32 * kd + 8 * g);
    float m[2] = {-1e30f, -1e30f}, ls[2] = {0.f, 0.f};
#pragma unroll
    for (int qt = 0; qt < 2; ++qt)
#pragma unroll
        for (int et = 0; et < 8; ++et) O[qt][et] = (f32x4){0.f, 0.f, 0.f, 0.f};
    const int nkb = nk >> 5, nkt = L >> 5, kr = 8 * (q16 >> 2) + (q16 & 3);
    const float sc2 = 0.125f * 1.44269504088896f;
    const bf16_t* ktok = cols + (size_t)(rb + kr) * NMIX + C_DK + (h * 2 + c) * 64 + 8 * g; const bf16_t* kcac = kdc_bh + ((size_t)c * 512 + kr) * 64 + 8 * g;
#define DKP(kb_) ((kb_) < nkt ? ktok + (size_t)(kb_) * 32 * NMIX : kcac + (size_t)((kb_) - nkt) * 32 * 64)
#define DKS(kb_) ((kb_) < nkt ? 4 * NMIX : 4 * 64)
    bf16x8 ak00, ak01, ak10, ak11;
    { const bf16_t* kp = DKP(0); const int st = DKS(0); ak00 = ldfrag(kp); ak01 = ldfrag(kp + 32); ak10 = ldfrag(kp + st); ak11 = ldfrag(kp + st + 32); }
#define DSTEP(kb_) do { \
        bf16x8 av[8]; \
        _Pragma("unroll") for (int et = 0; et < 8; ++et) av[et] = ldfrag(vt + ((size_t)(kb_) * 128 + 16 * et + q16) * 32 + 8 * g); \
        f32x4 s0[2], s1[2]; \
        _Pragma("unroll") for (int qt = 0; qt < 2; ++qt) { s0[qt] = MFMA16(ak00, bq[qt][0], ((f32x4){0.f, 0.f, 0.f, 0.f})); s0[qt] = MFMA16(ak01, bq[qt][1], s0[qt]); \
            s1[qt] = MFMA16(ak10, bq[qt][0], ((f32x4){0.f, 0.f, 0.f, 0.f})); s1[qt] = MFMA16(ak11, bq[qt][1], s1[qt]); } \
        { const int kn = (kb_) + 1 < nkb ? (kb_) + 1 : (kb_); const bf16_t* kp = DKP(kn); const int st = DKS(kn); ak00 = ldfrag(kp); ak01 = ldfrag(kp + 32); ak10 = ldfrag(kp + st); ak11 = ldfrag(kp + st + 32); } \
        bf16x8 pb[2]; \
        _Pragma("unroll") for (int qt = 0; qt < 2; ++qt) { \
            const float x[8] = {s0[qt][0], s0[qt][1], s0[qt][2], s0[qt][3], s1[qt][0], s1[qt][1], s1[qt][2], s1[qt][3]};     \
            float ml = fmaxf(fmaxf(fmaxf(x[0], x[1]), fmaxf(x[2], x[3])), fmaxf(fmaxf(x[4], x[5]), fmaxf(x[6], x[7]))); \
            ml = fmaxf(ml, shx<16>(ml)); ml = fmaxf(ml, shx<32>(ml)); \
            const float mn = fmaxf(m[qt], ml * sc2); \
            if (__any(mn > m[qt])) { const float alpha = __builtin_amdgcn_exp2f(m[qt] - mn); ls[qt] *= alpha; \
                _Pragma("unroll") for (int et = 0; et < 8; ++et) O[qt][et] = O[qt][et] * alpha; }        \
            m[qt] = mn; \
            float p[8], psum = 0.f; \
            _Pragma("unroll") for (int j = 0; j < 8; ++j) { p[j] = __builtin_amdgcn_exp2f(__builtin_fmaf(x[j], sc2, -mn)); psum += p[j]; } \
            ls[qt] += psum; \
            pb[qt] = pack8(p); } \
        _Pragma("unroll") for (int et = 0; et < 8; ++et) { O[0][et] = MFMA16(av[et], pb[0], O[0][et]); O[1][et] = MFMA16(av[et], pb[1], O[1][et]); } \
    } while (0)
#pragma unroll 1
    for (int kb = 0; kb < nkb; ++kb) { DSTEP(kb); }
#undef DSTEP
#undef DKP
#undef DKS
#pragma unroll
    for (int qt = 0; qt < 2; ++qt) { float lt = ls[qt]; lt += shx<16>(lt); lt += shx<32>(lt); const float inv = 1.0f / lt;
#pragma unroll
        for (int et = 0; et < 8; ++et) O[qt][et] = O[qt][et] * inv; }
}
__device__ __forceinline__ void diff_mfma_item(const Ctx& a, int l, int grp, int h, int qb, int lane, LAS float* scr) {
    const bf16_t* cols = (const bf16_t*)(a.ws + WS_BIG); bf16_t* yo = (bf16_t*)(a.ws + WS_YBR) + (size_t)1 * M * 512;
    const bool lat = grp >= 32; const int b = lat ? grp - 32 : grp, L = lat ? 1024 : 256, rb = lat ? 8192 + b * 1024 : b * 256, nk = lat ? 1536 : 256;
    const int q16 = lane & 15, g = lane >> 4, q0 = qb * 32;
    const bf16_t* vt = lat ? (const bf16_t*)(a.ws + WS_VTDL) + (size_t)((b * 4 + h) * 128) * 1536 : (const bf16_t*)(a.ws + WS_VTDC) + (size_t)((b * 4 + h) * 128) * 256;
    const bf16_t* kdc = (const bf16_t*)(a.ws + WS_KDC) + (size_t)((b * 4 + h) * 2) * 512 * 64;
    const float* dl = inp(a, I_DLAM) + l * 256; float s01 = 0.f, s23 = 0.f;
    for (int i = 0; i < 64; ++i) { s01 += dl[i] * dl[64 + i]; s23 += dl[128 + i] * dl[192 + i]; }
    const float lam_init = 0.8f - 0.6f * expf(-0.3f * (float)l), lam = expf(s01) - expf(s23) + lam_init;
    f32x4 o0[2][8], o1[2][8];
    diff_map(cols, kdc, vt, nk, L, rb, h, 0, q0, lane, o0);
#pragma unroll
    for (int qt = 0; qt < 2; ++qt)
#pragma unroll
        for (int et = 0; et < 8; ++et) *(LAS f32x4*)(scr + ((qt * 8 + et) * 64 + lane) * 4) = o0[qt][et];
    asm volatile("" ::: "memory");
    diff_map(cols, kdc, vt, nk, L, rb, h, 1, q0, lane, o1);
    LDS_WAIT(); asm volatile("" ::: "memory");
#pragma unroll
    for (int qt = 0; qt < 2; ++qt)
#pragma unroll
        for (int et = 0; et < 8; ++et) o0[qt][et] = *(const LAS f32x4*)(scr + ((qt * 8 + et) * 64 + lane) * 4);
    LDS_WAIT(); asm volatile("" ::: "memory");
    const float* sg = inp(a, I_DSUB) + l * 128;
#pragma unroll
    for (int qt = 0; qt < 2; ++qt) { float ss = 0.f;
#pragma unroll
        for (int et = 0; et < 8; ++et) { o0[qt][et] = o0[qt][et] - o1[qt][et] * lam; const f32x4 v = o0[qt][et]; ss += (v[0] * v[0] + v[1] * v[1]) + (v[2] * v[2] + v[3] * v[3]); }
        ss += shx<16>(ss); ss += shx<32>(ss);
        const float rs = (1.0f / sqrtf(ss * (1.0f / 128.0f) + EPS)) * (1.0f - lam_init);
        bf16_t* orow = yo + (size_t)(rb + q0 + 16 * qt + q16) * 512 + h * 128 + 4 * g;
#pragma unroll
        for (int et = 0; et < 8; ++et) { const f32x4 gn = *(const f32x4*)(sg + 16 * et + 4 * g); const f32x4 v = o0[qt][et] * rs * gn;
            u32x2 w; w.x = cvt_pk_bf16(v[0], v[1]); w.y = cvt_pk_bf16(v[2], v[3]); *(u32x2*)(orow + 16 * et) = w; } }
}

__device__ __forceinline__ void prep_ret(const Ctx& a, int l, LAS unsigned char* lds, int bid, int nblk, int tid) {
    const int lane = tid & 63, wave = __builtin_amdgcn_readfirstlane(tid >> 6), gw = bid * 8 + wave, NGW = nblk * 8;
    LAS float* scr = (LAS float*)(lds + wave * 16640);
    const bf16_t* cols = (const bf16_t*)(a.ws + WS_BIG); bf16_t* vtl = (bf16_t*)(a.ws + WS_VTRL); bf16_t* vtc = (bf16_t*)(a.ws + WS_VTRC); bf16_t* st = (bf16_t*)(a.ws + WS_ST);
#pragma unroll 1
    for (int it = gw; it < 2048 + 128 + 512; it += NGW) {
        if (it >= 2048 + 128) { const int q = it - 2176, b = q >> 4, h = (q >> 2) & 3, tb = q & 3;
            transpose64<false>(cols + (size_t)(b * 256 + tb * 64) * NMIX + C_RK + h * 64, NMIX, (bf16_t*)(a.ws + WS_KTR) + (size_t)((b * 4 + h) * 64) * 256 + tb * 64, 256, scr, lane); }
        else if (it < 1024) { const int b = it >> 7, h = (it >> 5) & 3, tb = (it >> 1) & 15, eb = it & 1;
            transpose64<false>(cols + (size_t)(8192 + b * 1024 + tb * 64) * NMIX + C_RV + h * 128 + eb * 64, NMIX, vtl + (size_t)(b * 4 + h) * 128 * 1024 + ((size_t)(2 * tb) * 128 + eb * 64) * 32, 32, scr, lane, 128 * 32); }
        else if (it < 2048) { const int q = it - 1024, b = q >> 5, h = (q >> 3) & 3, tb = (q >> 1) & 3, eb = q & 1;
            transpose64<false>(cols + (size_t)(b * 256 + tb * 64) * NMIX + C_RV + h * 128 + eb * 64, NMIX, vtc + (size_t)(b * 4 + h) * 128 * 256 + ((size_t)(2 * tb) * 128 + eb * 64) * 32, 32, scr, lane, 128 * 32); }
        else { const int q = it - 2048, b = q >> 4, h = (q >> 2) & 3, dir = (q >> 1) & 1, eb = q & 1;
            const float* src = inp(a, dir ? I_SRB : I_SRF) + ((((size_t)b * 2 + l) * 4 + h) * 64) * 128 + eb * 64;
            transpose64<true>(src, 128, st + ((size_t)((b * 4 + h) * 2 + dir) * 128 + eb * 64) * 64, 64, scr, lane); }
    }
}
__device__ __forceinline__ bf16x8 scale8(bf16x8 v, float w) { const u32x4 u = __builtin_bit_cast(u32x4, v); float p[8] = {bf_lo(u.x) * w, bf_hi(u.x) * w, bf_lo(u.y) * w, bf_hi(u.y) * w, bf_lo(u.z) * w, bf_hi(u.z) * w, bf_lo(u.w) * w, bf_hi(u.w) * w}; return pack8(p); }
__device__ __forceinline__ void ret_mfma_item(const Ctx& a, int l, int grp, int h, int qb, int lane) {
    const bf16_t* cols = (const bf16_t*)(a.ws + WS_BIG); bf16_t* yo = (bf16_t*)(a.ws + WS_YBR) + (size_t)3 * M * 512;
    const bool lat = grp >= 32; const int b = lat ? grp - 32 : grp, L = lat ? 1024 : 256, rb = lat ? 8192 + b * 1024 : b * 256;
    const int q16 = lane & 15, g = lane >> 4, q0 = qb * 32;
    const bf16_t* vt = lat ? (const bf16_t*)(a.ws + WS_VTRL) + (size_t)((b * 4 + h) * 128) * 1024 : (const bf16_t*)(a.ws + WS_VTRC) + (size_t)((b * 4 + h) * 128) * 256;
    const float lgf2 = -log1pf(expf(-inp(a, I_RDF)[l * 4 + h])) * 1.44269504088896f, lgb2 = -log1pf(expf(-inp(a, I_RDB)[l * 4 + h])) * 1.44269504088896f;
    bf16x8 bq[2][2];
#pragma unroll
    for (int qt = 0; qt < 2; ++qt)
#pragma unroll
        for (int kd = 0; kd < 2; ++kd) bq[qt][kd] = ldfrag(cols + (size_t)(rb + q0 + 16 * qt + q16) * NMIX + C_RQ + h * 64 + 32 * kd + 8 * g);
    f32x4 O[2][8];
#pragma unroll
    for (int qt = 0; qt < 2; ++qt)
#pragma unroll
        for (int et = 0; et < 8; ++et) O[qt][et] = (f32x4){0.f, 0.f, 0.f, 0.f};
    const int nkb = L >> 5, kr = 8 * (q16 >> 2) + (q16 & 3);
    const bf16_t* kbase = cols + (size_t)(rb + kr) * NMIX + C_RK + h * 64 + 8 * g;
    bf16x8 ak00 = ldfrag(kbase), ak01 = ldfrag(kbase + 32), ak10 = ldfrag(kbase + 4 * NMIX), ak11 = ldfrag(kbase + 4 * NMIX + 32);
    float cf[8], cb[8];
#pragma unroll
    for (int j = 0; j < 8; ++j) { cf[j] = __builtin_amdgcn_exp2f(-(float)j * lgf2); cb[j] = __builtin_amdgcn_exp2f((float)j * lgb2); }
#define RSTEP(kb_) do { \
        bf16x8 av[8]; \
        _Pragma("unroll") for (int et = 0; et < 8; ++et) av[et] = ldfrag(vt + ((size_t)(kb_) * 128 + 16 * et + q16) * 32 + 8 * g); \
        f32x4 s0[2], s1[2]; \
        _Pragma("unroll") for (int qt = 0; qt < 2; ++qt) { s0[qt] = MFMA16(ak00, bq[qt][0], ((f32x4){0.f, 0.f, 0.f, 0.f})); s0[qt] = MFMA16(ak01, bq[qt][1], s0[qt]); \
            s1[qt] = MFMA16(ak10, bq[qt][0], ((f32x4){0.f, 0.f, 0.f, 0.f})); s1[qt] = MFMA16(ak11, bq[qt][1], s1[qt]); } \
        { const int kn = (kb_) + 1 < nkb ? (kb_) + 1 : (kb_); const bf16_t* kp = kbase + (size_t)kn * 32 * NMIX; ak00 = ldfrag(kp); ak01 = ldfrag(kp + 32); ak10 = ldfrag(kp + 4 * NMIX); ak11 = ldfrag(kp + 4 * NMIX + 32); } \
        bf16x8 pb[2]; \
        _Pragma("unroll") for (int qt = 0; qt < 2; ++qt) { \
            const float x[8] = {s0[qt][0], s0[qt][1], s0[qt][2], s0[qt][3], s1[qt][0], s1[qt][1], s1[qt][2], s1[qt][3]}; \
            const int d0 = (q0 + 16 * qt + q16) - ((kb_) * 32 + 8 * g);     \
            float p[8]; \
            const int kbq = (q0 + 16 * qt) >> 5;       \
            if ((kb_) < kbq) { const float e0 = 0.125f * __builtin_amdgcn_exp2f((float)d0 * lgf2);              \
                _Pragma("unroll") for (int j = 0; j < 8; ++j) p[j] = x[j] * (e0 * cf[j]); } \
            else if ((kb_) > kbq) { const float e0 = 0.125f * __builtin_amdgcn_exp2f((float)(-d0) * lgb2);       \
                _Pragma("unroll") for (int j = 0; j < 8; ++j) p[j] = x[j] * (e0 * cb[j]); } \
            else { _Pragma("unroll") for (int j = 0; j < 8; ++j) { const int d = d0 - j; const float wf = d >= 0 ? __builtin_amdgcn_exp2f((float)d * lgf2) : 0.f, wb = d <= 0 ? __builtin_amdgcn_exp2f((float)(-d) * lgb2) : 0.f; \
                p[j] = x[j] * 0.125f * (wf + wb); } } \
            pb[qt] = pack8(p); } \
        _Pragma("unroll") for (int et = 0; et < 8; ++et) { O[0][et] = MFMA16(av[et], pb[0], O[0][et]); O[1][et] = MFMA16(av[et], pb[1], O[1][et]); } \
    } while (0)
#pragma unroll 1
    for (int kb = 0; kb < nkb; ++kb) { RSTEP(kb); }
#undef RSTEP
    if (lat) { const bf16_t* stf = (const bf16_t*)(a.ws + WS_ST) + (size_t)((b * 4 + h) * 2) * 128 * 64; const bf16_t* stb = stf + 128 * 64;
        bf16x8 qf[2][2], qk[2][2];
#pragma unroll
        for (int qt = 0; qt < 2; ++qt) { const int t = q0 + 16 * qt + q16; const float wf = __builtin_amdgcn_exp2f((float)(t + 1) * lgf2), wb = __builtin_amdgcn_exp2f((float)(L - t) * lgb2);
#pragma unroll
            for (int kd = 0; kd < 2; ++kd) { qf[qt][kd] = scale8(bq[qt][kd], wf); qk[qt][kd] = scale8(bq[qt][kd], wb); } }
#pragma unroll
        for (int et = 0; et < 8; ++et) { const bf16_t* pf = stf + (size_t)(16 * et + q16) * 64 + 8 * g; const bf16_t* pb2 = stb + (size_t)(16 * et + q16) * 64 + 8 * g;
            const bf16x8 f0 = ldfrag(pf), f1 = ldfrag(pf + 32), b0 = ldfrag(pb2), b1 = ldfrag(pb2 + 32);
#pragma unroll
            for (int qt = 0; qt < 2; ++qt) { O[qt][et] = MFMA16(f0, qf[qt][0], O[qt][et]); O[qt][et] = MFMA16(f1, qf[qt][1], O[qt][et]); O[qt][et] = MFMA16(b0, qk[qt][0], O[qt][et]); O[qt][et] = MFMA16(b1, qk[qt][1], O[qt][et]); }
            asm volatile("" ::: "memory"); } }
#pragma unroll
    for (int qt = 0; qt < 2; ++qt) { float ss = 0.f;
#pragma unroll
        for (int et = 0; et < 8; ++et) { const f32x4 v = O[qt][et]; ss += (v[0] * v[0] + v[1] * v[1]) + (v[2] * v[2] + v[3] * v[3]); }
        ss += shx<16>(ss); ss += shx<32>(ss);
        const float rs = 1.0f / sqrtf(ss * (1.0f / 128.0f) + EPS);
        const size_t row = (size_t)(rb + q0 + 16 * qt + q16);
        const bf16_t* rg = cols + row * NMIX + C_RG + h * 128 + 4 * g; bf16_t* orow = yo + row * 512 + h * 128 + 4 * g;
#pragma unroll
        for (int et = 0; et < 8; ++et) { const u32x2 gw2 = *(const u32x2*)(rg + 16 * et); const float g0 = bf_lo(gw2.x), g1 = bf_hi(gw2.x), g2 = bf_lo(gw2.y), g3 = bf_hi(gw2.y);
            const f32x4 v = O[qt][et] * rs;
            u32x2 w; w.x = cvt_pk_bf16(v[0] * (g0 / (1.0f + __expf(-g0))), v[1] * (g1 / (1.0f + __expf(-g1)))); w.y = cvt_pk_bf16(v[2] * (g2 / (1.0f + __expf(-g2))), v[3] * (g3 / (1.0f + __expf(-g3))));
            *(u32x2*)(orow + 16 * et) = w; } }
}

__device__ __forceinline__ void prep_win(const Ctx& a, int l, LAS unsigned char* lds, int bid, int nblk, int tid) {
    const int lane = tid & 63, wave = __builtin_amdgcn_readfirstlane(tid >> 6), gw = bid * 8 + wave, NGW = nblk * 8, gtid = bid * 512 + tid, NT = nblk * 512;
    LAS float* scr = (LAS float*)(lds + wave * 16640);
    const bf16_t* cols = (const bf16_t*)(a.ws + WS_BIG); bf16_t* vtl = (bf16_t*)(a.ws + WS_VTWL); bf16_t* vtc = (bf16_t*)(a.ws + WS_VTWC);
#pragma unroll 1
    for (int it = gw; it < 640; it += NGW) {
        if (it < 256) { const int b = it >> 5, hk = (it >> 4) & 1, tb = it & 15;
            transpose64<false>(cols + (size_t)(8192 + b * 1024 + tb * 64) * NMIX + C_WV + hk * 64, NMIX, vtl + (size_t)(b * 2 + hk) * 64 * 1536 + (size_t)(2 * tb) * 64 * 32, 32, scr, lane, 64 * 32); }
        else if (it < 384) { const int q = it - 256, b = q >> 4, hk = (q >> 3) & 1, jb = q & 7;
            transpose64<true>(inp(a, I_CWV) + ((((size_t)b * 2 + l) * 512 + jb * 64) * 2 + hk) * 64, 128, vtl + (size_t)(b * 2 + hk) * 64 * 1536 + (size_t)(32 + 2 * jb) * 64 * 32, 32, scr, lane, 64 * 32); }
        else { const int q = it - 384, b = q >> 3, hk = (q >> 2) & 1, tb = q & 3;
            transpose64<false>(cols + (size_t)(b * 256 + tb * 64) * NMIX + C_WV + hk * 64, NMIX, vtc + (size_t)(b * 2 + hk) * 64 * 256 + (size_t)(2 * tb) * 64 * 32, 32, scr, lane, 64 * 32); }
    }
    { bf16_t* kwc = (bf16_t*)(a.ws + WS_KWC); const float* ck = inp(a, I_CWK);
      for (int i = gtid; i < 8 * 2 * 512 * 8; i += NT) { const int d8 = i & 7, j = (i >> 3) & 511, hk = (i >> 12) & 1, b = i >> 13;
          const float4* p = (const float4*)(ck + ((((size_t)b * 2 + l) * 512 + j) * 2 + hk) * 64 + d8 * 8); const float4 u = p[0], v = p[1];
          uint4 w; w.x = pk2(u.x, u.y); w.y = pk2(u.z, u.w); w.z = pk2(v.x, v.y); w.w = pk2(v.z, v.w);
          *(uint4*)(kwc + (((size_t)b * 2 + hk) * 512 + j) * 64 + d8 * 8) = w; } }
}
__device__ __forceinline__ void win_mfma_item(const Ctx& a, int l, int grp, int hk, int tb, int lane) {
    const bf16_t* cols = (const bf16_t*)(a.ws + WS_BIG); bf16_t* yo = (bf16_t*)(a.ws + WS_YBR) + (size_t)2 * M * 512;
    const bool lat = grp >= 32; const int b = lat ? grp - 32 : grp, L = lat ? 1024 : 256, rb = lat ? 8192 + b * 1024 : b * 256, nk = lat ? 1536 : 256;
    const int q16 = lane & 15, g = lane >> 4, t0 = tb * 16, t = t0 + q16;
    const bf16_t* vt = lat ? (const bf16_t*)(a.ws + WS_VTWL) + (size_t)((b * 2 + hk) * 64) * 1536 : (const bf16_t*)(a.ws + WS_VTWC) + (size_t)((b * 2 + hk) * 64) * 256;
    const bf16_t* kwc = (const bf16_t*)(a.ws + WS_KWC) + (size_t)(b * 2 + hk) * 512 * 64;
    bf16x8 bq[4][2]; float m[4], ls[4]; f32x4 O[4][4];
#pragma unroll
    for (int qh = 0; qh < 4; ++qh) { m[qh] = inp(a, I_WSINK)[l * 8 + hk * 4 + qh] * 1.44269504088896f; ls[qh] = g == 0 ? 1.0f : 0.0f;
#pragma unroll
        for (int kd = 0; kd < 2; ++kd) bq[qh][kd] = ldfrag(cols + (size_t)(rb + t) * NMIX + C_WQ + (hk * 4 + qh) * 64 + 32 * kd + 8 * g);
#pragma unroll
        for (int et = 0; et < 4; ++et) O[qh][et] = (f32x4){0.f, 0.f, 0.f, 0.f}; }
    const int kr = 8 * (q16 >> 2) + (q16 & 3); const float sc2 = 0.125f * 1.44269504088896f;
    const int kb_lo = lat ? max(0, (t0 - 128) >> 5) : 0, kb_hi = lat ? min(31, (t0 + 143) >> 5) : 7, ncache = lat ? 16 : 0, nblocks = (kb_hi - kb_lo + 1) + ncache;
    const int ntokb = kb_hi - kb_lo + 1;
    const bf16_t* ktok = cols + (size_t)(rb + kr) * NMIX + C_WK + hk * 64 + 8 * g; const bf16_t* kcac = kwc + (size_t)kr * 64 + 8 * g;
#define WKP(ib_) ((ib_) < ntokb ? ktok + (size_t)(kb_lo + (ib_)) * 32 * NMIX : kcac + (size_t)((ib_) - ntokb) * 32 * 64)
#define WKS(ib_) ((ib_) < ntokb ? 4 * NMIX : 4 * 64)
    bf16x8 ak00, ak01, ak10, ak11;
    { const bf16_t* kp = WKP(0); const int st = WKS(0); ak00 = ldfrag(kp); ak01 = ldfrag(kp + 32); ak10 = ldfrag(kp + st); ak11 = ldfrag(kp + st + 32); }
#pragma unroll 1
    for (int ib = 0; ib < nblocks; ++ib) {
        const bool tok = ib < ntokb; const int kb = tok ? kb_lo + ib : ib - ntokb;
        const int vcol = tok ? kb * 32 : 1024 + kb * 32;
        bf16x8 av[4];
#pragma unroll
        for (int et = 0; et < 4; ++et) av[et] = ldfrag(vt + ((size_t)(vcol >> 5) * 64 + 16 * et + q16) * 32 + 8 * g);
        const int in = ib + 1 < nblocks ? ib + 1 : ib; const bf16_t* kp = WKP(in); const int st = WKS(in);
        const bf16x8 n00 = ldfrag(kp), n01 = ldfrag(kp + 32), n10 = ldfrag(kp + st), n11 = ldfrag(kp + st + 32);
        const bool domask = lat && tok; const int dk0 = t - (kb * 32 + 8 * g);
        bf16x8 pb[4];
#pragma unroll
        for (int qh = 0; qh < 4; ++qh) {
            f32x4 s0 = MFMA16(ak00, bq[qh][0], ((f32x4){0.f, 0.f, 0.f, 0.f})); s0 = MFMA16(ak01, bq[qh][1], s0);
            f32x4 s1 = MFMA16(ak10, bq[qh][0], ((f32x4){0.f, 0.f, 0.f, 0.f})); s1 = MFMA16(ak11, bq[qh][1], s1);
            float x[8] = {s0[0], s0[1], s0[2], s0[3], s1[0], s1[1], s1[2], s1[3]};
            if (domask) {
#pragma unroll
                for (int j = 0; j < 8; ++j) { const int d = dk0 - j; if (d > 128 || d < -128) x[j] = -1e30f; } }
            float ml = fmaxf(fmaxf(fmaxf(x[0], x[1]), fmaxf(x[2], x[3])), fmaxf(fmaxf(x[4], x[5]), fmaxf(x[6], x[7])));
            ml = fmaxf(ml, shx<16>(ml)); ml = fmaxf(ml, shx<32>(ml));
            const float mn = fmaxf(m[qh], ml * sc2);
            if (__any(mn > m[qh])) { const float alpha = __builtin_amdgcn_exp2f(m[qh] - mn); ls[qh] *= alpha;
#pragma unroll
                for (int et = 0; et < 4; ++et) O[qh][et] = O[qh][et] * alpha; }
            m[qh] = mn;
            float p[8], psum = 0.f;
#pragma unroll
            for (int j = 0; j < 8; ++j) { p[j] = __builtin_amdgcn_exp2f(__builtin_fmaf(x[j], sc2, -mn)); psum += p[j]; }
            ls[qh] += psum;
            pb[qh] = pack8(p);
        }
#pragma unroll
        for (int et = 0; et < 4; ++et) {
#pragma unroll
            for (int qh = 0; qh < 4; ++qh) O[qh][et] = MFMA16(av[et], pb[qh], O[qh][et]); }
        ak00 = n00; ak01 = n01; ak10 = n10; ak11 = n11;
    }
#undef WKP
#undef WKS
#pragma unroll
    for (int qh = 0; qh < 4; ++qh) { float lt = ls[qh]; lt += shx<16>(lt); lt += shx<32>(lt); const float inv = 1.0f / lt;
        bf16_t* orow = yo + (size_t)(rb + t) * 512 + (hk * 4 + qh) * 64 + 4 * g;
#pragma unroll
        for (int et = 0; et < 4; ++et) { const f32x4 v = O[qh][et] * inv; u32x2 w; w.x = cvt_pk_bf16(v[0], v[1]); w.y = cvt_pk_bf16(v[2], v[3]); *(u32x2*)(orow + 16 * et) = w; } }
}

#ifndef HY_ABL
#define HY_ABL 0
#endif
__device__ __forceinline__ void hy_mfma_item(const Ctx& a, int l, int it, int lane, LAS unsigned* fl  ) {
    const bf16_t* cols = (const bf16_t*)(a.ws + WS_BIG); bf16_t* yo = (bf16_t*)(a.ws + WS_YBR);
    const bool lat = it < 2048; const int c = lat ? it >> 2 : (it - 2048) >> 1, sub = lat ? it & 3 : (it - 2048) & 1;
    const int L = lat ? 1024 : 256, NB = lat ? 8 : 32, tg0 = lat ? sub * 256 : 0, b0 = lat ? 0 : sub * 16;
    const int tl = lane & 15, g = lane >> 4;
    const bf16_t* gt = (const bf16_t*)(a.ws + WS_GRT) + (size_t)l * (512 * 2560) + (lat ? 512 * 512 : 0) + (size_t)c * (2 * L);
    { const u32x4* src = (const u32x4*)gt; LAS u32x4* dst = (LAS u32x4*)fl;
      for (int i = lane; i < (2 * L) / 8; i += 64) dst[i] = src[i];
      LDS_WAIT(); asm volatile("" ::: "memory"); }
    const bf16_t* zt = (const bf16_t*)(a.ws + WS_ZB) + (lat ? ((size_t)c * 8 + (tl & 7)) * 1024 : (size_t)512 * 8 * 1024 + ((size_t)c * 32 + b0 + tl) * 256) + 8 * g;
    f32x4 acc[16];
#pragma unroll
    for (int tt = 0; tt < 16; ++tt) acc[tt] = (f32x4){0.f, 0.f, 0.f, 0.f};
#pragma unroll 1
    for (int s0 = 0; s0 < (HY_ABL == 2 ? 32 : L); s0 += 32) { const bf16x8 zf = ldfrag(zt + s0);
        const int idx0 = L - 1 - (tg0 + tl) + s0 + 8 * g;
#pragma unroll
        for (int tt = 0; tt < 16; ++tt) { const int idx = idx0 - 16 * tt; const unsigned sh = (unsigned)(idx & 1) * 16u; const LAS unsigned* q = fl + (idx >> 1);
            const unsigned d0 = q[0], d1 = q[1], d2 = q[2], d3 = q[3], d4 = q[4];
            u32x4 w; w.x = __builtin_amdgcn_alignbit(d1, d0, sh); w.y = __builtin_amdgcn_alignbit(d2, d1, sh); w.z = __builtin_amdgcn_alignbit(d3, d2, sh); w.w = __builtin_amdgcn_alignbit(d4, d3, sh);
            acc[tt] = MFMA16(zf, __builtin_bit_cast(bf16x8, w), acc[tt]); } }
    const float sk = inp(a, I_HSKIP)[l * 512 + c];
    if (HY_ABL == 1) { float sacc = 0.f;
#pragma unroll
        for (int tt = 0; tt < 16; ++tt) sacc += acc[tt][0] + acc[tt][1] + acc[tt][2] + acc[tt][3];
        if (sacc == 123.456f) yo[0] = 0; }
    else if (!lat || g < 2) { bf16_t* colsw = (bf16_t*)(a.ws + WS_BIG);
#pragma unroll
        for (int r = 0; r < 4; ++r) { const int bb = b0 + 4 * g + r; const int pos0 = (lat ? 8192 + bb * 1024 : bb * 256) + tg0 + tl;
            const bf16_t* zp = (const bf16_t*)(a.ws + WS_ZB) + (lat ? ((size_t)c * 8 + bb) * 1024 : (size_t)512 * 8 * 1024 + ((size_t)c * 32 + bb) * 256) + tg0 + tl;
            bf16_t* yp = colsw + (size_t)(c * 32 + (pos0 >> 9)) * NMIX + (pos0 & 511);
#pragma unroll
            for (int tt = 0; tt < 16; ++tt) yp[16 * tt] = (bf16_t)f2bf(acc[tt][r] + sk * bf2f(zp[16 * tt])); } }
    LDS_WAIT(); asm volatile("" ::: "memory");
}

__device__ __forceinline__ void retstate_mfma_item(const Ctx& a, int l, int it, int lane) {
    const int dt = it & 3, dir = (it >> 2) & 1, h = (it >> 3) & 3, b = it >> 5, q16 = lane & 15, g = lane >> 4;
    const float lg2 = -log1pf(expf(-inp(a, dir ? I_RDB : I_RDF)[l * 4 + h])) * 1.44269504088896f;
    const bf16_t* kt = (const bf16_t*)(a.ws + WS_KTR) + (size_t)((b * 4 + h) * 64 + dt * 16 + q16) * 256 + 8 * g;
    const bf16_t* vt = (const bf16_t*)(a.ws + WS_VTRC) + (size_t)(b * 4 + h) * 128 * 256 + (size_t)q16 * 32 + 8 * g;
    f32x4 S[8];
#pragma unroll
    for (int et = 0; et < 8; ++et) S[et] = (f32x4){0.f, 0.f, 0.f, 0.f};
#pragma unroll 1
    for (int s0 = 0; s0 < 256; s0 += 32) { const u32x4 u = __builtin_bit_cast(u32x4, ldfrag(kt + s0)); const int sb = s0 + 8 * g;
        float p[8] = {bf_lo(u.x), bf_hi(u.x), bf_lo(u.y), bf_hi(u.y), bf_lo(u.z), bf_hi(u.z), bf_lo(u.w), bf_hi(u.w)};
#pragma unroll
        for (int j = 0; j < 8; ++j) { const int sp = sb + j; p[j] *= 0.125f * __builtin_amdgcn_exp2f((float)(dir ? sp : 255 - sp) * lg2); }
        const bf16x8 ka = pack8(p);
#pragma unroll
        for (int et = 0; et < 8; ++et) S[et] = MFMA16(ka, ldfrag(vt + ((size_t)(s0 >> 5) * 128 + 16 * et) * 32), S[et]); }
    float* o = a.out + (dir ? O_RB : O_RF) + ((((size_t)b * 2 + l) * 4 + h) * 64 + dt * 16 + 4 * g) * 128 + q16;
#pragma unroll
    for (int et = 0; et < 8; ++et)
#pragma unroll
        for (int r = 0; r < 4; ++r) o[(size_t)r * 128 + 16 * et] = S[et][r];
}

__device__ __forceinline__ void hyfin_item(const Ctx& a, int l, int it, int lane) {
    const bf16_t* cols = (const bf16_t*)(a.ws + WS_BIG); bf16_t* yo = (bf16_t*)(a.ws + WS_YBR);
    const int rblk = it >> 3, c = (it & 7) * 64 + lane, row0 = rblk * 64; const bool lat = row0 >= 8192;
    const int L = lat ? 1024 : 256, t0 = lat ? ((row0 - 8192) & 1023) : (row0 & 255);
    const float* cw = inp(a, I_HCW) + l * 3 * 1536; const float cb = inp(a, I_HCB)[l * 1536 + 512 + c];
    const float w0 = cw[512 + c], w1 = cw[1536 + 512 + c], w2 = cw[3072 + 512 + c];
    const uint4* yt = (const uint4*)(cols + (size_t)(c * 32 + (row0 >> 9)) * NMIX + (row0 & 511));
    uint4 yv[8];
#pragma unroll
    for (int i = 0; i < 8; ++i) yv[i] = yt[i];
    const bf16_t* p = cols + (size_t)row0 * NMIX + 512 + c;
    float xm = t0 > 0 ? bf2f(p[-NMIX]) : 0.f, x0 = bf2f(p[0]);
#pragma unroll
    for (int i = 0; i < 8; ++i) { const unsigned wv[4] = {yv[i].x, yv[i].y, yv[i].z, yv[i].w};
#pragma unroll
        for (int j = 0; j < 8; ++j) { const int k = 8 * i + j; const float xp = (t0 + k < L - 1) ? bf2f(p[(size_t)(k + 1) * NMIX]) : 0.f;
            const float y = (j & 1) ? bf_hi(wv[j >> 1]) : bf_lo(wv[j >> 1]);
            yo[(size_t)(row0 + k) * 512 + c] = (bf16_t)f2bf((xm * w0 + x0 * w1 + xp * w2 + cb) * y); xm = x0; x0 = xp; } }
}
#define LAUNDER_MIX() do { unsigned long long w_ = (unsigned long long)a.ws, o_ = (unsigned long long)a.out; unsigned t_ = (unsigned)(size_t)a.tab; \
    asm volatile("" : "+s"(w_), "+s"(o_), "+s"(t_), "+s"(l), "+s"(gw), "+s"(NGW)); asm volatile("" : "+v"(lane)); a.ws = (unsigned char*)(__attribute__((address_space(1))) unsigned char*)w_; a.out = (float*)(__attribute__((address_space(1))) float*)o_; a.tab = (const LAS unsigned long long*)(size_t)t_; } while (0)
#ifndef PROBE_MIXPART
#define PROBE_MIXPART 0
#endif
#ifdef PROF_MIX
#ifndef PROF_WAVE
#define PROF_WAVE 0
#endif
#ifndef PROF_L
#define PROF_L 0
#endif
#define PMIX_T0(k) unsigned long long pm_t##k = 0; if ((k) == PROF_MIX) pm_t##k = __builtin_amdgcn_s_memrealtime();
#define PMIX_T1(k) if ((k) == PROF_MIX && bid == 0 && wave == PROF_WAVE && l == PROF_L && lane == 0) *(LAS unsigned long long*)(lds + LDS_ST_OFF + 16) = __builtin_amdgcn_s_memrealtime() - pm_t##k;
#else
#define PMIX_T0(k)
#define PMIX_T1(k)
#endif
__device__ __forceinline__ void phase_mix(const Ctx& a0, int l, LAS unsigned char* lds, int bid, int nblk, int tid) {
    int lane = tid & 63; const int wave = __builtin_amdgcn_readfirstlane(tid >> 6); int NGW = nblk * 8;
    int gw = (wave >> 2) * (NGW >> 1) + bid * 4 + (wave & 3);
    LAS float* qs = (LAS float*)(lds + wave * 16640);
    Ctx a = a0;
    PMIX_T0(0)
    for (int rep_ = 0; rep_ < (((PROBE_MIXPART >> 0) & 1) ? 2 : 1); ++rep_) {
    LAUNDER_MIX();
#pragma unroll 1
    for (int r = gw; r < 2048; r += NGW) { if (r < 1024) diff_mfma_item(a, l, 32 + (r >> 7), (r >> 5) & 3, r & 31, lane, qs); else { const int q = r - 1024; diff_mfma_item(a, l, q >> 5, (q >> 3) & 3, q & 7, lane, qs); } }
    }
    PMIX_T1(0)
    PMIX_T0(1)
    for (int rep_ = 0; rep_ < (((PROBE_MIXPART >> 1) & 1) ? 2 : 1); ++rep_) {
    LAUNDER_MIX();
#pragma unroll 1
    for (int r0 = gw; r0 < 2048; r0 += NGW) { const int r = (r0 + 1024) & 2047; if (r < 1024) ret_mfma_item(a, l, 32 + (r >> 7), (r >> 5) & 3, r & 31, lane); else { const int q = r - 1024; ret_mfma_item(a, l, q >> 5, (q >> 3) & 3, q & 7, lane); } }
    }
    PMIX_T1(1)
    PMIX_T0(2)
    for (int rep_ = 0; rep_ < (((PROBE_MIXPART >> 2) & 1) ? 2 : 1); ++rep_) {
    LAUNDER_MIX();
#pragma unroll 1
    for (int r0 = gw; r0 < 2048; r0 += NGW) { const int r = (r0 + 1024) & 2047; if (r < 1024) win_mfma_item(a, l, 32 + (r >> 7), (r >> 6) & 1, r & 63, lane); else { const int q = r - 1024; win_mfma_item(a, l, q >> 5, (q >> 4) & 1, q & 15, lane); } }
    }
    PMIX_T1(2)
    PMIX_T0(3)
    for (int rep_ = 0; rep_ < (((PROBE_MIXPART >> 3) & 1) ? 2 : 1); ++rep_) {
    LAUNDER_MIX();
#pragma unroll 1
    for (int r0 = gw; r0 < 2048; r0 += NGW) {
        if (r0 < 1024) hy_mfma_item(a, l, 2048 + r0, lane, (LAS unsigned*)qs);
        else { hy_mfma_item(a, l, 2 * (r0 - 1024), lane, (LAS unsigned*)qs); hy_mfma_item(a, l, 2 * (r0 - 1024) + 1, lane, (LAS unsigned*)qs); } }
    }
    PMIX_T1(3)
}
__device__ __forceinline__ void phase_mixb(const Ctx& a0, int l, LAS unsigned char* lds, int bid, int nblk, int tid) {
    int lane = tid & 63; const int wave = __builtin_amdgcn_readfirstlane(tid >> 6); int NGW = nblk * 8; int gw = bid * 8 + wave;
    Ctx a = a0;
    LAUNDER_MIX();
#pragma unroll 1
    for (int r = gw; r < 2048; r += NGW) hyfin_item(a, l, r, lane);
    PMIX_T0(4)
    for (int rep_ = 0; rep_ < (((PROBE_MIXPART >> 4) & 1) ? 2 : 1); ++rep_) {
    LAUNDER_MIX();
#pragma unroll 1
    for (int r = gw; r < 1024; r += NGW) retstate_mfma_item(a, l, r, lane);
    }
    PMIX_T1(4)
    PMIX_T0(5)
    for (int rep_ = 0; rep_ < (((PROBE_MIXPART >> 5) & 1) ? 2 : 1); ++rep_) {
    LAUNDER_MIX();
    convert_weights(a, l, 1, lds, gw, NGW, wave, lane);
    }
    PMIX_T1(5)
    if (l == 0) { LAUNDER_MIX(); convert_weights(a, 1, 0, lds, gw, NGW, wave, lane); }
}
template <class Epi> __device__ __forceinline__ void run_gemm(LAS unsigned char* lds, const bf16_t* A, const bf16_t* Bt, int N, int K, const Epi& E, int bid, int nblk, int tid) {
    pg8::Gemm g{A, Bt, M, N, K}; pg8::StaticOrder S; S.init(M, N, nblk, bid);
    pg8::gemm_phase<Epi, pg8::StaticOrder, false>(lds, g, S, E, nullptr, tid);
}
#define XB_TMO      128
#define XB_XCNT(j)  (256  + 64 * (j))
#define XB_XSUB(j)  (1280 + 64 * (j))
#define XB_XGEN(j)  (2304 + 64 * (j))
#define XB_TOP      3328
#define XB_TOPGEN   3392
#define XCD_BAR_WORDS 3456
#define XB_SPIN_CAP (1u << 18)

__device__ __forceinline__ unsigned xb_ld(unsigned* p)              { return __hip_atomic_load(p, __ATOMIC_RELAXED, __HIP_MEMORY_SCOPE_AGENT); }
__device__ __forceinline__ unsigned xb_add(unsigned* p, unsigned v) { return __hip_atomic_fetch_add(p, v, __ATOMIC_RELAXED, __HIP_MEMORY_SCOPE_AGENT); }
__device__ __forceinline__ unsigned xb_xcc_id() { return (unsigned)__builtin_amdgcn_s_getreg((3 << 11) | 20) & 0xFu; }
#define XB_SPIN(cond, bar) do { unsigned _sp = 0; while (cond) { __builtin_amdgcn_s_sleep(1); \
    if ((++_sp & 255u) == 0u) { if (xb_ld(&(bar)[XB_TMO])) break; if (_sp > XB_SPIN_CAP) { atomicAdd(&(bar)[XB_TMO], 1u); break; } } } } while (0)

struct XcdBarrier {
    unsigned* bar; unsigned x;
    volatile LAS unsigned* st;
};

__device__ __forceinline__ XcdBarrier xcd_barrier_post(unsigned* bar, volatile LAS unsigned* st) {
    XcdBarrier b; b.bar = bar; b.x = xb_xcc_id(); b.st = st;
    if (threadIdx.x == 0) (void)xb_add(&bar[XB_XCNT(b.x)], 1u);
    return b;
}
__device__ __forceinline__ void xcd_barrier_complete(unsigned* bar, unsigned x, unsigned& nloc, unsigned& nx) {
    const unsigned G = gridDim.x * gridDim.y * gridDim.z;
    unsigned sum, cnt, mine, sp = 0u;
    for (;;) {
        sum = 0u; cnt = 0u; mine = 0u;
#pragma unroll
        for (unsigned j = 0; j < 16; ++j) { const unsigned c = xb_ld(&bar[XB_XCNT(j)]); sum += c; cnt += (c > 0u) ? 1u : 0u; mine = (j == x) ? c : mine; }
        if (sum == G) break;
        __builtin_amdgcn_s_sleep(1);
        if ((++sp & 255u) == 0u) { if (xb_ld(&bar[XB_TMO])) break; if (sp > XB_SPIN_CAP) { atomicAdd(&bar[XB_TMO], 1u); break; } }
    }
    nloc = mine > 0u ? mine : 1u; nx = cnt > 0u ? cnt : 1u;
}

__device__ __forceinline__ void xcd_barrier(const XcdBarrier& b) {
    asm volatile("s_waitcnt vmcnt(0)" ::: "memory");
    __syncthreads();
    if (threadIdx.x == 0) {
        unsigned* bar = b.bar;
        __builtin_amdgcn_s_waitcnt(0);
        unsigned nloc = b.st[0], nx = b.st[1];
        if (nloc == 0u) { xcd_barrier_complete(bar, b.x, nloc, nx); b.st[0] = nloc; b.st[1] = nx; }
        const unsigned old = xb_add(&bar[XB_XSUB(b.x)], 1u);
        const unsigned gen = old / nloc;
        if (old + 1u == (gen + 1u) * nloc) {
            __builtin_amdgcn_fence(__ATOMIC_RELEASE, "agent");
            asm volatile("s_waitcnt vmcnt(0)" ::: "memory");
            const unsigned og = xb_add(&bar[XB_TOP], 1u);
            const unsigned tg = og / nx;
            if (og + 1u == (tg + 1u) * nx) xb_add(&bar[XB_TOPGEN], 1u);
            else XB_SPIN(xb_ld(&bar[XB_TOPGEN]) == tg, bar);
            __builtin_amdgcn_fence(__ATOMIC_ACQUIRE, "agent");
            xb_add(&bar[XB_XGEN(b.x)], 1u);
            asm volatile("s_waitcnt vmcnt(0)" ::: "memory");
        } else {
            XB_SPIN(xb_ld(&bar[XB_XGEN(b.x)]) == gen, bar);
            __builtin_amdgcn_fence(__ATOMIC_ACQUIRE, "agent");
            asm volatile("s_waitcnt vmcnt(0)" ::: "memory");
        }
    }
    __syncthreads();
}

template <int SL> __device__ __forceinline__ void run_slot(const Ctx& a0, int l, LAS unsigned char* lds, int bid, int nblk, int tid) {
    Ctx a = a0;
    { unsigned long long w = (unsigned long long)a.ws, o = (unsigned long long)a.out; unsigned t = (unsigned)(size_t)a.tab, ld = (unsigned)(size_t)lds;
      asm volatile("" : "+s"(w), "+s"(o), "+s"(t), "+s"(ld), "+s"(l), "+s"(bid), "+s"(nblk)); asm volatile("" : "+v"(tid));
      a.ws = (unsigned char*)(__attribute__((address_space(1))) unsigned char*)w; a.out = (float*)(__attribute__((address_space(1))) float*)o; a.tab = (const LAS unsigned long long*)(size_t)t; lds = (LAS unsigned char*)(size_t)ld; }
    unsigned char* ws = a.ws; unsigned char* wb = ws + WS_W;
    bf16_t* H = (bf16_t*)(ws + WS_H); bf16_t* BIG = (bf16_t*)(ws + WS_BIG); bf16_t* YBR = (bf16_t*)(ws + WS_YBR);
    float* MERGEP = (float*)(ws + WS_BIG + 128 * MiB);
    const float* modl = (const float*)(ws + WS_MOD) + (size_t)l * 9 * 9216;
    if constexpr (SL == 0) phase_p0a(a, lds, bid, nblk, tid);
    if constexpr (SL == 1) phase_p0b(a, lds, bid, nblk, tid);
    if constexpr (SL == 2) { phase_norm(a, l, I_NFA, 0, bid, nblk, tid, l == 0); }
    if constexpr (SL == 3) run_gemm(lds, H, (const bf16_t*)(wb + W_FA_IN), 2 * DFF, D, pg8::EpiSwiGLU{BIG, DFF}, bid, nblk, tid);
    if constexpr (SL == 4) run_gemm(lds, BIG, (const bf16_t*)(wb + W_FA_OUT), D, DFF, pg8::EpiResid{a.out, l == 0 ? inp(a, I_XP) : a.out, l == 0 ? inp(a, I_XS) : a.out + (size_t)8192 * 1024, modl + 2 * 1024, 0.5f}, bid, nblk, tid);
    if constexpr (SL == 5) phase_norm(a, l, I_NMIX, 3, bid, nblk, tid);
    if constexpr (SL == 6) run_gemm(lds, H, (const bf16_t*)(wb + W_IN), NMIX, D, pg8::EpiStore<0>{BIG, NMIX}, bid, nblk, tid);
    if constexpr (SL == 7) { phase_prep(a, l, bid, nblk, tid); prep_diff(a, l, lds, bid, nblk, tid); prep_ret(a, l, lds, bid, nblk, tid); prep_win(a, l, lds, bid, nblk, tid); prep_hy(a, l, lds, bid, nblk, tid); }
    if constexpr (SL == 8) phase_mix(a, l, lds, bid, nblk, tid);
    if constexpr (SL == 15) phase_mixb(a, l, lds, bid, nblk, tid);
    if constexpr (SL == 9) run_gemm(lds, H, (const bf16_t*)(wb + W_IN) + (size_t)NMIX * D, NGATE, D, pg8::EpiStore<1>{BIG, NGATE}, bid, nblk, tid);
    if constexpr (SL == 10) { pg8::Gemm g{YBR, (const bf16_t*)(wb + W_BR), 4 * M, 4 * D, 512}; pg8::MergeOrder S; S.init(M, nblk, bid);
        pg8::gemm_phase<pg8::EpiMerge, pg8::MergeOrder, false>(lds, g, S, pg8::EpiMerge{BIG, H}, nullptr, tid); }
    if constexpr (SL == 11) run_gemm(lds, H, (const bf16_t*)(wb + W_OUT), D, D, pg8::EpiResid{a.out, a.out, a.out + (size_t)8192 * 1024, modl + 5 * 1024, 1.0f}, bid, nblk, tid);
    if constexpr (SL == 12) phase_norm(a, l, I_NFB, 6, bid, nblk, tid);
    if constexpr (SL == 13) run_gemm(lds, H, (const bf16_t*)(wb + W_FB_IN), 2 * DFF, D, pg8::EpiSwiGLU{BIG, DFF}, bid, nblk, tid);
    if constexpr (SL == 14) run_gemm(lds, BIG, (const bf16_t*)(wb + W_FB_OUT), D, DFF, pg8::EpiResid{a.out, a.out, a.out + (size_t)8192 * 1024, modl + 8 * 1024, 0.5f}, bid, nblk, tid);
}
template <int SL> __global__ void __launch_bounds__(512, 2) k_slot(Args a) {
    extern __shared__ __attribute__((aligned(16))) unsigned char lds_raw[];
    const Ctx c = make_ctx(a, (LAS unsigned char*)lds_raw, threadIdx.x);
    run_slot<SL>(c, a.ph_lo, (LAS unsigned char*)lds_raw, blockIdx.x, gridDim.x, threadIdx.x);
}

constexpr int CW_BAR = 4096;
__global__ void __launch_bounds__(512, 2) mega(Args a) {
    extern __shared__ __attribute__((aligned(16))) unsigned char lds_raw[];
    LAS unsigned char* lds = (LAS unsigned char*)lds_raw;
    const int tid = threadIdx.x, bid = blockIdx.x, nblk = gridDim.x;
    volatile LAS unsigned* st = (volatile LAS unsigned*)(lds + LDS_ST_OFF);
    const Ctx c = make_ctx(a, lds, tid);
    const XcdBarrier bar = xcd_barrier_post((unsigned*)(a.ws + WS_CTL) + CW_BAR, st);
#define GB() do { XcdBarrier b_ = bar; unsigned long long bp_ = (unsigned long long)b_.bar; unsigned bx_ = b_.x; asm volatile("" : "+s"(bp_), "+s"(bx_)); b_.bar = (unsigned*)bp_; b_.x = bx_; xcd_barrier(b_); } while (0)
#ifndef MEGA_MASK
#define MEGA_MASK 0xffff
#endif
#ifndef PROBE_DUP
#define PROBE_DUP 0
#endif
#ifdef PROF_SLOT
#ifndef PROF_L
#define PROF_L 0
#endif
#ifndef PROF_DIV
#define PROF_DIV 100
#endif
#define PROF_T0(k) if ((k) == PROF_SLOT && ((k) < 2 || l_ == PROF_L)) { __syncthreads(); prof_t0 = __builtin_amdgcn_s_memrealtime(); }
#define PROF_T1(k) if ((k) == PROF_SLOT && ((k) < 2 || l_ == PROF_L)) { __syncthreads(); prof_dt = __builtin_amdgcn_s_memrealtime() - prof_t0; }
#else
#define PROF_T0(k)
#define PROF_T1(k)
#endif
#define RS(k) if constexpr ((PROBE_DUP >> k) & 1) { run_slot<k>(c, (k < 2 ? 0 : l_), lds, bid, nblk, tid); GB(); } if constexpr ((MEGA_MASK >> k) & 1) run_slot<k>
    int l_ = 0; unsigned long long prof_t0 = 0, prof_dt = 0;
    PROF_T0(0) RS(0)(c, 0, lds, bid, nblk, tid); PROF_T1(0) GB();
    PROF_T0(1) RS(1)(c, 0, lds, bid, nblk, tid); PROF_T1(1) GB();
#pragma unroll 1
    for (int l = 0; l < 2; ++l) { l_ = l;
        PROF_T0(2) RS(2)(c, l, lds, bid, nblk, tid); PROF_T1(2) GB();
        PROF_T0(3) RS(3)(c, l, lds, bid, nblk, tid); PROF_T1(3) GB();
        PROF_T0(4) RS(4)(c, l, lds, bid, nblk, tid); PROF_T1(4) GB();
        PROF_T0(5) RS(5)(c, l, lds, bid, nblk, tid); PROF_T1(5) GB();
        PROF_T0(6) RS(6)(c, l, lds, bid, nblk, tid); PROF_T1(6) GB();
        PROF_T0(7) RS(7)(c, l, lds, bid, nblk, tid); PROF_T1(7) GB();
        PROF_T0(8) RS(8)(c, l, lds, bid, nblk, tid); PROF_T1(8) GB();
        PROF_T0(15) RS(15)(c, l, lds, bid, nblk, tid); PROF_T1(15) GB();
        PROF_T0(9) RS(9)(c, l, lds, bid, nblk, tid); PROF_T1(9) GB();
        PROF_T0(10) RS(10)(c, l, lds, bid, nblk, tid); PROF_T1(10) GB();
        PROF_T0(11) RS(11)(c, l, lds, bid, nblk, tid); PROF_T1(11) GB();
        PROF_T0(12) RS(12)(c, l, lds, bid, nblk, tid); PROF_T1(12) GB();
        PROF_T0(13) RS(13)(c, l, lds, bid, nblk, tid); PROF_T1(13) GB();
        PROF_T0(14) RS(14)(c, l, lds, bid, nblk, tid); PROF_T1(14) if (l == 0) GB();
    }
#ifdef PROF_MIX
    GB();
    if (bid == 0 && tid == 0) a.out[0] = (float)((*(LAS unsigned long long*)(lds + LDS_ST_OFF + 16) / 1000ull) * 10ull + 5ull);
#endif
#ifdef PROF_SLOT
    GB();
    if (bid == 0 && tid == 0) a.out[0] = (float)((prof_dt / 2000ull) * 20ull + 10ull);
#endif
#undef GB
#undef RS
}
template <int SL> static void launch_slot(const Args& a, int grid, hipStream_t stream) {
    static bool attr = false;
    if (!attr) { (void)hipFuncSetAttribute((const void*)k_slot<SL>, hipFuncAttributeMaxDynamicSharedMemorySize, LDS_BYTES); attr = true; }
    hipLaunchKernelGGL(k_slot<SL>, dim3(grid), dim3(512), LDS_BYTES, stream, a);
}

#ifdef DIAG_YBR
__global__ void k_diag(Args a) {
    for (size_t i = (size_t)blockIdx.x * blockDim.x + threadIdx.x; i < (size_t)M * 1024; i += (size_t)gridDim.x * blockDim.x) { const size_t row = i >> 10, c = i & 1023;
#if DIAG_YBR < 4
        const bf16_t* y = (const bf16_t*)(a.ws + WS_YBR) + (size_t)DIAG_YBR * M * 512;
        a.out[i] = bf2f(y[(c >> 9) * (size_t)M * 512 + row * 512 + (c & 511)]);
#elif DIAG_YBR == 4
        a.out[i] = bf2f(((const bf16_t*)(a.ws + WS_H))[i]);
#elif DIAG_YBR >= 5 && DIAG_YBR < 9
        a.out[i] = bf2f(((const bf16_t*)(a.ws + WS_BIG))[row * 4096 + (DIAG_YBR - 5) * 1024 + c]);
#elif DIAG_YBR == 9
        a.out[i] = ((const float*)(a.ws + WS_BIG + 128 * MiB))[i];
#elif DIAG_YBR >= 10 && DIAG_YBR < 15
        a.out[i] = bf2f(((const bf16_t*)(a.ws + WS_BIG))[row * 5376 + (DIAG_YBR - 10) * 1024 + c]);
#elif DIAG_YBR >= 15 && DIAG_YBR < 17
        a.out[i] = bf2f(((const bf16_t*)(a.ws + WS_BIG))[row * 2816 + (DIAG_YBR - 15) * 1024 + c]);
#endif
    }
}
#endif
extern "C" void kernel_launch(void* const* d_in, const int* in_sizes, int n_in, void* d_out, int out_size, void* d_ws, size_t ws_size, hipStream_t stream) {
    static int grid = 0;
    if (grid == 0) {
        if (n_in != N_IN || out_size != (int)O_END || ws_size < WS_END) { fprintf(stderr, "kernel_launch: unexpected shapes: n_in %d out %d ws %zu (need %zu)\n", n_in, out_size, ws_size, (size_t)WS_END); grid = -1; return; }
        int dev = 0, cus = 0;
        if (hipGetDevice(&dev) != hipSuccess || hipDeviceGetAttribute(&cus, hipDeviceAttributeMultiprocessorCount, dev) != hipSuccess) { grid = -1; return; }
        grid = cus > 0 ? cus : 256;
    }
    if (grid < 0) return;
    (void)hipMemsetAsync((char*)d_ws + WS_CTL, 0, CTL_ZERO_BYTES, stream);
    Args a{};
    for (int i = 0; i < N_IN; ++i) a.in[i] = (const float*)d_in[i];
    a.out = (float*)d_out; a.ws = (unsigned char*)d_ws;
    a.ph_lo = 0; a.ph_hi = 0;
#ifndef MULTI_LAUNCH
    { static bool attr = false; if (!attr) { (void)hipFuncSetAttribute((const void*)mega, hipFuncAttributeMaxDynamicSharedMemorySize, LDS_BYTES); attr = true; }
      hipLaunchKernelGGL(mega, dim3(grid), dim3(512), LDS_BYTES, stream, a); return; }
#endif
    int nl = 0;
#ifndef STOP_AFTER
#define STOP_AFTER 1000
#endif
#define LS(k) do { if (nl++ < STOP_AFTER) launch_slot<k>(a, grid, stream); } while (0)
    LS(0); LS(1);
    for (int l = 0; l < 2; ++l) { a.ph_lo = l;
        LS(2); LS(3); LS(4); LS(5); LS(6); LS(7); LS(8); LS(15); LS(9); LS(10); LS(11); LS(12); LS(13); LS(14); }
#ifdef DIAG_YBR
    hipLaunchKernelGGL(k_diag, dim3(1024), dim3(256), 0, stream, a);
#endif
}
```
